# Optimizing an MI355X kernel written in HIP

```python
import math
import jax, jax.numpy as jnp
from jax import lax
import numpy as np

D_MODEL = 4096
BATCH = 2
SEQ = 8192
DEPTH = 1
DEC_BATCH = 1
DEC_SEQ = 8192
PAST_LEN = 128

RMS_EPS = 1e-6
POOL_WIDTH = D_MODEL // 2
POOL_WINDOWS = (2, 4, 8, 16)
N_POOL_GROUPS = len(POOL_WINDOWS)
POOL_GROUP = POOL_WIDTH // N_POOL_GROUPS
N_HEADS = 16
NOPE_DIM = 128
ROPE_DIM = 64
V_DIM = 128
QK_DIM = NOPE_DIM + ROPE_DIM
Q_LORA = D_MODEL // 4
KV_LORA = D_MODEL // 8
MLA_WIDTH = N_HEADS * V_DIM
ROPE_THETA = 10000.0
Q_BLOCK = 128
D_FF = 11008
CONV_W = 3
OFF_POOL = 0
OFF_CQ = OFF_POOL + POOL_WIDTH
OFF_CKV = OFF_CQ + Q_LORA
OFF_KR = OFF_CKV + KV_LORA
OFF_GP = OFF_KR + ROPE_DIM
OFF_GM = OFF_GP + D_MODEL
IN_COLS = OFF_GM + D_MODEL

kernel_name = "gated_pool_mla_convglu_encoder"


def _rmsnorm(x, g):
    xf = x.astype(jnp.float32)
    y = xf * lax.rsqrt(jnp.mean(xf * xf, axis=-1, keepdims=True) + RMS_EPS)
    return (y * g.astype(jnp.float32)).astype(x.dtype)


def _rope_tables(S):
    inv = 1.0 / (ROPE_THETA ** (jnp.arange(0, ROPE_DIM, 2, dtype=jnp.float32) / ROPE_DIM))
    ang = jnp.arange(S, dtype=jnp.float32)[:, None] * inv[None, :]
    return jnp.cos(ang), jnp.sin(ang)


def _apply_rope(x, cos, sin):
    xf = x.astype(jnp.float32)
    x1, x2 = jnp.split(xf, 2, axis=-1)
    c = cos[None, :, None, :]
    s = sin[None, :, None, :]
    out = jnp.concatenate([x1 * c - x2 * s, x2 * c + x1 * s], axis=-1)
    return out.astype(x.dtype)


def _multiscale_pool(u):
    B, S, _ = u.shape
    ug = u.reshape(B, S, N_POOL_GROUPS, POOL_GROUP).astype(jnp.float32)
    cs = jnp.pad(jnp.cumsum(ug, axis=1), ((0, 0), (1, 0), (0, 0), (0, 0)))
    t = jnp.arange(S)
    means = []
    for gi, w in enumerate(POOL_WINDOWS):
        lo = jnp.clip(t - w // 2, 0, S)
        hi = jnp.clip(t + (w - w // 2), 0, S)
        csg = cs[:, :, gi]
        cnt = (hi - lo).astype(jnp.float32)[None, :, None]
        means.append((csg[:, hi] - csg[:, lo]) / cnt)
    mean = jnp.stack(means, axis=2)
    return (mean - ug).astype(u.dtype)


def _attention(q, k, v):
    B, S, H, Dq = q.shape
    nblk = S // Q_BLOCK
    scale = 1.0 / math.sqrt(Dq)
    qb = q.reshape(B, nblk, Q_BLOCK, H, Dq).transpose(1, 0, 2, 3, 4)

    def one_block(qi):
        s = jnp.einsum('bqhd,bkhd->bhqk', qi, k, preferred_element_type=jnp.float32) * scale
        p = jax.nn.softmax(s, axis=-1)
        return jnp.einsum('bhqk,bkhd->bqhd', p.astype(v.dtype), v)

    o = lax.map(one_block, qb)
    return o.transpose(1, 0, 2, 3, 4).reshape(B, S, H * V_DIM)


def _dwconv3(a, w, b):
    ap = jnp.pad(a, ((0, 0), (1, 1), (0, 0)))
    return ap[:, :-2] * w[0] + ap[:, 1:-1] * w[1] + ap[:, 2:] * w[2] + b


def _layer(x, norm_mix_gain, w_in, pool_w, pool_scale, q_a_norm_gain, w_uq, kv_a_norm_gain,
           w_ukv, q_norm_gain, k_norm_gain, w_branch_pool, w_branch_mla, w_o, norm_ffn_gain,
           w_up, conv_w, conv_b, w_down):
    B, S, _ = x.shape
    h = _rmsnorm(x, norm_mix_gain)
    z = h @ w_in
    u_pool = z[..., OFF_POOL:OFF_CQ]
    c_q = z[..., OFF_CQ:OFF_CKV]
    c_kv = z[..., OFF_CKV:OFF_KR]
    k_rope = z[..., OFF_KR:OFF_GP]
    g_pool = z[..., OFF_GP:OFF_GM]
    g_mla = z[..., OFF_GM:IN_COLS]

    pooled = _multiscale_pool(u_pool)
    a_out = jnp.einsum('bsgc,gcd->bsgd', pooled, pool_w).reshape(B, S, POOL_WIDTH) * pool_scale

    q = (_rmsnorm(c_q, q_a_norm_gain) @ w_uq).reshape(B, S, N_HEADS, QK_DIM)
    kv = (_rmsnorm(c_kv, kv_a_norm_gain) @ w_ukv).reshape(B, S, N_HEADS, NOPE_DIM + V_DIM)
    k_nope, v = kv[..., :NOPE_DIM], kv[..., NOPE_DIM:]
    k_r = jnp.broadcast_to(k_rope[:, :, None, :], (B, S, N_HEADS, ROPE_DIM))
    k = jnp.concatenate([k_nope, k_r], axis=-1)
    q = _rmsnorm(q, q_norm_gain)
    k = _rmsnorm(k, k_norm_gain)
    cos, sin = _rope_tables(S)
    q = jnp.concatenate([q[..., :NOPE_DIM], _apply_rope(q[..., NOPE_DIM:], cos, sin)], axis=-1)
    k = jnp.concatenate([k[..., :NOPE_DIM], _apply_rope(k[..., NOPE_DIM:], cos, sin)], axis=-1)
    b_out = _attention(q, k, v)

    m = jax.nn.sigmoid(g_pool) * (a_out @ w_branch_pool) + jax.nn.sigmoid(g_mla) * (b_out @ w_branch_mla)
    x = x + m @ w_o

    h2 = _rmsnorm(x, norm_ffn_gain)
    up = _dwconv3(h2 @ w_up, conv_w, conv_b)
    gate, val = up[..., :D_FF], up[..., D_FF:]
    return x + (jax.nn.silu(gate) * val) @ w_down


def _trunk(x, norm_mix_gain, w_in, pool_w, pool_scale, q_a_norm_gain, w_uq, kv_a_norm_gain,
           w_ukv, q_norm_gain, k_norm_gain, w_branch_pool, w_branch_mla, w_o, norm_ffn_gain,
           w_up, conv_w, conv_b, w_down):
    for l in range(DEPTH):
        x = _layer(x, norm_mix_gain[l], w_in[l], pool_w[l], pool_scale[l], q_a_norm_gain[l],
                   w_uq[l], kv_a_norm_gain[l], w_ukv[l], q_norm_gain[l], k_norm_gain[l],
                   w_branch_pool[l], w_branch_mla[l], w_o[l], norm_ffn_gain[l], w_up[l],
                   conv_w[l], conv_b[l], w_down[l])
    return x


def setup_inputs(seed: int = 0) -> dict:
    key = jax.random.key(seed)
    ks = jax.random.split(key, 20)
    f32 = jnp.float32
    L = DEPTH

    def nrm(k, shape, fan_in):
        return jax.random.normal(k, shape, f32) * (fan_in ** -0.5)

    def gain(k, n):
        return 1.0 + 0.02 * jax.random.normal(k, (L, n), f32)

    return {
        "x_prompt": jax.random.normal(ks[0], (BATCH, SEQ, D_MODEL), f32),
        "x_sample": jax.random.normal(ks[1], (DEC_BATCH, DEC_SEQ, D_MODEL), f32),
        "norm_mix_gain": gain(ks[2], D_MODEL),
        "w_in": nrm(ks[3], (L, D_MODEL, IN_COLS), D_MODEL),
        "pool_w": nrm(ks[4], (L, N_POOL_GROUPS, POOL_GROUP, POOL_GROUP), POOL_GROUP),
        "pool_scale": 1.0 + 0.1 * jax.random.normal(ks[5], (L, POOL_WIDTH), f32),
        "q_a_norm_gain": gain(ks[6], Q_LORA),
        "w_uq": nrm(ks[7], (L, Q_LORA, N_HEADS * QK_DIM), Q_LORA),
        "kv_a_norm_gain": gain(ks[8], KV_LORA),
        "w_ukv": nrm(ks[9], (L, KV_LORA, N_HEADS * (NOPE_DIM + V_DIM)), KV_LORA),
        "q_norm_gain": gain(ks[10], QK_DIM),
        "k_norm_gain": gain(ks[11], QK_DIM),
        "w_branch_pool": nrm(ks[12], (L, POOL_WIDTH, D_MODEL), POOL_WIDTH),
        "w_branch_mla": nrm(ks[13], (L, MLA_WIDTH, D_MODEL), MLA_WIDTH),
        "w_o": nrm(ks[14], (L, D_MODEL, D_MODEL), D_MODEL),
        "norm_ffn_gain": gain(ks[15], D_MODEL),
        "w_up": nrm(ks[16], (L, D_MODEL, 2 * D_FF), D_MODEL),
        "conv_w": nrm(ks[17], (L, CONV_W, 2 * D_FF), CONV_W),
        "conv_b": 0.01 * jax.random.normal(ks[18], (L, 2 * D_FF), f32),
        "w_down": nrm(ks[19], (L, D_FF, D_MODEL), D_FF),
    }


def reference(x_prompt, x_sample, norm_mix_gain, w_in, pool_w, pool_scale, q_a_norm_gain, w_uq,
              kv_a_norm_gain, w_ukv, q_norm_gain, k_norm_gain, w_branch_pool, w_branch_mla, w_o,
              norm_ffn_gain, w_up, conv_w, conv_b, w_down):
    y_prompt = _trunk(x_prompt, norm_mix_gain, w_in, pool_w, pool_scale, q_a_norm_gain, w_uq,
                      kv_a_norm_gain, w_ukv, q_norm_gain, k_norm_gain, w_branch_pool,
                      w_branch_mla, w_o, norm_ffn_gain, w_up, conv_w, conv_b, w_down)
    y_sample = _trunk(x_sample, norm_mix_gain, w_in, pool_w, pool_scale, q_a_norm_gain, w_uq,
                      kv_a_norm_gain, w_ukv, q_norm_gain, k_norm_gain, w_branch_pool,
                      w_branch_mla, w_o, norm_ffn_gain, w_up, conv_w, conv_b, w_down)
    return (y_prompt, y_sample)
```

```cpp
#include <hip/hip_runtime.h>
#include <cstdio>
#include <cstdint>
namespace pg8 {
#define PG8_LAS __attribute__((address_space(3)))
typedef unsigned short bf16_t;
typedef short bf16x8 __attribute__((ext_vector_type(8)));
typedef float f32x4 __attribute__((ext_vector_type(4)));
typedef unsigned u32x4 __attribute__((ext_vector_type(4)));
constexpr int BM = 256, BK = 64, HALF = 128, HTB = HALF * BK * 2  , STAGE_BYTES = 8 * HTB, NXCD = 8, WGM = 8;

__host__ __device__ __forceinline__ int lds_byte(int r, int c) { const int st = (r >> 4) * 2 + (c >> 5), rr = r & 15, cc = c & 31, ob = rr * 64 + cc * 2; return st * 1024 + (ob ^ (((ob >> 9) & 1) << 5)); }
__host__ __device__ __forceinline__ void stage_rc(int b, int& R, int& C) { const int st = b / 1024, sb = b % 1024, swz = sb ^ (((sb >> 9) & 1) << 5); R = (st >> 1) * 16 + swz / 64; C = (st & 1) * 32 + (swz % 64) / 2; }
__host__ __device__ __forceinline__ int perm32(int rho) { const int n = rho >> 4, i = rho & 15; return 8 * (i >> 2) + 4 * n + (i & 3); }

struct Unit { int pm, pn; };
struct Gemm { const bf16_t* A; const bf16_t* Bt; int M, N, K; };

struct StaticOrder {
    int nM, nN, nwg, G, c;
    __host__ __device__ void init(int M, int N, int G_, int c_) { nM = M / BM; nN = N / BM; nwg = nM * nN; G = G_; c = c_; }
    __host__ __device__ bool next(int i, Unit& u) const {
        const long L = (long)i * G + c; if (L >= nwg) return false;
        int wgid = (int)L; { const int q = nwg / NXCD, r = nwg % NXCD, xcd = wgid % NXCD, off = wgid / NXCD; wgid = (xcd < r ? xcd * (q + 1) : r * (q + 1) + (xcd - r) * q) + off; }
        const int nig = WGM * nN, gid = wgid / nig, fm = gid * WGM, gsz = (nM - fm) < WGM ? (nM - fm) : WGM;
        u.pm = fm + ((wgid % nig) % gsz); u.pn = (wgid % nig) / gsz; return true;
    }
    __device__ __forceinline__ void a_ready(const Unit&) const {}
    __device__ __forceinline__ void done(const Unit&) const {}
};
__device__ __forceinline__ unsigned cvt_pk_bf16(float lo, float hi) { unsigned r; asm volatile("v_cvt_pk_bf16_f32 %0, %1, %2" : "=v"(r) : "v"(lo), "v"(hi)); return r; }
typedef float f32x2 __attribute__((ext_vector_type(2)));

struct PoolOrder {
    int G, c;
    __device__ __forceinline__ bool next(int i, Unit& u) const {
        const int L = i * G + c; if (L >= 768) return false;
        const int g = L / 192, r = L % 192; u.pm = g * 96 + (r >> 1); u.pn = g * 2 + (r & 1); return true;
    }
    __device__ __forceinline__ void a_ready(const Unit&) const {}
    __device__ __forceinline__ void done(const Unit&) const {}
};
__device__ __forceinline__ void st8(bf16_t* p, const f32x4 v0, const f32x4 v1) {
    u32x4 w; w.x = cvt_pk_bf16(v0[0], v0[1]); w.y = cvt_pk_bf16(v0[2], v0[3]); w.z = cvt_pk_bf16(v1[0], v1[1]); w.w = cvt_pk_bf16(v1[2], v1[3]);
    *(u32x4*)p = w;
}
__device__ __forceinline__ void ld8(const bf16_t* p, f32x4& v0, f32x4& v1) {
    const u32x4 w = *(const u32x4*)p;
    v0[0] = __uint_as_float(w.x << 16); v0[1] = __uint_as_float(w.x & 0xffff0000u); v0[2] = __uint_as_float(w.y << 16); v0[3] = __uint_as_float(w.y & 0xffff0000u);
    v1[0] = __uint_as_float(w.z << 16); v1[1] = __uint_as_float(w.z & 0xffff0000u); v1[2] = __uint_as_float(w.w << 16); v1[3] = __uint_as_float(w.w & 0xffff0000u);
}
__device__ __forceinline__ float sigmoidf_(float x) { return __builtin_amdgcn_rcpf(1.0f + __expf(-x)); }
__device__ __forceinline__ f32x4 sig4(const f32x4 x) { f32x4 r; r[0] = sigmoidf_(x[0]); r[1] = sigmoidf_(x[1]); r[2] = sigmoidf_(x[2]); r[3] = sigmoidf_(x[3]); return r; }

struct EpiBf {
    static constexpr bool PERM = true, AFTER_DRAIN = false;
    bf16_t* O; int ldc;
    __device__ __forceinline__ void operator()(const f32x4 (&acc)[2][2][4][2], const Unit& u, int wr, int wc, int fr, int fq) const {
        const int row0 = u.pm * BM + wr * 64 + fr, col0 = u.pn * BM + wc * 32 + 8 * fq;
#pragma unroll
        for (int ai = 0; ai < 2; ++ai)
#pragma unroll
            for (int m = 0; m < 4; ++m) { bf16_t* rowp = O + (size_t)(row0 + ai * HALF + m * 16) * ldc + col0;
#pragma unroll
                for (int bj = 0; bj < 2; ++bj) st8(rowp + bj * HALF, acc[ai][bj][m][0], acc[ai][bj][m][1]); }
    }
};
struct EpiZ {
    static constexpr bool PERM = true, AFTER_DRAIN = false;
    bf16_t *ZA, *ZG, *ZK;
    __device__ __forceinline__ void operator()(const f32x4 (&acc)[2][2][4][2], const Unit& u, int wr, int wc, int fr, int fq) const {
        bf16_t* base; int ldc, colt;
        if (u.pn < 14) { base = ZA; ldc = 3584; colt = u.pn * 256; } else if (u.pn < 46) { base = ZG; ldc = 8192; colt = (u.pn - 14) * 256; } else { base = ZK; ldc = 256; colt = 0; }
        const int row0 = u.pm * BM + wr * 64 + fr, col0 = colt + wc * 32 + 8 * fq;
#pragma unroll
        for (int ai = 0; ai < 2; ++ai)
#pragma unroll
            for (int m = 0; m < 4; ++m) { bf16_t* rowp = base + (size_t)(row0 + ai * HALF + m * 16) * ldc + col0;
#pragma unroll
                for (int bj = 0; bj < 2; ++bj) st8(rowp + bj * HALF, acc[ai][bj][m][0], acc[ai][bj][m][1]); }
    }
};
struct EpiPool {
    static constexpr bool PERM = true, AFTER_DRAIN = false;
    bf16_t* O; const float* scale;
    __device__ __forceinline__ void operator()(const f32x4 (&acc)[2][2][4][2], const Unit& u, int wr, int wc, int fr, int fq) const {
        const int g = u.pm / 96, row0 = (u.pm % 96) * BM + wr * 64 + fr, col0 = g * 512 + (u.pn & 1) * 256 + wc * 32 + 8 * fq;
        f32x4 sv[2][2];
#pragma unroll
        for (int bj = 0; bj < 2; ++bj)
#pragma unroll
            for (int n = 0; n < 2; ++n) sv[bj][n] = *(const f32x4*)(scale + col0 + bj * HALF + 4 * n);
#pragma unroll
        for (int ai = 0; ai < 2; ++ai)
#pragma unroll
            for (int m = 0; m < 4; ++m) { bf16_t* rowp = O + (size_t)(row0 + ai * HALF + m * 16) * 2048 + col0;
#pragma unroll
                for (int bj = 0; bj < 2; ++bj) st8(rowp + bj * HALF, acc[ai][bj][m][0] * sv[bj][0], acc[ai][bj][m][1] * sv[bj][1]); }
    }
};
struct EpiGateA {
    static constexpr bool PERM = true, AFTER_DRAIN = false;
    bf16_t* T; const bf16_t* ZG;
    __device__ __forceinline__ void operator()(const f32x4 (&acc)[2][2][4][2], const Unit& u, int wr, int wc, int fr, int fq) const {
        const int row0 = u.pm * BM + wr * 64 + fr, col0 = u.pn * BM + wc * 32 + 8 * fq;
#pragma unroll
        for (int ai = 0; ai < 2; ++ai)
#pragma unroll
            for (int m = 0; m < 4; ++m) { const size_t r = (size_t)(row0 + ai * HALF + m * 16);
#pragma unroll
                for (int bj = 0; bj < 2; ++bj) { f32x4 g0, g1; ld8(ZG + r * 8192 + col0 + bj * HALF, g0, g1);
                    st8(T + r * 4096 + col0 + bj * HALF, acc[ai][bj][m][0] * sig4(g0), acc[ai][bj][m][1] * sig4(g1)); } }
    }
};
struct EpiGateB {
    static constexpr bool PERM = true, AFTER_DRAIN = false;
    const bf16_t* T; bf16_t* Mo; const bf16_t* ZG;
    __device__ __forceinline__ void operator()(const f32x4 (&acc)[2][2][4][2], const Unit& u, int wr, int wc, int fr, int fq) const {
        const int row0 = u.pm * BM + wr * 64 + fr, col0 = u.pn * BM + wc * 32 + 8 * fq;
#pragma unroll
        for (int ai = 0; ai < 2; ++ai)
#pragma unroll
            for (int m = 0; m < 4; ++m) { const size_t r = (size_t)(row0 + ai * HALF + m * 16);
#pragma unroll
                for (int bj = 0; bj < 2; ++bj) { f32x4 g0, g1, t0, t1; ld8(ZG + r * 8192 + 4096 + col0 + bj * HALF, g0, g1); ld8(T + r * 4096 + col0 + bj * HALF, t0, t1);
                    st8(Mo + r * 4096 + col0 + bj * HALF, t0 + acc[ai][bj][m][0] * sig4(g0), t1 + acc[ai][bj][m][1] * sig4(g1)); } }
    }
};
struct EpiResX {
    static constexpr bool PERM = false, AFTER_DRAIN = false;
    const float *xp, *xs; float* out;
    __device__ __forceinline__ void operator()(const f32x4 (&acc)[2][2][4][2], const Unit& u, int wr, int wc, int fr, int fq) const {
        const float* xb = (u.pm < 64) ? xp + (size_t)u.pm * BM * 4096 : xs + (size_t)(u.pm - 64) * BM * 4096;
        float* ob = out + (size_t)u.pm * BM * 4096;
        const int rl0 = wr * 64 + fr, col0 = u.pn * BM + wc * 32 + 4 * fq;
#pragma unroll
        for (int ai = 0; ai < 2; ++ai)
#pragma unroll
            for (int m = 0; m < 4; ++m) { const size_t off = (size_t)(rl0 + ai * HALF + m * 16) * 4096 + col0;
#pragma unroll
                for (int bj = 0; bj < 2; ++bj)
#pragma unroll
                    for (int n = 0; n < 2; ++n) { const f32x4 xv = *(const f32x4*)(xb + off + bj * HALF + n * 16); *(f32x4*)(ob + off + bj * HALF + n * 16) = xv + acc[ai][bj][m][n]; }
                asm volatile("" ::: "memory"); }
    }
};
struct EpiResOut {
    static constexpr bool PERM = false, AFTER_DRAIN = false;
    float* out;
    __device__ __forceinline__ void operator()(const f32x4 (&acc)[2][2][4][2], const Unit& u, int wr, int wc, int fr, int fq) const {
        float* ob = out + (size_t)u.pm * BM * 4096;
        const int rl0 = wr * 64 + fr, col0 = u.pn * BM + wc * 32 + 4 * fq;
#pragma unroll
        for (int ai = 0; ai < 2; ++ai)
#pragma unroll
            for (int m = 0; m < 4; ++m) { const size_t off = (size_t)(rl0 + ai * HALF + m * 16) * 4096 + col0;
#pragma unroll
                for (int bj = 0; bj < 2; ++bj)
#pragma unroll
                    for (int n = 0; n < 2; ++n) { const f32x4 xv = *(const f32x4*)(ob + off + bj * HALF + n * 16); *(f32x4*)(ob + off + bj * HALF + n * 16) = xv + acc[ai][bj][m][n]; }
                asm volatile("" ::: "memory"); }
    }
};
template <class Epi, class Sched, bool ALIGN_EPI = false, bool SP2 = false>
__device__ __forceinline__ void gemm_phase(PG8_LAS unsigned char* lds, const Gemm g, const Sched& S, const Epi& E) {
    int tid_l = threadIdx.x; asm volatile("" : "+v"(tid_l));
    const int tid = tid_l, wid = __builtin_amdgcn_readfirstlane(tid >> 6), lane = tid & 63, wr = wid >> 2, wc = wid & 3, fr = lane & 15, fq = lane >> 4;
    const int K = g.K, nt = K / BK;
    unsigned voffA[2], voffB[2];
#pragma unroll
    for (int i = 0; i < 2; ++i) { int R, C; stage_rc(tid * 16 + i * 8192, R, C); const int Rb = Epi::PERM ? ((R & ~31) + perm32(R & 31)) : R;
        voffA[i] = (unsigned)(R * K + C) * 2u; voffB[i] = (unsigned)(Rb * K + C) * 2u; }
    const size_t kstep = (size_t)(BK * 2);
    const size_t hstep = (size_t)HALF * K * 2;
    const size_t tstep = 2 * hstep;
    const unsigned ldsw = (unsigned)wid * 1024u;
    const int aoff = lds_byte(wr * 64 + fr, fq * 8), boff = lds_byte(wc * 32 + fr, fq * 8);
#define PG8_SA(b, h) (((b) * 2 + (h)) * HTB)
#define PG8_SB(b, h) ((4 + (b) * 2 + (h)) * HTB)
#define PG8_STAGE(bufoff, gbase, voff) do { _Pragma("unroll") for (int _i = 0; _i < 2; ++_i) \
        __builtin_amdgcn_global_load_lds((const unsigned*)((const char*)(gbase) + (voff)[_i]), (PG8_LAS unsigned*)(lds + (bufoff) + ldsw + _i * 8192), 16, 0, 0); } while (0)
#define PG8_LDA(dst, b, h) do { _Pragma("unroll") for (int m = 0; m < 4; ++m) _Pragma("unroll") for (int k = 0; k < 2; ++k) dst[m][k] = *(const PG8_LAS bf16x8*)(lds + PG8_SA(b, h) + aoff + m * 2048 + k * 1024); } while (0)
#define PG8_LDB(dst, b, h) do { _Pragma("unroll") for (int n = 0; n < 2; ++n) _Pragma("unroll") for (int k = 0; k < 2; ++k) dst[n][k] = *(const PG8_LAS bf16x8*)(lds + PG8_SB(b, h) + boff + n * 2048 + k * 1024); } while (0)
#define PG8_MMA(ai, bj, At, Bt) do { __builtin_amdgcn_s_setprio(1); _Pragma("unroll") for (int m = 0; m < 4; ++m) _Pragma("unroll") for (int n = 0; n < 2; ++n) _Pragma("unroll") for (int k = 0; k < 2; ++k) \
        acc[ai][bj][m][n] = __builtin_amdgcn_mfma_f32_16x16x32_bf16(Bt[n][k], At[m][k], acc[ai][bj][m][n], 0, 0, 0); __builtin_amdgcn_s_setprio(0); } while (0)
#define PG8_WAIT_V(n) asm volatile("s_waitcnt vmcnt(" #n ")" ::: "memory")
#define PG8_WAIT_L(n) asm volatile("s_waitcnt lgkmcnt(" #n ")" ::: "memory")
#define PG8_BAR __builtin_amdgcn_s_barrier()
#define PG8_SCHED __builtin_amdgcn_sched_barrier(0)
    Unit cur, nxt; int ui = 0;
    if (!S.next(0, cur)) return;
    f32x4 acc[2][2][4][2];
#pragma unroll
    for (int a = 0; a < 2; ++a)
#pragma unroll
        for (int b = 0; b < 2; ++b)
#pragma unroll
            for (int m = 0; m < 4; ++m)
#pragma unroll
                for (int n = 0; n < 2; ++n) acc[a][b][m][n] = (f32x4){0.f, 0.f, 0.f, 0.f};
    bf16x8 At[4][2], B0[2][2], B1[2][2];
    const char* cA = (const char*)g.A + (size_t)cur.pm * tstep; const char* cB = (const char*)g.Bt + (size_t)cur.pn * tstep;
    S.a_ready(cur);
    if constexpr (SP2) {
        PG8_STAGE(PG8_SB(0, 0), cB, voffB); PG8_STAGE(PG8_SB(0, 1), cB + hstep, voffB); PG8_STAGE(PG8_SA(0, 0), cA, voffA); PG8_STAGE(PG8_SA(0, 1), cA + hstep, voffA);
        if (wr == 1) PG8_BAR;
        PG8_WAIT_V(2); PG8_BAR;
        PG8_STAGE(PG8_SB(1, 0), cB + kstep, voffB); PG8_STAGE(PG8_SA(1, 0), cA + kstep, voffA); PG8_STAGE(PG8_SB(1, 1), cB + hstep + kstep, voffB);
        PG8_WAIT_V(6); PG8_BAR;
    } else {
        PG8_STAGE(PG8_SB(0, 0), cB, voffB); PG8_STAGE(PG8_SA(0, 0), cA, voffA); PG8_STAGE(PG8_SB(0, 1), cB + hstep, voffB); PG8_STAGE(PG8_SA(0, 1), cA + hstep, voffA);
        if (wr == 1) PG8_BAR;
        PG8_WAIT_V(4); PG8_BAR;
        PG8_STAGE(PG8_SB(1, 0), cB + kstep, voffB); PG8_STAGE(PG8_SA(1, 0), cA + kstep, voffA); PG8_STAGE(PG8_SB(1, 1), cB + hstep + kstep, voffB);
        PG8_WAIT_V(6); PG8_BAR;
    }
    for (;;) {
        const bool has_next = S.next(ui + 1, nxt);
        const char* nA = has_next ? (const char*)g.A + (size_t)nxt.pm * tstep : cA; const char* nB = has_next ? (const char*)g.Bt + (size_t)nxt.pn * tstep : cB;
        for (int t = 0; t < nt; t += 2) {
            const bool last = (t == nt - 2);
            const char* a1 = cA + (size_t)(t + 1) * kstep;
            const char* a2 = last ? nA : cA + (size_t)(t + 2) * kstep; const char* b2 = last ? nB : cB + (size_t)(t + 2) * kstep;
            const char* a3 = a2 + kstep; const char* b3 = b2 + kstep;
            if (last && has_next) S.a_ready(nxt);
            if constexpr (SP2) {
            PG8_LDB(B0, 0, 0); PG8_LDB(B1, 0, 1); PG8_SCHED; PG8_LDA(At, 0, 0); PG8_STAGE(PG8_SA(1, 1), a1 + hstep, voffA);
            PG8_WAIT_V(8); PG8_WAIT_L(0); PG8_BAR; PG8_MMA(0, 0, At, B0); PG8_MMA(0, 1, At, B1); PG8_BAR; PG8_SCHED;
            PG8_LDA(At, 0, 1); PG8_STAGE(PG8_SB(0, 0), b2, voffB); PG8_STAGE(PG8_SB(0, 1), b2 + hstep, voffB); PG8_STAGE(PG8_SA(0, 0), a2, voffA);
            PG8_WAIT_V(8); PG8_WAIT_L(0); PG8_BAR; PG8_MMA(1, 0, At, B0); PG8_MMA(1, 1, At, B1); PG8_BAR; PG8_SCHED;
            PG8_LDB(B0, 1, 0); PG8_LDB(B1, 1, 1); PG8_SCHED; PG8_LDA(At, 1, 0); PG8_STAGE(PG8_SA(0, 1), a2 + hstep, voffA);
            PG8_WAIT_V(8); PG8_WAIT_L(0); PG8_BAR; PG8_MMA(0, 0, At, B0); PG8_MMA(0, 1, At, B1); PG8_BAR; PG8_SCHED;
            PG8_LDA(At, 1, 1); PG8_STAGE(PG8_SB(1, 0), b3, voffB); PG8_STAGE(PG8_SB(1, 1), b3 + hstep, voffB); PG8_STAGE(PG8_SA(1, 0), a3, voffA);
            PG8_WAIT_V(8); PG8_WAIT_L(0); PG8_BAR; PG8_MMA(1, 0, At, B0); PG8_MMA(1, 1, At, B1); PG8_BAR; PG8_SCHED;
            } else {
            PG8_LDB(B0, 0, 0); PG8_SCHED; PG8_LDA(At, 0, 0); PG8_STAGE(PG8_SA(1, 1), a1 + hstep, voffA);
            PG8_WAIT_L(8); PG8_BAR; PG8_WAIT_L(0); PG8_MMA(0, 0, At, B0); PG8_BAR; PG8_SCHED;
            PG8_LDB(B1, 0, 1); PG8_STAGE(PG8_SB(0, 0), b2, voffB);
            PG8_BAR; PG8_WAIT_L(0); PG8_MMA(0, 1, At, B1); PG8_BAR;
            PG8_LDA(At, 0, 1); PG8_STAGE(PG8_SA(0, 0), a2, voffA);
            PG8_BAR; PG8_WAIT_L(0); PG8_MMA(1, 0, At, B0); PG8_BAR; PG8_SCHED;
            PG8_STAGE(PG8_SB(0, 1), b2 + hstep, voffB);
            PG8_WAIT_V(6); PG8_BAR; PG8_MMA(1, 1, At, B1); PG8_BAR;
            PG8_LDB(B0, 1, 0); PG8_SCHED; PG8_LDA(At, 1, 0); PG8_STAGE(PG8_SA(0, 1), a2 + hstep, voffA);
            PG8_WAIT_L(8); PG8_BAR; PG8_WAIT_L(0); PG8_MMA(0, 0, At, B0); PG8_BAR; PG8_SCHED;
            PG8_LDB(B1, 1, 1); PG8_STAGE(PG8_SB(1, 0), b3, voffB);
            PG8_BAR; PG8_WAIT_L(0); PG8_MMA(0, 1, At, B1); PG8_BAR;
            PG8_LDA(At, 1, 1); PG8_STAGE(PG8_SA(1, 0), a3, voffA);
            PG8_BAR; PG8_WAIT_L(0); PG8_MMA(1, 0, At, B0); PG8_BAR; PG8_SCHED;
            PG8_STAGE(PG8_SB(1, 1), b3 + hstep, voffB);
            PG8_WAIT_V(6); PG8_BAR; PG8_MMA(1, 1, At, B1); PG8_BAR;
            }
        }
        if constexpr (ALIGN_EPI) { if (wr == 0) PG8_BAR; }
        if constexpr (!Epi::AFTER_DRAIN) { E(acc, cur, wr, wc, fr, fq); S.done(cur); }
        if (!has_next) break;
#pragma unroll
        for (int a = 0; a < 2; ++a)
#pragma unroll
            for (int b = 0; b < 2; ++b)
#pragma unroll
                for (int m = 0; m < 4; ++m)
#pragma unroll
                    for (int n = 0; n < 2; ++n) acc[a][b][m][n] = (f32x4){0.f, 0.f, 0.f, 0.f};
        cur = nxt; cA = nA; cB = nB; ++ui;
        if constexpr (ALIGN_EPI) { if (wr == 1) PG8_BAR; }
    }
    PG8_WAIT_V(0);
    if constexpr (!ALIGN_EPI) { if (wr == 0) PG8_BAR; }
    PG8_BAR;
    if constexpr (Epi::AFTER_DRAIN) { E.fused(acc, cur, wr, wc, fr, fq, lds, wid, lane); S.done(cur); }
#undef PG8_SA
#undef PG8_SB
#undef PG8_STAGE
#undef PG8_LDA
#undef PG8_LDB
#undef PG8_MMA
#undef PG8_WAIT_V
#undef PG8_WAIT_L
#undef PG8_BAR
#undef PG8_SCHED
}
}

namespace att {
#define ATT_LAS __attribute__((address_space(3)))
typedef unsigned short bf16_t;
typedef short bf16x8 __attribute__((ext_vector_type(8)));
typedef short s16x4 __attribute__((ext_vector_type(4)));
typedef float f32x16 __attribute__((ext_vector_type(16)));
typedef unsigned u32x4 __attribute__((ext_vector_type(4)));
constexpr int KROW = 400;
constexpr int SHM_K = 64 * KROW, SHM_V = 64 * 128 * 2;
constexpr int OFF_K = 0, OFF_V = 2 * SHM_K, OFF_SCR = 2 * SHM_K + 2 * SHM_V, ATT_LDS_BYTES = OFF_SCR + 8 * 64 * 4;
constexpr float SCALE = 0.07216878364870322f;
constexpr float THR = 8.f;
constexpr int LDQ = 3072, LDK = 3072, LDV = 4096, LDO = 2048, SEQ = 8192;
#define ATT_SBAR() __builtin_amdgcn_sched_barrier(0)
__device__ __forceinline__ int crow(int r, int hi) { return (r & 3) + 8 * (r >> 2) + 4 * hi; }
__device__ __forceinline__ unsigned cvtpk(float lo, float hi) { unsigned r; asm volatile("v_cvt_pk_bf16_f32 %0, %1, %2" : "=v"(r) : "v"(lo), "v"(hi)); return r; }

__device__ __forceinline__ void partialSM(f32x16& p0, f32x16& p1, float& m_reg, float& mn, float& alpha) {
  constexpr float C = SCALE * 1.4426950408889634f;
  float pmax = p0[0];
#pragma unroll
  for (int r = 1; r < 16; ++r) pmax = fmaxf(pmax, p0[r]);
#pragma unroll
  for (int r = 0; r < 16; ++r) pmax = fmaxf(pmax, p1[r]);
  { auto rr = __builtin_amdgcn_permlane32_swap(__float_as_uint(pmax), __float_as_uint(pmax), false, false);
    pmax = fmaxf(__uint_as_float(rr[0]), __uint_as_float(rr[1])); }
  if (__builtin_expect(__all(pmax - m_reg <= THR / SCALE), 1)) { mn = m_reg; alpha = 1.f; }
  else { mn = fmaxf(m_reg, pmax); alpha = __builtin_amdgcn_exp2f((m_reg - mn) * C); m_reg = mn; }
  const float mnC = -mn * C;
#pragma unroll
  for (int r = 0; r < 16; ++r) p0[r] = fmaf(p0[r], C, mnC);
#pragma unroll
  for (int r = 0; r < 16; ++r) p1[r] = fmaf(p1[r], C, mnC);
#pragma unroll
  for (int r = 0; r < 16; ++r) p0[r] = __builtin_amdgcn_exp2f(p0[r]);
}
__device__ __forceinline__ void finishSM(f32x16& p0, f32x16& p1, float alpha, float& l_reg, bf16x8& pa0, bf16x8& pa1, bf16x8& pa2, bf16x8& pa3) {
#pragma unroll
  for (int r = 0; r < 16; ++r) p1[r] = __builtin_amdgcn_exp2f(p1[r]);
  float ps = 0;
#pragma unroll
  for (int r = 0; r < 16; ++r) ps += p0[r];
#pragma unroll
  for (int r = 0; r < 16; ++r) ps += p1[r];
  { auto rr = __builtin_amdgcn_permlane32_swap(__float_as_uint(ps), __float_as_uint(ps), false, false);
    ps = __uint_as_float(rr[0]) + __uint_as_float(rr[1]); }
  l_reg = l_reg * alpha + ps;
#define ATT_PK4(P, BASE, OUT) do { unsigned a0 = cvtpk(P[BASE + 0], P[BASE + 1]), a1 = cvtpk(P[BASE + 2], P[BASE + 3]);   \
    unsigned b0 = cvtpk(P[BASE + 4], P[BASE + 5]), b1 = cvtpk(P[BASE + 6], P[BASE + 7]);                              \
    auto r0 = __builtin_amdgcn_permlane32_swap(a0, b0, false, false); auto r1 = __builtin_amdgcn_permlane32_swap(a1, b1, false, false); \
    u32x4 w = {r0[0], r1[0], r0[1], r1[1]}; OUT = *reinterpret_cast<bf16x8*>(&w); } while (0)
  ATT_PK4(p0, 0, pa0); ATT_PK4(p0, 8, pa1); ATT_PK4(p1, 0, pa2); ATT_PK4(p1, 8, pa3);
#undef ATT_PK4
}
__device__ __forceinline__ void qkt(f32x16& p0, f32x16& p1, const ATT_LAS unsigned char* Ks, const bf16x8 (&qr)[12], int r32, int hi) {
  p0 = f32x16{}; p1 = f32x16{};
#pragma unroll
  for (int d0 = 0; d0 < 12; ++d0) { const int cb = (d0 * 16 + hi * 8) * 2;
    const bf16x8 b0 = *(const ATT_LAS bf16x8*)(Ks + r32 * KROW + cb);
    const bf16x8 b1 = *(const ATT_LAS bf16x8*)(Ks + (32 + r32) * KROW + cb);
    p0 = __builtin_amdgcn_mfma_f32_32x32x16_bf16(b0, qr[d0], p0, 0, 0, 0);
    p1 = __builtin_amdgcn_mfma_f32_32x32x16_bf16(b1, qr[d0], p1, 0, 0, 0); }
}
__device__ __forceinline__ int v_st(int k, int c) { const int kk = (k & ~0xC) | ((k & 4) << 1) | ((k & 8) >> 1); return ((kk >> 3) * 4 + (c >> 5)) * 512 + ((kk & 7) * 32 + (c & 31)) * 2; }
__device__ __forceinline__ int v_rd_base(int lane) { return ((lane & 3) << 3) | (((lane >> 2) & 3) << 6) | (((lane >> 4) & 1) << 5) | (((lane >> 5) & 1) << 8); }
constexpr int v_rd_off(int d0, int ks, int half) { return d0 * 512 + ks * 4096 + half * 2048; }
template <int OFF> __device__ __forceinline__ s16x4 tr_read(int vb) {
  s16x4 r; asm volatile("ds_read_b64_tr_b16 %0, %1 offset:%2" : "=&v"(r) : "v"(vb), "i"(OFF) : "memory"); return r;
}
template <int D0> __device__ __forceinline__ void pv_one(f32x16& od, int vb, bf16x8 pa0, bf16x8 pa1, bf16x8 pa2, bf16x8 pa3) {
  const s16x4 l0 = tr_read<v_rd_off(D0, 0, 0)>(vb), h0 = tr_read<v_rd_off(D0, 0, 1)>(vb), l1 = tr_read<v_rd_off(D0, 1, 0)>(vb), h1 = tr_read<v_rd_off(D0, 1, 1)>(vb);
  const s16x4 l2 = tr_read<v_rd_off(D0, 2, 0)>(vb), h2 = tr_read<v_rd_off(D0, 2, 1)>(vb), l3 = tr_read<v_rd_off(D0, 3, 0)>(vb), h3 = tr_read<v_rd_off(D0, 3, 1)>(vb);
  asm volatile("s_waitcnt lgkmcnt(0)" ::: "memory"); ATT_SBAR();
#define ATT_PK(L, H) (bf16x8){L[0], L[1], L[2], L[3], H[0], H[1], H[2], H[3]}
  od = __builtin_amdgcn_mfma_f32_32x32x16_bf16(pa0, ATT_PK(l0, h0), od, 0, 0, 0);
  od = __builtin_amdgcn_mfma_f32_32x32x16_bf16(pa1, ATT_PK(l1, h1), od, 0, 0, 0);
  od = __builtin_amdgcn_mfma_f32_32x32x16_bf16(pa2, ATT_PK(l2, h2), od, 0, 0, 0);
  od = __builtin_amdgcn_mfma_f32_32x32x16_bf16(pa3, ATT_PK(l3, h3), od, 0, 0, 0);
#undef ATT_PK
}
__device__ __forceinline__ void pv_d0(f32x16 (&o)[4], int vb, bf16x8 pa0, bf16x8 pa1, bf16x8 pa2, bf16x8 pa3) {
  pv_one<0>(o[0], vb, pa0, pa1, pa2, pa3); pv_one<1>(o[1], vb, pa0, pa1, pa2, pa3); pv_one<2>(o[2], vb, pa0, pa1, pa2, pa3); pv_one<3>(o[3], vb, pa0, pa1, pa2, pa3);
}

__device__ __forceinline__ void attn_unit(const bf16_t* __restrict__ Qb, const bf16_t* __restrict__ Kh, const bf16_t* __restrict__ Vh, bf16_t* __restrict__ Ob, ATT_LAS unsigned char* lds) {
  int tid_l = threadIdx.x; asm volatile("" : "+v"(tid_l));
  const int tid = tid_l, wid = tid >> 6, lane = tid & 63, r32 = lane & 31, hi = lane >> 5;
  ATT_LAS unsigned char* Kl = lds + OFF_K; ATT_LAS unsigned char* Vl = lds + OFF_V;
  ATT_LAS float* scr = (ATT_LAS float*)(lds + OFF_SCR) + wid * 64; ATT_LAS float* li_l = scr; ATT_LAS float* al_l = scr + 32;
  float m_reg = -1e30f, l_reg = 0.f; f32x16 o[4] = {}; bf16x8 qr[12];
  const bf16_t* Qw = Qb + (size_t)(wid * 32 + r32) * LDQ + hi * 8;
#pragma unroll
  for (int d0 = 0; d0 < 12; ++d0) qr[d0] = *(const bf16x8*)(Qw + d0 * 16);
  int kg[3], kl[3];
#pragma unroll
  for (int i = 0; i < 3; ++i) { const int idx = tid + 512 * i, row = idx / 24, c16 = idx % 24; kg[i] = row * LDK + c16 * 8; kl[i] = row * KROW + c16 * 16; }
  const int sr = tid >> 4, sc = (tid & 15) * 8;
  const int vg0 = sr * LDV + sc, vg1 = (32 + sr) * LDV + sc, vl0 = v_st(sr, sc), vl1 = v_st(32 + sr, sc);
  const int vb0 = (int)(unsigned)(uintptr_t)Vl + v_rd_base(lane);
  bf16x8 ks0, ks1, ks2, vs0, vs1;
#define ATT_SLOAD(key0) do { const bf16_t* kp = Kh + (size_t)(key0) * LDK; const bf16_t* vp = Vh + (size_t)(key0) * LDV; \
    ks0 = *(const bf16x8*)(kp + kg[0]); ks1 = *(const bf16x8*)(kp + kg[1]); ks2 = *(const bf16x8*)(kp + kg[2]); vs0 = *(const bf16x8*)(vp + vg0); vs1 = *(const bf16x8*)(vp + vg1); } while (0)
#define ATT_SWRITE(b) do { *(ATT_LAS bf16x8*)(Kl + (b) * SHM_K + kl[0]) = ks0; *(ATT_LAS bf16x8*)(Kl + (b) * SHM_K + kl[1]) = ks1; *(ATT_LAS bf16x8*)(Kl + (b) * SHM_K + kl[2]) = ks2; \
    *(ATT_LAS bf16x8*)(Vl + (b) * SHM_V + vl0) = vs0; *(ATT_LAS bf16x8*)(Vl + (b) * SHM_V + vl1) = vs1; } while (0)
  constexpr int NT = SEQ / 64;
  ATT_SLOAD(0); ATT_SWRITE(0); __syncthreads();
  for (int j = 0; j < NT; ++j) {
    const int b = j & 1;
    if (j + 1 < NT) ATT_SLOAD((j + 1) * 64);
    f32x16 p0, p1; float mn, al; bf16x8 pa0, pa1, pa2, pa3;
    qkt(p0, p1, Kl + b * SHM_K, qr, r32, hi);
    partialSM(p0, p1, m_reg, mn, al);
    if (__any(al < 1.f)) { if (hi == 0) al_l[r32] = al; asm volatile("s_waitcnt lgkmcnt(0)" ::: "memory");
#pragma unroll
      for (int d = 0; d < 4; ++d)
#pragma unroll
        for (int r = 0; r < 16; ++r) o[d][r] *= al_l[crow(r, hi)]; }
    finishSM(p0, p1, al, l_reg, pa0, pa1, pa2, pa3);
    pv_d0(o, vb0 + b * SHM_V, pa0, pa1, pa2, pa3);
    if (j + 1 < NT) ATT_SWRITE(b ^ 1);
    __syncthreads();
  }
  if (hi == 0) li_l[r32] = l_reg;
  asm volatile("s_waitcnt lgkmcnt(0)" ::: "memory");
  float rli[16];
#pragma unroll
  for (int r = 0; r < 16; ++r) rli[r] = __builtin_amdgcn_rcpf(li_l[crow(r, hi)]);
  bf16_t* Ow = Ob + (size_t)(wid * 32) * LDO;
#pragma unroll
  for (int r = 0; r < 16; ++r) { const int orow = crow(r, hi);
#pragma unroll
    for (int d0 = 0; d0 < 4; ++d0) { const float v = o[d0][r] * rli[r]; Ow[(size_t)orow * LDO + d0 * 32 + r32] = (bf16_t)(cvtpk(v, v) & 0xffffu); } }
#undef ATT_SLOAD
#undef ATT_SWRITE
}
}

constexpr int NWAVES = 8;
constexpr int M = 24576, DM = 4096, SEQ = 8192, NSEQ = 3, MP = 16384;
constexpr int DFF = 11008, NUP = 22016, NIN = 12032;
constexpr float RMS_EPS = 1e-6f;
constexpr size_t MiB = 1u << 20;
constexpr size_t WS_CTL = 0, CTL_ZERO_BYTES = 1 * MiB;
constexpr size_t WS_ROPE = 1 * MiB;
constexpr size_t WS_BPOOL = 4 * MiB, WS_BUQ = 6 * MiB, WS_BUKV = 12 * MiB, WS_BBP = 16 * MiB, WS_BBM = 32 * MiB, WS_BO = 48 * MiB, WS_BIN = 80 * MiB;
constexpr size_t WS_A = 176 * MiB;
constexpr size_t WS_B = 368 * MiB;
constexpr size_t WS_ZK = 536 * MiB;
constexpr size_t WS_ZG = 548 * MiB;
constexpr size_t WS_AO = 932 * MiB;
constexpr size_t WS_F = 1028 * MiB;
constexpr size_t WS_BOUT = 1220 * MiB;
constexpr size_t WS_END1 = 1316 * MiB;
constexpr size_t WS_BUP = 4 * MiB, WS_BDOWN = 176 * MiB, WS_H2 = 262 * MiB, WS_U = 454 * MiB, WS_ACT = 798 * MiB, WS_END2 = 970 * MiB;
constexpr size_t WS_NEED = WS_END1;
constexpr int CW_TMO = 0, CW_CODE = 1, CW_BAR = 4096;
constexpr int RING_OFF = 0, RING_BYTES = 131072;
constexpr int LDSCTL_OFF = RING_BYTES, MISC_OFF = LDSCTL_OFF + 320;
constexpr int LDS_BYTES = 147456;

#define GAS __attribute__((address_space(1)))
#define LAS __attribute__((address_space(3)))
typedef unsigned short bf16;
typedef unsigned v4u __attribute__((ext_vector_type(4)));
typedef unsigned v2u __attribute__((ext_vector_type(2)));
typedef float f32x4 __attribute__((ext_vector_type(4)));
typedef GAS unsigned gu32;
#define RLX_AGENT __ATOMIC_RELAXED, __HIP_MEMORY_SCOPE_AGENT
#define LDS_WAIT() asm volatile("s_waitcnt lgkmcnt(0)" ::: "memory")
#define VM_WAIT() asm volatile("s_waitcnt vmcnt(0)" ::: "memory")
__device__ __forceinline__ unsigned f2bf(float f) { unsigned u = __builtin_bit_cast(unsigned, f); return (u + 0x7fffu + ((u >> 16) & 1u)) >> 16; }
__device__ __forceinline__ unsigned pk2(float lo, float hi) { return f2bf(lo) | (f2bf(hi) << 16); }
__device__ __forceinline__ float bflo(unsigned w) { return __uint_as_float(w << 16); }
__device__ __forceinline__ float bfhi(unsigned w) { return __uint_as_float(w & 0xffff0000u); }
__device__ __forceinline__ void unpack8(const v4u w, float (&v)[8]) { v[0] = bflo(w.x); v[1] = bfhi(w.x); v[2] = bflo(w.y); v[3] = bfhi(w.y); v[4] = bflo(w.z); v[5] = bfhi(w.z); v[6] = bflo(w.w); v[7] = bfhi(w.w); }
__device__ __forceinline__ v4u pack8(const float (&v)[8]) { v4u w; w.x = pk2(v[0], v[1]); w.y = pk2(v[2], v[3]); w.z = pk2(v[4], v[5]); w.w = pk2(v[6], v[7]); return w; }
#define XB_TMO      128
#define XB_XCNT(j)  (256  + 64 * (j))
#define XB_XSUB(j)  (1280 + 64 * (j))
#define XB_XGEN(j)  (2304 + 64 * (j))
#define XB_TOP      3328
#define XB_TOPGEN   3392
#define XCD_BAR_WORDS 3456
#define XB_SPIN_CAP (1u << 18)

__device__ __forceinline__ unsigned xb_ld(unsigned* p)              { return __hip_atomic_load(p, __ATOMIC_RELAXED, __HIP_MEMORY_SCOPE_AGENT); }
__device__ __forceinline__ unsigned xb_add(unsigned* p, unsigned v) { return __hip_atomic_fetch_add(p, v, __ATOMIC_RELAXED, __HIP_MEMORY_SCOPE_AGENT); }
__device__ __forceinline__ unsigned xb_xcc_id() { return (unsigned)__builtin_amdgcn_s_getreg((3 << 11) | 20) & 0xFu; }
#define XB_SPIN(cond, bar) do { unsigned _sp = 0; while (cond) { __builtin_amdgcn_s_sleep(1); \
    if ((++_sp & 255u) == 0u) { if (xb_ld(&(bar)[XB_TMO])) break; if (_sp > XB_SPIN_CAP) { atomicAdd(&(bar)[XB_TMO], 1u); break; } } } } while (0)

struct XcdBarrier {
    unsigned* bar; unsigned x;
    volatile LAS unsigned* st;
};

__device__ __forceinline__ XcdBarrier xcd_barrier_post(unsigned* bar, volatile LAS unsigned* st) {
    XcdBarrier b; b.bar = bar; b.x = xb_xcc_id(); b.st = st;
    if (threadIdx.x == 0) (void)xb_add(&bar[XB_XCNT(b.x)], 1u);
    return b;
}
__device__ __forceinline__ void xcd_barrier_complete(unsigned* bar, unsigned x, unsigned& nloc, unsigned& nx) {
    const unsigned G = gridDim.x * gridDim.y * gridDim.z;
    unsigned sum, cnt, mine, sp = 0u;
    for (;;) {
        sum = 0u; cnt = 0u; mine = 0u;
#pragma unroll
        for (unsigned j = 0; j < 16; ++j) { const unsigned c = xb_ld(&bar[XB_XCNT(j)]); sum += c; cnt += (c > 0u) ? 1u : 0u; mine = (j == x) ? c : mine; }
        if (sum == G) break;
        __builtin_amdgcn_s_sleep(1);
        if ((++sp & 255u) == 0u) { if (xb_ld(&bar[XB_TMO])) break; if (sp > XB_SPIN_CAP) { atomicAdd(&bar[XB_TMO], 1u); break; } }
    }
    nloc = mine > 0u ? mine : 1u; nx = cnt > 0u ? cnt : 1u;
}

__device__ __forceinline__ void xcd_barrier(const XcdBarrier& b) {
    asm volatile("s_waitcnt vmcnt(0)" ::: "memory");
    __syncthreads();
    if (threadIdx.x == 0) {
        unsigned* bar = b.bar;
        __builtin_amdgcn_s_waitcnt(0);
        unsigned nloc = b.st[0], nx = b.st[1];
        if (nloc == 0u) { xcd_barrier_complete(bar, b.x, nloc, nx); b.st[0] = nloc; b.st[1] = nx; }
        const unsigned old = xb_add(&bar[XB_XSUB(b.x)], 1u);
        const unsigned gen = old / nloc;
        if (old + 1u == (gen + 1u) * nloc) {
            __builtin_amdgcn_fence(__ATOMIC_RELEASE, "agent");
            asm volatile("s_waitcnt vmcnt(0)" ::: "memory");
            const unsigned og = xb_add(&bar[XB_TOP], 1u);
            const unsigned tg = og / nx;
            if (og + 1u == (tg + 1u) * nx) xb_add(&bar[XB_TOPGEN], 1u);
            else XB_SPIN(xb_ld(&bar[XB_TOPGEN]) == tg, bar);
            __builtin_amdgcn_fence(__ATOMIC_ACQUIRE, "agent");
            xb_add(&bar[XB_XGEN(b.x)], 1u);
            asm volatile("s_waitcnt vmcnt(0)" ::: "memory");
        } else {
            XB_SPIN(xb_ld(&bar[XB_XGEN(b.x)]) == gen, bar);
            __builtin_amdgcn_fence(__ATOMIC_ACQUIRE, "agent");
            asm volatile("s_waitcnt vmcnt(0)" ::: "memory");
        }
    }
    __syncthreads();
}

__device__ __forceinline__ float wave_sum(float v) {
#pragma unroll
    for (int o = 1; o < 64; o <<= 1) v += __shfl_xor(v, o);
    return v;
}
__device__ __forceinline__ void tr_item(const float* W, int N, bf16* WT, int ldt, int k0, int n0, int drow0, LAS float* scr, int lane) {
#pragma unroll 8
    for (int i = 0; i < 32; ++i) { const int kk = 2 * i + (lane >> 5); scr[kk * 33 + (lane & 31)] = W[(size_t)(k0 + kk) * N + n0 + (lane & 31)]; }
    LDS_WAIT(); asm volatile("" ::: "memory");
    const int c = lane & 7;
#pragma unroll
    for (int j = 0; j < 4; ++j) { const int n = (lane >> 3) + 8 * j; const LAS float* s = scr + (8 * c) * 33 + n;
        v4u o; o.x = pk2(s[0 * 33], s[1 * 33]); o.y = pk2(s[2 * 33], s[3 * 33]); o.z = pk2(s[4 * 33], s[5 * 33]); o.w = pk2(s[6 * 33], s[7 * 33]);
        *(GAS v4u*)(WT + (size_t)(drow0 + n) * ldt + k0 + 8 * c) = o; }
    LDS_WAIT(); asm volatile("" ::: "memory");
}
__device__ __forceinline__ void rms_row_4096(const float* xrow, const float* gain, bf16* orow, int lane) {
    const GAS f32x4* xr = (const GAS f32x4*)xrow + lane; const GAS f32x4* gr = (const GAS f32x4*)gain + lane;
    f32x4 v[16]; float s = 0.f;
#pragma unroll
    for (int j = 0; j < 16; ++j) { v[j] = xr[64 * j]; s += (v[j].x * v[j].x + v[j].y * v[j].y) + (v[j].z * v[j].z + v[j].w * v[j].w); }
    const float r = 1.0f / sqrtf(wave_sum(s) * (1.f / 4096.f) + RMS_EPS);
    GAS v2u* o8 = (GAS v2u*)orow + lane;
#pragma unroll
    for (int j = 0; j < 16; ++j) { const f32x4 g = gr[64 * j]; v2u w; w.x = pk2(v[j].x * r * g.x, v[j].y * r * g.y); w.y = pk2(v[j].z * r * g.z, v[j].w * r * g.w); o8[64 * j] = w; }
}
__device__ __forceinline__ void sincos_d(double a, double& s, double& c) {
    const double TWO_PI = 6.283185307179586476925286766559;
    const double n = __builtin_rint(a / TWO_PI); const double x = a - n * TWO_PI;
    const double x2 = x * x; double ts = 1.0, tc = 1.0; double ss = 1.0, cs = 1.0;
#pragma unroll
    for (int k = 1; k <= 14; ++k) { tc *= -x2 / (double)((2 * k - 1) * (2 * k)); cs += tc; ts *= -x2 / (double)((2 * k) * (2 * k + 1)); ss += ts; }
    s = x * ss; c = cs;
}

#ifndef PHM
#define PHM 0x3ff
#endif
typedef const __attribute__((address_space(4))) unsigned char* kptr_t;
__device__ __forceinline__ kptr_t karg() { kptr_t p = (kptr_t)__builtin_amdgcn_kernarg_segment_ptr(); asm volatile("" : "+s"(p)); return p; }
#define KIN(i) (*(const float* const __attribute__((address_space(4)))*)(kp + 8 * (i)))
#define KOUT() (*(float* const __attribute__((address_space(4)))*)(kp + 8 * 20))
#define KWS() (*(unsigned char* const __attribute__((address_space(4)))*)(kp + 8 * 21))
struct Args { const float* in[20]; float* out; unsigned char* ws; };
__global__ void __launch_bounds__(NWAVES * 64, 2) fwd_kernel(Args args) {
    extern __shared__ __attribute__((aligned(16))) unsigned char lds_raw[];
    LAS unsigned char* lds = (LAS unsigned char*)lds_raw;
    volatile LAS unsigned* MISC = (volatile LAS unsigned*)(lds + MISC_OFF);
    const int tid = threadIdx.x, lane = tid & 63, wave = __builtin_amdgcn_readfirstlane(tid >> 6);
    const int G = gridDim.x, bx = blockIdx.x;
    const int vcu = (G % 8 == 0) ? (bx % 8) * (G / 8) + bx / 8 : bx;
    gu32* ctl = (gu32*)(args.ws + WS_CTL);
    for (int u = tid; u < (LDS_BYTES - LDSCTL_OFF) / 4; u += NWAVES * 64) ((LAS unsigned*)(lds + LDSCTL_OFF))[u] = 0u;
    __syncthreads();
    XcdBarrier bar = xcd_barrier_post((unsigned*)(ctl + CW_BAR), MISC + 8);
#define GRID_BAR() xcd_barrier(bar)
    const int gw = vcu * NWAVES + wave, NGW = G * NWAVES;
    const int gt = vcu * (NWAVES * 64) + tid, NGT = G * NWAVES * 64;
    LAS float* scr = (LAS float*)(lds + RING_OFF + wave * 16384);

#if (PHM >> 0) & 1
    {
        kptr_t kp = karg(); unsigned char* ws = KWS();
        const float* x_prompt = KIN(0); const float* x_sample = KIN(1); const float* norm_mix_gain = KIN(2); const float* w_in = KIN(3); const float* pool_w = KIN(4);
        const float* w_uq = KIN(7); const float* w_ukv = KIN(9); const float* w_bp = KIN(12); const float* w_bm = KIN(13); const float* w_o = KIN(14);
        float* ropec = (float*)(ws + WS_ROPE); float* ropes = ropec + SEQ * 32;
        bf16* Bpool = (bf16*)(ws + WS_BPOOL); bf16* Buq = (bf16*)(ws + WS_BUQ); bf16* Bukv = (bf16*)(ws + WS_BUKV); bf16* Bbp = (bf16*)(ws + WS_BBP);
        bf16* Bbm = (bf16*)(ws + WS_BBM); bf16* Bo = (bf16*)(ws + WS_BO); bf16* Bin = (bf16*)(ws + WS_BIN); bf16* Hb = (bf16*)(ws + WS_A);
        constexpr int I_POOL = 512, I_UQ = 1536, I_UKV = 1024, I_BP = 4096, I_BM = 4096, I_O = 8192, I_IN = 23680;
        constexpr int NITEMS = I_POOL + I_UQ + I_UKV + I_BP + I_BM + I_O + I_IN;
        for (int it = gw; it < NITEMS; it += NGW) {
            int r = it;
            if (r < I_POOL) { const int g = r >> 7, q = r & 127; tr_item(pool_w + (size_t)g * 512 * 512, 512, Bpool, 512, 64 * (q >> 4), 32 * (q & 15), g * 512 + 32 * (q & 15), scr, lane); continue; } r -= I_POOL;
            if (r < I_UQ) { tr_item(w_uq, 3072, Buq, 1024, 64 * (r / 96), 32 * (r % 96), 32 * (r % 96), scr, lane); continue; } r -= I_UQ;
            if (r < I_UKV) { tr_item(w_ukv, 4096, Bukv, 512, 64 * (r / 128), 32 * (r % 128), 32 * (r % 128), scr, lane); continue; } r -= I_UKV;
            if (r < I_BP) { tr_item(w_bp, 4096, Bbp, 2048, 64 * (r / 128), 32 * (r % 128), 32 * (r % 128), scr, lane); continue; } r -= I_BP;
            if (r < I_BM) { tr_item(w_bm, 4096, Bbm, 2048, 64 * (r / 128), 32 * (r % 128), 32 * (r % 128), scr, lane); continue; } r -= I_BM;
            if (r < I_O) { tr_item(w_o, 4096, Bo, 4096, 64 * (r / 128), 32 * (r % 128), 32 * (r % 128), scr, lane); continue; } r -= I_O;
            { const int n0 = 32 * (r % 370); const int drow = (n0 < 3584) ? n0 : (n0 < 3648 ? 11776 + (n0 - 3584) : n0 - 64);
              tr_item(w_in, 11840, Bin, 4096, 64 * (r / 370), n0, drow, scr, lane); }
        }
        { GAS v4u* z = (GAS v4u*)(Bin + (size_t)11840 * 4096); const v4u zero = {0u, 0u, 0u, 0u};
          for (int i = gt; i < 192 * 4096 / 8; i += NGT) z[i] = zero; }
        for (int i = gt; i < SEQ * 32; i += NGT) { const int t = i >> 5, f = i & 31;
            const float inv = 1.0f / (float)exp2(13.287712379549449 * ((double)(2 * f) / 64.0));
            const float ang = (float)t * inv; double s, c; sincos_d((double)ang, s, c); ropec[i] = (float)c; ropes[i] = (float)s; }
        for (int m = gw; m < M; m += NGW) { const float* xr = (m < MP) ? x_prompt + (size_t)m * DM : x_sample + (size_t)(m - MP) * DM; rms_row_4096(xr, norm_mix_gain, Hb + (size_t)m * DM, lane); }
    }
    GRID_BAR();
#endif
#if (PHM >> 1) & 1
    {
        kptr_t kp = karg(); unsigned char* ws = KWS();
        bf16* Hb = (bf16*)(ws + WS_A); bf16* Bin = (bf16*)(ws + WS_BIN); bf16* ZA = (bf16*)(ws + WS_B); bf16* ZK = (bf16*)(ws + WS_ZK); bf16* ZG = (bf16*)(ws + WS_ZG);
        pg8::Gemm g{Hb, Bin, M, NIN, DM}; pg8::StaticOrder S; S.init(M, NIN, G, bx);
        pg8::EpiZ E{ZA, ZG, ZK};
        pg8::gemm_phase<pg8::EpiZ, pg8::StaticOrder, true, true>(lds + RING_OFF, g, S, E);
    }
    GRID_BAR();
#endif
#if (PHM >> 2) & 1
    {
        kptr_t kp = karg(); unsigned char* ws = KWS(); const float* q_a_gain = KIN(6); const float* kv_a_gain = KIN(8);
        bf16* ZA = (bf16*)(ws + WS_B); bf16* PAp = (bf16*)(ws + WS_A); bf16* CQN = PAp + (size_t)4 * M * 512; bf16* CKVN = CQN + (size_t)M * 1024;
    for (int m = gw; m < M; m += NGW) {
        const int t = m % SEQ; const bf16* zrow = ZA + (size_t)m * 3584;
#pragma unroll
        for (int g = 0; g < 4; ++g) {
            const int half = 1 << g; const int lo = (t - half < 0) ? 0 : t - half, hi = (t + half > SEQ) ? SEQ : t + half;
            float acc[8] = {0.f, 0.f, 0.f, 0.f, 0.f, 0.f, 0.f, 0.f}, self[8];
            for (int tt = lo; tt < hi; ++tt) { float v[8]; unpack8(*(const GAS v4u*)(zrow + (ptrdiff_t)(tt - t) * 3584 + g * 512 + lane * 8), v);
#pragma unroll
                for (int j = 0; j < 8; ++j) acc[j] += v[j]; }
            unpack8(*(const GAS v4u*)(zrow + g * 512 + lane * 8), self);
            const float cnt = (float)(hi - lo);
#pragma unroll
            for (int j = 0; j < 8; ++j) acc[j] = acc[j] / cnt - self[j];
            *(GAS v4u*)(PAp + ((size_t)g * M + m) * 512 + lane * 8) = pack8(acc);
        }
        { float a[8], b[8]; unpack8(*(const GAS v4u*)(zrow + 2048 + lane * 8), a); unpack8(*(const GAS v4u*)(zrow + 2560 + lane * 8), b);
          float s = 0.f;
#pragma unroll
          for (int j = 0; j < 8; ++j) s += a[j] * a[j] + b[j] * b[j];
          const float r = 1.0f / sqrtf(wave_sum(s) * (1.f / 1024.f) + RMS_EPS);
          const GAS f32x4* ga = (const GAS f32x4*)(q_a_gain + lane * 8); const GAS f32x4* gb = (const GAS f32x4*)(q_a_gain + 512 + lane * 8);
          const f32x4 ga0 = ga[0], ga1 = ga[1], gb0 = gb[0], gb1 = gb[1];
#pragma unroll
          for (int j = 0; j < 4; ++j) { a[j] *= r * ga0[j]; a[4 + j] *= r * ga1[j]; b[j] *= r * gb0[j]; b[4 + j] *= r * gb1[j]; }
          *(GAS v4u*)(CQN + (size_t)m * 1024 + lane * 8) = pack8(a); *(GAS v4u*)(CQN + (size_t)m * 1024 + 512 + lane * 8) = pack8(b); }
        { float a[8]; unpack8(*(const GAS v4u*)(zrow + 3072 + lane * 8), a);
          float s = 0.f;
#pragma unroll
          for (int j = 0; j < 8; ++j) s += a[j] * a[j];
          const float r = 1.0f / sqrtf(wave_sum(s) * (1.f / 512.f) + RMS_EPS);
          const GAS f32x4* ga = (const GAS f32x4*)(kv_a_gain + lane * 8); const f32x4 ga0 = ga[0], ga1 = ga[1];
#pragma unroll
          for (int j = 0; j < 4; ++j) { a[j] *= r * ga0[j]; a[4 + j] *= r * ga1[j]; }
          *(GAS v4u*)(CKVN + (size_t)m * 512 + lane * 8) = pack8(a); }
    }
    }
    GRID_BAR();
#endif
#if (PHM >> 3) & 1
    {
        kptr_t kp = karg(); unsigned char* ws = KWS(); const float* pool_scale = KIN(5);
        bf16* PAp = (bf16*)(ws + WS_A); bf16* CQN = PAp + (size_t)4 * M * 512; bf16* CKVN = CQN + (size_t)M * 1024;
        bf16* Bpool = (bf16*)(ws + WS_BPOOL); bf16* Buq = (bf16*)(ws + WS_BUQ); bf16* Bukv = (bf16*)(ws + WS_BUKV);
        bf16* AO = (bf16*)(ws + WS_AO); bf16* Qb = (bf16*)(ws + WS_B); bf16* KV = (bf16*)(ws + WS_F);
    {
        pg8::Gemm g{PAp, Bpool, 4 * M, 2048, 512}; pg8::PoolOrder S{G, bx};
        pg8::EpiPool E{AO, pool_scale};
        pg8::gemm_phase<pg8::EpiPool, pg8::PoolOrder, true, true>(lds + RING_OFF, g, S, E);
    }
    {
        pg8::Gemm g{CQN, Buq, M, 3072, 1024}; pg8::StaticOrder S; S.init(M, 3072, G, bx);
        pg8::EpiBf E{Qb, 3072};
        pg8::gemm_phase<pg8::EpiBf, pg8::StaticOrder, true, true>(lds + RING_OFF, g, S, E);
    }
    {
        pg8::Gemm g{CKVN, Bukv, M, 4096, 512}; pg8::StaticOrder S; S.init(M, 4096, G, bx);
        pg8::EpiBf E{KV, 4096};
        pg8::gemm_phase<pg8::EpiBf, pg8::StaticOrder, true, true>(lds + RING_OFF, g, S, E);
    }
    }
    GRID_BAR();
#endif
#if (PHM >> 4) & 1
    {
        kptr_t kp = karg(); unsigned char* ws = KWS(); const float* q_gain = KIN(10); const float* k_gain = KIN(11);
        const float* ropec = (const float*)(ws + WS_ROPE); const float* ropes = ropec + SEQ * 32;
        bf16* Qb = (bf16*)(ws + WS_B); bf16* KV = (bf16*)(ws + WS_F); bf16* ZK = (bf16*)(ws + WS_ZK); bf16* Kb = (bf16*)(ws + WS_A);
    for (int m = gw; m < M; m += NGW) {
        const int t = m % SEQ, h = lane >> 2, s4 = lane & 3;
        float cs[8], sn[8];
        { const GAS f32x4* cp = (const GAS f32x4*)(ropec + t * 32 + 8 * s4); const GAS f32x4* sp = (const GAS f32x4*)(ropes + t * 32 + 8 * s4);
          const f32x4 c0 = cp[0], c1 = cp[1], s0 = sp[0], s1 = sp[1];
#pragma unroll
          for (int j = 0; j < 4; ++j) { cs[j] = c0[j]; cs[4 + j] = c1[j]; sn[j] = s0[j]; sn[4 + j] = s1[j]; } }
#pragma unroll
        for (int which = 0; which < 2; ++which) {
            float v[6][8];
            const float* gain = which ? k_gain : q_gain;
            if (which == 0) { const bf16* qp = Qb + (size_t)m * 3072 + h * 192;
#pragma unroll
                for (int c = 0; c < 4; ++c) unpack8(*(const GAS v4u*)(qp + 32 * s4 + 8 * c), v[c]);
                unpack8(*(const GAS v4u*)(qp + 128 + 8 * s4), v[4]); unpack8(*(const GAS v4u*)(qp + 160 + 8 * s4), v[5]); }
            else { const bf16* kp = KV + (size_t)m * 4096 + h * 256; const bf16* rp = ZK + (size_t)m * 256;
#pragma unroll
                for (int c = 0; c < 4; ++c) unpack8(*(const GAS v4u*)(kp + 32 * s4 + 8 * c), v[c]);
                unpack8(*(const GAS v4u*)(rp + 8 * s4), v[4]); unpack8(*(const GAS v4u*)(rp + 32 + 8 * s4), v[5]); }
            float ss = 0.f;
#pragma unroll
            for (int c = 0; c < 6; ++c)
#pragma unroll
                for (int j = 0; j < 8; ++j) ss += v[c][j] * v[c][j];
            ss += __shfl_xor(ss, 1); ss += __shfl_xor(ss, 2);
            const float r = 1.0f / sqrtf(ss * (1.f / 192.f) + RMS_EPS);
#pragma unroll
            for (int c = 0; c < 6; ++c) { const int d = (c < 4) ? 32 * s4 + 8 * c : (c == 4 ? 128 + 8 * s4 : 160 + 8 * s4);
                const GAS f32x4* gp = (const GAS f32x4*)(gain + d); const f32x4 g0 = gp[0], g1 = gp[1];
#pragma unroll
                for (int j = 0; j < 4; ++j) { v[c][j] *= r * g0[j]; v[c][4 + j] *= r * g1[j]; } }
#pragma unroll
            for (int j = 0; j < 8; ++j) { const float x1 = v[4][j], x2 = v[5][j]; v[4][j] = x1 * cs[j] - x2 * sn[j]; v[5][j] = x2 * cs[j] + x1 * sn[j]; }
            bf16* op = (which == 0) ? Qb + (size_t)m * 3072 + h * 192 : Kb + (size_t)m * 3072 + h * 192;
#pragma unroll
            for (int c = 0; c < 4; ++c) *(GAS v4u*)(op + 32 * s4 + 8 * c) = pack8(v[c]);
            *(GAS v4u*)(op + 128 + 8 * s4) = pack8(v[4]); *(GAS v4u*)(op + 160 + 8 * s4) = pack8(v[5]);
        }
    }
    }
    GRID_BAR();
#endif
#if (PHM >> 5) & 1
    {
        kptr_t kp = karg(); unsigned char* ws = KWS();
        bf16* Qb = (bf16*)(ws + WS_B); bf16* KV = (bf16*)(ws + WS_F); bf16* Kb = (bf16*)(ws + WS_A); bf16* BOUT = (bf16*)(ws + WS_BOUT);
        for (int i = 0;; ++i) {
            int pair, qb;
            if (G == 256) { pair = i * 8 + (bx & 7); qb = bx >> 3; if (pair >= 48) break; }
            else { const int L = i * G + bx; if (L >= 48 * 32) break; pair = L >> 5; qb = L & 31; }
            const int sq = pair >> 4, h = pair & 15; const size_t tok0 = (size_t)sq * SEQ + (size_t)qb * 256;
            att::attn_unit(Qb + tok0 * 3072 + h * 192, Kb + (size_t)sq * SEQ * 3072 + h * 192, KV + (size_t)sq * SEQ * 4096 + h * 256 + 128, BOUT + tok0 * 2048 + h * 128, lds + RING_OFF);
        }
    }
    GRID_BAR();
#endif
#if (PHM >> 6) & 1
    {
        kptr_t kp = karg(); unsigned char* ws = KWS();
        bf16* AO = (bf16*)(ws + WS_AO); bf16* BOUT = (bf16*)(ws + WS_BOUT); bf16* Bbp = (bf16*)(ws + WS_BBP); bf16* Bbm = (bf16*)(ws + WS_BBM);
        bf16* Tb = (bf16*)(ws + WS_A); bf16* Mb = (bf16*)(ws + WS_F); bf16* ZG = (bf16*)(ws + WS_ZG);
    {
        pg8::Gemm g{AO, Bbp, M, 4096, 2048}; pg8::StaticOrder S; S.init(M, 4096, G, bx);
        pg8::EpiGateA E{Tb, ZG};
        pg8::gemm_phase<pg8::EpiGateA, pg8::StaticOrder, true, true>(lds + RING_OFF, g, S, E);
    }
    {
        pg8::Gemm g{BOUT, Bbm, M, 4096, 2048}; pg8::StaticOrder S; S.init(M, 4096, G, bx);
        pg8::EpiGateB E{Tb, Mb, ZG};
        pg8::gemm_phase<pg8::EpiGateB, pg8::StaticOrder, true, true>(lds + RING_OFF, g, S, E);
    }
    }
    GRID_BAR();
#endif
#if (PHM >> 7) & 1
    {
        kptr_t kp = karg(); unsigned char* ws = KWS(); const float* x_prompt = KIN(0); const float* x_sample = KIN(1); float* out = KOUT();
        bf16* Mb = (bf16*)(ws + WS_F); bf16* Bo = (bf16*)(ws + WS_BO);
        pg8::Gemm g{Mb, Bo, M, 4096, 4096}; pg8::StaticOrder S; S.init(M, 4096, G, bx);
        pg8::EpiResX E{x_prompt, x_sample, out};
        pg8::gemm_phase<pg8::EpiResX, pg8::StaticOrder, true, true>(lds + RING_OFF, g, S, E);
    }
    GRID_BAR();
#endif
#if (PHM >> 8) & 1
    {
        kptr_t kp = karg(); unsigned char* ws = KWS(); const float* norm_ffn_gain = KIN(15); const float* w_up = KIN(16); const float* w_down = KIN(19); float* out = KOUT();
        bf16* Bup = (bf16*)(ws + WS_BUP); bf16* Bdown = (bf16*)(ws + WS_BDOWN); bf16* H2 = (bf16*)(ws + WS_H2);
        constexpr int I_UP = 64 * 688, I_DOWN = 172 * 128;
        for (int it = gw; it < I_UP + I_DOWN; it += NGW) {
            int r = it;
            if (r < I_UP) { const int n0 = 32 * (r % 688); const int nn = (n0 < DFF) ? n0 : n0 - DFF; const int drow = 256 * (nn >> 7) + (nn & 127) + ((n0 < DFF) ? 0 : 128);
                tr_item(w_up, NUP, Bup, 4096, 64 * (r / 688), n0, drow, scr, lane); continue; } r -= I_UP;
            tr_item(w_down, 4096, Bdown, DFF, 64 * (r / 128), 32 * (r % 128), 32 * (r % 128), scr, lane);
        }
        for (int m = gw; m < M; m += NGW) rms_row_4096(out + (size_t)m * DM, norm_ffn_gain, H2 + (size_t)m * DM, lane);
    }
    GRID_BAR();
#endif
#if (PHM >> 9) & 1
#pragma unroll
    for (int sq = 0; sq < NSEQ; ++sq) {
        {
            kptr_t kp = karg(); unsigned char* ws = KWS(); bf16* H2 = (bf16*)(ws + WS_H2); bf16* Bup = (bf16*)(ws + WS_BUP); bf16* Ub = (bf16*)(ws + WS_U);
            pg8::Gemm g{H2 + (size_t)sq * SEQ * DM, Bup, SEQ, NUP, DM}; pg8::StaticOrder S; S.init(SEQ, NUP, G, bx);
            pg8::EpiBf E{Ub, NUP};
            pg8::gemm_phase<pg8::EpiBf, pg8::StaticOrder, true, true>(lds + RING_OFF, g, S, E);
        }
        GRID_BAR();
        {
        kptr_t kp = karg(); unsigned char* ws = KWS(); const float* conv_w = KIN(17); const float* conv_b = KIN(18); bf16* Ub = (bf16*)(ws + WS_U); bf16* ACT = (bf16*)(ws + WS_ACT);
        for (int idx = gt; idx < SEQ * 1376; idx += NGT) {
            const int t = idx / 1376, ch = idx % 1376, tile = ch >> 4, j8 = (ch & 15) * 8, c = tile * 128 + j8;
            const bf16* up = Ub + (size_t)t * NUP + tile * 256 + j8;
            float gm[8], g0[8], gp[8], vm[8], v0[8], vp[8];
            const v4u zero = {0u, 0u, 0u, 0u};
            unpack8(t > 0 ? *(const GAS v4u*)(up - NUP) : zero, gm); unpack8(*(const GAS v4u*)(up), g0); unpack8(t < SEQ - 1 ? *(const GAS v4u*)(up + NUP) : zero, gp);
            unpack8(t > 0 ? *(const GAS v4u*)(up - NUP + 128) : zero, vm); unpack8(*(const GAS v4u*)(up + 128), v0); unpack8(t < SEQ - 1 ? *(const GAS v4u*)(up + NUP + 128) : zero, vp);
            float a[8];
#pragma unroll
            for (int j = 0; j < 8; ++j) {
                const float gg = gm[j] * conv_w[c + j] + g0[j] * conv_w[NUP + c + j] + gp[j] * conv_w[2 * NUP + c + j] + conv_b[c + j];
                const float vv = vm[j] * conv_w[DFF + c + j] + v0[j] * conv_w[NUP + DFF + c + j] + vp[j] * conv_w[2 * NUP + DFF + c + j] + conv_b[DFF + c + j];
                a[j] = gg * __builtin_amdgcn_rcpf(1.0f + __expf(-gg)) * vv; }
            *(GAS v4u*)(ACT + (size_t)t * DFF + c) = pack8(a);
        }
        }
        GRID_BAR();
        {
            kptr_t kp = karg(); unsigned char* ws = KWS(); float* out = KOUT(); bf16* ACT = (bf16*)(ws + WS_ACT); bf16* Bdown = (bf16*)(ws + WS_BDOWN);
            pg8::Gemm g{ACT, Bdown, SEQ, 4096, DFF}; pg8::StaticOrder S; S.init(SEQ, 4096, G, bx);
            pg8::EpiResOut E{out + (size_t)sq * SEQ * DM};
            pg8::gemm_phase<pg8::EpiResOut, pg8::StaticOrder, true, true>(lds + RING_OFF, g, S, E);
        }
    }
#endif
}

extern "C" void kernel_launch(void* const* d_in, const int* in_sizes, int n_in, void* d_out, int out_size, void* d_ws, size_t ws_size, hipStream_t stream) {
    static int grid = 0;
    if (grid == 0) {
        if (n_in != 20 || in_sizes[0] != MP * DM || in_sizes[1] != (M - MP) * DM || out_size != M * DM || ws_size < WS_NEED) {
            fprintf(stderr, "kernel_launch: shape mismatch (n_in %d, in0 %d, in1 %d, out %d, ws %zu, need %zu); nothing launched\n", n_in, n_in > 0 ? in_sizes[0] : -1, n_in > 1 ? in_sizes[1] : -1, out_size, ws_size, (size_t)WS_NEED); grid = -1; return; }
        int dev = 0, cus = 0, per_cu = 0;
        if (hipGetDevice(&dev) != hipSuccess || hipDeviceGetAttribute(&cus, hipDeviceAttributeMultiprocessorCount, dev) != hipSuccess) { fprintf(stderr, "kernel_launch: device query failed\n"); grid = -1; return; }
        if (hipFuncSetAttribute((const void*)fwd_kernel, hipFuncAttributeMaxDynamicSharedMemorySize, LDS_BYTES) != hipSuccess) { fprintf(stderr, "kernel_launch: hipFuncSetAttribute failed\n"); grid = -1; return; }
        if (hipOccupancyMaxActiveBlocksPerMultiprocessor(&per_cu, (const void*)fwd_kernel, NWAVES * 64, LDS_BYTES) != hipSuccess || per_cu < 1)
            fprintf(stderr, "kernel_launch: note: occupancy query reports %d workgroups per CU\n", per_cu);
        (void)hipGetLastError();
        grid = cus;
    }
    if (grid < 0) return;
    if (hipMemsetAsync((char*)d_ws + WS_CTL, 0, CTL_ZERO_BYTES, stream) != hipSuccess) { fprintf(stderr, "kernel_launch: memset failed\n"); return; }
    Args a{};
    for (int i = 0; i < 20; ++i) a.in[i] = (const float*)d_in[i];
    a.out = (float*)d_out; a.ws = (unsigned char*)d_ws;
    hipLaunchKernelGGL(fwd_kernel, dim3(grid), dim3(NWAVES * 64), LDS_BYTES, stream, a);
    const hipError_t le = hipPeekAtLastError();
    if (le != hipSuccess) fprintf(stderr, "kernel_launch: launch failed: %s\n", hipGetErrorName(le));
}
```

```cpp
#include <hip/hip_runtime.h>
#include <cstdio>
#include <cstdint>
namespace pg8 {
#define PG8_LAS __attribute__((address_space(3)))
typedef unsigned short bf16_t;
typedef short bf16x8 __attribute__((ext_vector_type(8)));
typedef float f32x4 __attribute__((ext_vector_type(4)));
typedef unsigned u32x4 __attribute__((ext_vector_type(4)));
constexpr int BM = 256, BK = 64, HALF = 128, HTB = HALF * BK * 2  , STAGE_BYTES = 8 * HTB, NXCD = 8, WGM = 8;

__host__ __device__ __forceinline__ int lds_byte(int r, int c) { const int st = (r >> 4) * 2 + (c >> 5), rr = r & 15, cc = c & 31, ob = rr * 64 + cc * 2; return st * 1024 + (ob ^ (((ob >> 9) & 1) << 5)); }
__host__ __device__ __forceinline__ void stage_rc(int b, int& R, int& C) { const int st = b / 1024, sb = b % 1024, swz = sb ^ (((sb >> 9) & 1) << 5); R = (st >> 1) * 16 + swz / 64; C = (st & 1) * 32 + (swz % 64) / 2; }
__host__ __device__ __forceinline__ int perm32(int rho) { const int n = rho >> 4, i = rho & 15; return 8 * (i >> 2) + 4 * n + (i & 3); }

struct Unit { int pm, pn; };
struct Gemm { const bf16_t* A; const bf16_t* Bt; int M, N, K; };

struct StaticOrder {
    int nM, nN, nwg, G, c;
    __host__ __device__ void init(int M, int N, int G_, int c_) { nM = M / BM; nN = N / BM; nwg = nM * nN; G = G_; c = c_; }
    __host__ __device__ bool next(int i, Unit& u) const {
        const long L = (long)i * G + c; if (L >= nwg) return false;
        int wgid = (int)L; { const int q = nwg / NXCD, r = nwg % NXCD, xcd = wgid % NXCD, off = wgid / NXCD; wgid = (xcd < r ? xcd * (q + 1) : r * (q + 1) + (xcd - r) * q) + off; }
        const int nig = WGM * nN, gid = wgid / nig, fm = gid * WGM, gsz = (nM - fm) < WGM ? (nM - fm) : WGM;
        u.pm = fm + ((wgid % nig) % gsz); u.pn = (wgid % nig) / gsz; return true;
    }
    __device__ __forceinline__ void a_ready(const Unit&) const {}
    __device__ __forceinline__ void done(const Unit&) const {}
};
__device__ __forceinline__ unsigned cvt_pk_bf16(float lo, float hi) { unsigned r; asm volatile("v_cvt_pk_bf16_f32 %0, %1, %2" : "=v"(r) : "v"(lo), "v"(hi)); return r; }
typedef float f32x2 __attribute__((ext_vector_type(2)));

struct PoolOrder {
    int G, c;
    __device__ __forceinline__ bool next(int i, Unit& u) const {
        const int L = i * G + c; if (L >= 768) return false;
        const int g = L / 192, r = L % 192; u.pm = g * 96 + (r >> 1); u.pn = g * 2 + (r & 1); return true;
    }
    __device__ __forceinline__ void a_ready(const Unit&) const {}
    __device__ __forceinline__ void done(const Unit&) const {}
};
__device__ __forceinline__ void st8(bf16_t* p, const f32x4 v0, const f32x4 v1) {
    u32x4 w; w.x = cvt_pk_bf16(v0[0], v0[1]); w.y = cvt_pk_bf16(v0[2], v0[3]); w.z = cvt_pk_bf16(v1[0], v1[1]); w.w = cvt_pk_bf16(v1[2], v1[3]);
    *(u32x4*)p = w;
}
__device__ __forceinline__ void ld8(const bf16_t* p, f32x4& v0, f32x4& v1) {
    const u32x4 w = *(const u32x4*)p;
    v0[0] = __uint_as_float(w.x << 16); v0[1] = __uint_as_float(w.x & 0xffff0000u); v0[2] = __uint_as_float(w.y << 16); v0[3] = __uint_as_float(w.y & 0xffff0000u);
    v1[0] = __uint_as_float(w.z << 16); v1[1] = __uint_as_float(w.z & 0xffff0000u); v1[2] = __uint_as_float(w.w << 16); v1[3] = __uint_as_float(w.w & 0xffff0000u);
}
__device__ __forceinline__ float sigmoidf_(float x) { return __builtin_amdgcn_rcpf(1.0f + __expf(-x)); }
__device__ __forceinline__ f32x4 sig4(const f32x4 x) { f32x4 r; r[0] = sigmoidf_(x[0]); r[1] = sigmoidf_(x[1]); r[2] = sigmoidf_(x[2]); r[3] = sigmoidf_(x[3]); return r; }

struct EpiBf {
    static constexpr bool PERM = true, AFTER_DRAIN = false;
    bf16_t* O; int ldc;
    __device__ __forceinline__ void operator()(const f32x4 (&acc)[2][2][4][2], const Unit& u, int wr, int wc, int fr, int fq) const {
        const int row0 = u.pm * BM + wr * 64 + fr, col0 = u.pn * BM + wc * 32 + 8 * fq;
#pragma unroll
        for (int ai = 0; ai < 2; ++ai)
#pragma unroll
            for (int m = 0; m < 4; ++m) { bf16_t* rowp = O + (size_t)(row0 + ai * HALF + m * 16) * ldc + col0;
#pragma unroll
                for (int bj = 0; bj < 2; ++bj) st8(rowp + bj * HALF, acc[ai][bj][m][0], acc[ai][bj][m][1]); }
    }
};
struct EpiZ {
    static constexpr bool PERM = true, AFTER_DRAIN = false;
    bf16_t *ZA, *ZG, *ZK;
    __device__ __forceinline__ void operator()(const f32x4 (&acc)[2][2][4][2], const Unit& u, int wr, int wc, int fr, int fq) const {
        bf16_t* base; int ldc, colt;
        if (u.pn < 14) { base = ZA; ldc = 3584; colt = u.pn * 256; } else if (u.pn < 46) { base = ZG; ldc = 8192; colt = (u.pn - 14) * 256; } else { base = ZK; ldc = 256; colt = 0; }
        const int row0 = u.pm * BM + wr * 64 + fr, col0 = colt + wc * 32 + 8 * fq;
#pragma unroll
        for (int ai = 0; ai < 2; ++ai)
#pragma unroll
            for (int m = 0; m < 4; ++m) { bf16_t* rowp = base + (size_t)(row0 + ai * HALF + m * 16) * ldc + col0;
#pragma unroll
                for (int bj = 0; bj < 2; ++bj) st8(rowp + bj * HALF, acc[ai][bj][m][0], acc[ai][bj][m][1]); }
    }
};
struct EpiPool {
    static constexpr bool PERM = true, AFTER_DRAIN = false;
    bf16_t* O; const float* scale;
    __device__ __forceinline__ void operator()(const f32x4 (&acc)[2][2][4][2], const Unit& u, int wr, int wc, int fr, int fq) const {
        const int g = u.pm / 96, row0 = (u.pm % 96) * BM + wr * 64 + fr, col0 = g * 512 + (u.pn & 1) * 256 + wc * 32 + 8 * fq;
        f32x4 sv[2][2];
#pragma unroll
        for (int bj = 0; bj < 2; ++bj)
#pragma unroll
            for (int n = 0; n < 2; ++n) sv[bj][n] = *(const f32x4*)(scale + col0 + bj * HALF + 4 * n);
#pragma unroll
        for (int ai = 0; ai < 2; ++ai)
#pragma unroll
            for (int m = 0; m < 4; ++m) { bf16_t* rowp = O + (size_t)(row0 + ai * HALF + m * 16) * 2048 + col0;
#pragma unroll
                for (int bj = 0; bj < 2; ++bj) st8(rowp + bj * HALF, acc[ai][bj][m][0] * sv[bj][0], acc[ai][bj][m][1] * sv[bj][1]); }
    }
};
struct EpiGateA {
    static constexpr bool PERM = true, AFTER_DRAIN = false;
    bf16_t* T; const bf16_t* ZG;
    __device__ __forceinline__ void operator()(const f32x4 (&acc)[2][2][4][2], const Unit& u, int wr, int wc, int fr, int fq) const {
        const int row0 = u.pm * BM + wr * 64 + fr, col0 = u.pn * BM + wc * 32 + 8 * fq;
#pragma unroll
        for (int ai = 0; ai < 2; ++ai)
#pragma unroll
            for (int m = 0; m < 4; ++m) { const size_t r = (size_t)(row0 + ai * HALF + m * 16);
#pragma unroll
                for (int bj = 0; bj < 2; ++bj) { f32x4 g0, g1; ld8(ZG + r * 8192 + col0 + bj * HALF, g0, g1);
                    st8(T + r * 4096 + col0 + bj * HALF, acc[ai][bj][m][0] * sig4(g0), acc[ai][bj][m][1] * sig4(g1)); } }
    }
};
struct EpiGateB {
    static constexpr bool PERM = true, AFTER_DRAIN = false;
    const bf16_t* T; bf16_t* Mo; const bf16_t* ZG;
    __device__ __forceinline__ void operator()(const f32x4 (&acc)[2][2][4][2], const Unit& u, int wr, int wc, int fr, int fq) const {
        const int row0 = u.pm * BM + wr * 64 + fr, col0 = u.pn * BM + wc * 32 + 8 * fq;
#pragma unroll
        for (int ai = 0; ai < 2; ++ai)
#pragma unroll
            for (int m = 0; m < 4; ++m) { const size_t r = (size_t)(row0 + ai * HALF + m * 16);
#pragma unroll
                for (int bj = 0; bj < 2; ++bj) { f32x4 g0, g1, t0, t1; ld8(ZG + r * 8192 + 4096 + col0 + bj * HALF, g0, g1); ld8(T + r * 4096 + col0 + bj * HALF, t0, t1);
                    st8(Mo + r * 4096 + col0 + bj * HALF, t0 + acc[ai][bj][m][0] * sig4(g0), t1 + acc[ai][bj][m][1] * sig4(g1)); } }
    }
};
struct EpiResX {
    static constexpr bool PERM = false, AFTER_DRAIN = false;
    const float *xp, *xs; float* out;
    __device__ __forceinline__ void operator()(const f32x4 (&acc)[2][2][4][2], const Unit& u, int wr, int wc, int fr, int fq) const {
        const float* xb = (u.pm < 64) ? xp + (size_t)u.pm * BM * 4096 : xs + (size_t)(u.pm - 64) * BM * 4096;
        float* ob = out + (size_t)u.pm * BM * 4096;
        const int rl0 = wr * 64 + fr, col0 = u.pn * BM + wc * 32 + 4 * fq;
#pragma unroll
        for (int ai = 0; ai < 2; ++ai)
#pragma unroll
            for (int m = 0; m < 4; ++m) { const size_t off = (size_t)(rl0 + ai * HALF + m * 16) * 4096 + col0;
#pragma unroll
                for (int bj = 0; bj < 2; ++bj)
#pragma unroll
                    for (int n = 0; n < 2; ++n) { const f32x4 xv = *(const f32x4*)(xb + off + bj * HALF + n * 16); *(f32x4*)(ob + off + bj * HALF + n * 16) = xv + acc[ai][bj][m][n]; }
                asm volatile("" ::: "memory"); }
    }
};
struct EpiResOut {
    static constexpr bool PERM = false, AFTER_DRAIN = false;
    float* out;
    __device__ __forceinline__ void operator()(const f32x4 (&acc)[2][2][4][2], const Unit& u, int wr, int wc, int fr, int fq) const {
        float* ob = out + (size_t)u.pm * BM * 4096;
        const int rl0 = wr * 64 + fr, col0 = u.pn * BM + wc * 32 + 4 * fq;
#pragma unroll
        for (int ai = 0; ai < 2; ++ai)
#pragma unroll
            for (int m = 0; m < 4; ++m) { const size_t off = (size_t)(rl0 + ai * HALF + m * 16) * 4096 + col0;
#pragma unroll
                for (int bj = 0; bj < 2; ++bj)
#pragma unroll
                    for (int n = 0; n < 2; ++n) { const f32x4 xv = *(const f32x4*)(ob + off + bj * HALF + n * 16); *(f32x4*)(ob + off + bj * HALF + n * 16) = xv + acc[ai][bj][m][n]; }
                asm volatile("" ::: "memory"); }
    }
};

typedef unsigned u32x2 __attribute__((ext_vector_type(2)));
__device__ __forceinline__ float silu_(float x) { return x * __builtin_amdgcn_rcpf(1.0f + __builtin_amdgcn_exp2f(-1.4426950408889634f * x)); }
constexpr int CONV_SLICE_BYTES = 66 * 32;
__device__ __forceinline__ void st4(bf16_t* p, const f32x4 v) { u32x2 w; w.x = cvt_pk_bf16(v[0], v[1]); w.y = cvt_pk_bf16(v[2], v[3]); *(u32x2*)p = w; }
struct EpiConvGlu {
    static constexpr bool PERM = false, AFTER_DRAIN = false;
    bf16_t* ACT; bf16_t* SIDE; const float* cw; const float* cb; PG8_LAS unsigned char* scr;
    __device__ __forceinline__ void conv4(const f32x4 (&a)[4][2], int n, const float* wp, const float* bp, PG8_LAS unsigned char* sl, f32x4 (&out)[4]) const {
        const f32x4 w0 = *(const f32x4*)(wp), w1 = *(const f32x4*)(wp + 22016), w2 = *(const f32x4*)(wp + 2 * 22016), bb = *(const f32x4*)(bp);
#pragma unroll
        for (int m = 0; m < 4; ++m) { u32x2 w; w.x = cvt_pk_bf16(a[m][n][0], a[m][n][1]); w.y = cvt_pk_bf16(a[m][n][2], a[m][n][3]); *(PG8_LAS u32x2*)(sl + m * 512) = w; }
        asm volatile("s_waitcnt lgkmcnt(0)" ::: "memory");
        u32x2 pv[4], nx[4];
#pragma unroll
        for (int m = 0; m < 4; ++m) { pv[m] = *(const PG8_LAS u32x2*)(sl + m * 512 - 32); nx[m] = *(const PG8_LAS u32x2*)(sl + m * 512 + 32); }
        asm volatile("s_waitcnt lgkmcnt(0)" ::: "memory");
#pragma unroll
        for (int m = 0; m < 4; ++m) {
            const float p[4] = {__uint_as_float(pv[m].x << 16), __uint_as_float(pv[m].x & 0xffff0000u), __uint_as_float(pv[m].y << 16), __uint_as_float(pv[m].y & 0xffff0000u)};
            const float q[4] = {__uint_as_float(nx[m].x << 16), __uint_as_float(nx[m].x & 0xffff0000u), __uint_as_float(nx[m].y << 16), __uint_as_float(nx[m].y & 0xffff0000u)};
#pragma unroll
            for (int i = 0; i < 4; ++i) out[m][i] = fmaf(w0[i], p[i], fmaf(w1[i], a[m][n][i], fmaf(w2[i], q[i], bb[i])));
        }
    }
    __device__ __forceinline__ void operator()(const f32x4 (&acc)[2][2][4][2], const Unit& u, int wr, int wc, int fr_in, int fq_in) const {
        int fr = fr_in, fq = fq_in; asm volatile("" : "+v"(fr), "+v"(fq));
        const int chan0 = u.pn * 128 + wc * 32 + 4 * fq;
        const bool e0 = (fr == 0), e15 = (fr == 15);
        PG8_LAS unsigned char* sl = scr + (wr * 4 + wc) * CONV_SLICE_BYTES + (1 + fr) * 32 + fq * 8;
#pragma unroll
        for (int ai = 0; ai < 2; ++ai) {
            const int blk = u.pm * 4 + ai * 2 + wr;
#pragma unroll
            for (int bj = 0; bj < 2; ++bj)
#pragma unroll
                for (int n = 0; n < 2; ++n) { const int col = u.pn * 256 + bj * 128 + wc * 32 + 16 * n + 4 * fq;
                    if (fr < 2) st4(SIDE + ((size_t)blk * 4 + fr) * 22016 + col, acc[ai][bj][0][n]);
                    if (fr >= 14) st4(SIDE + ((size_t)blk * 4 + (fr - 12)) * 22016 + col, acc[ai][bj][3][n]); }
#pragma unroll
            for (int n = 0; n < 2; ++n) {
                f32x4 cg[4], cv[4];
                asm volatile("" ::: "memory");
                conv4(acc[ai][0], n, cw + chan0 + 16 * n, cb + chan0 + 16 * n, sl, cg);
                conv4(acc[ai][1], n, cw + 11008 + chan0 + 16 * n, cb + 11008 + chan0 + 16 * n, sl, cv);
#pragma unroll
                for (int m = 0; m < 4; ++m) {
                    f32x4 r;
#pragma unroll
                    for (int i = 0; i < 4; ++i) r[i] = silu_(cg[m][i]) * cv[m][i];
                    const bool skip = (m == 0 && e0) || (m == 3 && e15);
                    if (!skip) st4(ACT + (size_t)(u.pm * BM + ai * HALF + wr * 64 + m * 16 + fr) * 11008 + chan0 + 16 * n, r);
                }
            }
        }
    }
};
template <class Epi, class Sched, bool ALIGN_EPI = false, bool SP2 = false>
__device__ __forceinline__ void gemm_phase(PG8_LAS unsigned char* lds, const Gemm g, const Sched& S, const Epi& E) {
    int tid_l = threadIdx.x; asm volatile("" : "+v"(tid_l));
    const int tid = tid_l, wid = __builtin_amdgcn_readfirstlane(tid >> 6), lane = tid & 63, wr = wid >> 2, wc = wid & 3, fr = lane & 15, fq = lane >> 4;
    const int K = g.K, nt = K / BK;
    unsigned voffA[2], voffB[2];
#pragma unroll
    for (int i = 0; i < 2; ++i) { int R, C; stage_rc(tid * 16 + i * 8192, R, C); const int Rb = Epi::PERM ? ((R & ~31) + perm32(R & 31)) : R;
        voffA[i] = (unsigned)(R * K + C) * 2u; voffB[i] = (unsigned)(Rb * K + C) * 2u; }
    const size_t kstep = (size_t)(BK * 2);
    const size_t hstep = (size_t)HALF * K * 2;
    const size_t tstep = 2 * hstep;
    const unsigned ldsw = (unsigned)wid * 1024u;
    const int aoff = lds_byte(wr * 64 + fr, fq * 8), boff = lds_byte(wc * 32 + fr, fq * 8);
#define PG8_SA(b, h) (((b) * 2 + (h)) * HTB)
#define PG8_SB(b, h) ((4 + (b) * 2 + (h)) * HTB)
#define PG8_STAGE(bufoff, gbase, voff) do { _Pragma("unroll") for (int _i = 0; _i < 2; ++_i) \
        __builtin_amdgcn_global_load_lds((const unsigned*)((const char*)(gbase) + (voff)[_i]), (PG8_LAS unsigned*)(lds + (bufoff) + ldsw + _i * 8192), 16, 0, 0); } while (0)
#define PG8_LDA(dst, b, h) do { _Pragma("unroll") for (int m = 0; m < 4; ++m) _Pragma("unroll") for (int k = 0; k < 2; ++k) dst[m][k] = *(const PG8_LAS bf16x8*)(lds + PG8_SA(b, h) + aoff + m * 2048 + k * 1024); } while (0)
#define PG8_LDB(dst, b, h) do { _Pragma("unroll") for (int n = 0; n < 2; ++n) _Pragma("unroll") for (int k = 0; k < 2; ++k) dst[n][k] = *(const PG8_LAS bf16x8*)(lds + PG8_SB(b, h) + boff + n * 2048 + k * 1024); } while (0)
#define PG8_MMA(ai, bj, At, Bt) do { __builtin_amdgcn_s_setprio(1); _Pragma("unroll") for (int m = 0; m < 4; ++m) _Pragma("unroll") for (int n = 0; n < 2; ++n) _Pragma("unroll") for (int k = 0; k < 2; ++k) \
        acc[ai][bj][m][n] = __builtin_amdgcn_mfma_f32_16x16x32_bf16(Bt[n][k], At[m][k], acc[ai][bj][m][n], 0, 0, 0); __builtin_amdgcn_s_setprio(0); } while (0)
#define PG8_WAIT_V(n) asm volatile("s_waitcnt vmcnt(" #n ")" ::: "memory")
#define PG8_WAIT_L(n) asm volatile("s_waitcnt lgkmcnt(" #n ")" ::: "memory")
#define PG8_BAR __builtin_amdgcn_s_barrier()
#define PG8_SCHED __builtin_amdgcn_sched_barrier(0)
    Unit cur, nxt; int ui = 0;
    if (!S.next(0, cur)) return;
    f32x4 acc[2][2][4][2];
#pragma unroll
    for (int a = 0; a < 2; ++a)
#pragma unroll
        for (int b = 0; b < 2; ++b)
#pragma unroll
            for (int m = 0; m < 4; ++m)
#pragma unroll
                for (int n = 0; n < 2; ++n) acc[a][b][m][n] = (f32x4){0.f, 0.f, 0.f, 0.f};
    bf16x8 At[4][2], B0[2][2], B1[2][2];
    const char* cA = (const char*)g.A + (size_t)cur.pm * tstep; const char* cB = (const char*)g.Bt + (size_t)cur.pn * tstep;
    S.a_ready(cur);
    if constexpr (SP2) {
        PG8_STAGE(PG8_SB(0, 0), cB, voffB); PG8_STAGE(PG8_SB(0, 1), cB + hstep, voffB); PG8_STAGE(PG8_SA(0, 0), cA, voffA); PG8_STAGE(PG8_SA(0, 1), cA + hstep, voffA);
        if (wr == 1) PG8_BAR;
        PG8_WAIT_V(2); PG8_BAR;
        PG8_STAGE(PG8_SB(1, 0), cB + kstep, voffB); PG8_STAGE(PG8_SA(1, 0), cA + kstep, voffA); PG8_STAGE(PG8_SB(1, 1), cB + hstep + kstep, voffB);
        PG8_WAIT_V(6); PG8_BAR;
    } else {
        PG8_STAGE(PG8_SB(0, 0), cB, voffB); PG8_STAGE(PG8_SA(0, 0), cA, voffA); PG8_STAGE(PG8_SB(0, 1), cB + hstep, voffB); PG8_STAGE(PG8_SA(0, 1), cA + hstep, voffA);
        if (wr == 1) PG8_BAR;
        PG8_WAIT_V(4); PG8_BAR;
        PG8_STAGE(PG8_SB(1, 0), cB + kstep, voffB); PG8_STAGE(PG8_SA(1, 0), cA + kstep, voffA); PG8_STAGE(PG8_SB(1, 1), cB + hstep + kstep, voffB);
        PG8_WAIT_V(6); PG8_BAR;
    }
    for (;;) {
        const bool has_next = S.next(ui + 1, nxt);
        const char* nA = has_next ? (const char*)g.A + (size_t)nxt.pm * tstep : cA; const char* nB = has_next ? (const char*)g.Bt + (size_t)nxt.pn * tstep : cB;
        for (int t = 0; t < nt; t += 2) {
            const bool last = (t == nt - 2);
            const char* a1 = cA + (size_t)(t + 1) * kstep;
            const char* a2 = last ? nA : cA + (size_t)(t + 2) * kstep; const char* b2 = last ? nB : cB + (size_t)(t + 2) * kstep;
            const char* a3 = a2 + kstep; const char* b3 = b2 + kstep;
            if (last && has_next) S.a_ready(nxt);
            if constexpr (SP2) {
            PG8_LDB(B0, 0, 0); PG8_LDB(B1, 0, 1); PG8_SCHED; PG8_LDA(At, 0, 0); PG8_STAGE(PG8_SA(1, 1), a1 + hstep, voffA);
            PG8_WAIT_V(8); PG8_WAIT_L(0); PG8_BAR; PG8_MMA(0, 0, At, B0); PG8_MMA(0, 1, At, B1); PG8_BAR; PG8_SCHED;
            PG8_LDA(At, 0, 1); PG8_STAGE(PG8_SB(0, 0), b2, voffB); PG8_STAGE(PG8_SB(0, 1), b2 + hstep, voffB); PG8_STAGE(PG8_SA(0, 0), a2, voffA);
            PG8_WAIT_V(8); PG8_WAIT_L(0); PG8_BAR; PG8_MMA(1, 0, At, B0); PG8_MMA(1, 1, At, B1); PG8_BAR; PG8_SCHED;
            PG8_LDB(B0, 1, 0); PG8_LDB(B1, 1, 1); PG8_SCHED; PG8_LDA(At, 1, 0); PG8_STAGE(PG8_SA(0, 1), a2 + hstep, voffA);
            PG8_WAIT_V(8); PG8_WAIT_L(0); PG8_BAR; PG8_MMA(0, 0, At, B0); PG8_MMA(0, 1, At, B1); PG8_BAR; PG8_SCHED;
            PG8_LDA(At, 1, 1); PG8_STAGE(PG8_SB(1, 0), b3, voffB); PG8_STAGE(PG8_SB(1, 1), b3 + hstep, voffB); PG8_STAGE(PG8_SA(1, 0), a3, voffA);
            PG8_WAIT_V(8); PG8_WAIT_L(0); PG8_BAR; PG8_MMA(1, 0, At, B0); PG8_MMA(1, 1, At, B1); PG8_BAR; PG8_SCHED;
            } else {
            PG8_LDB(B0, 0, 0); PG8_SCHED; PG8_LDA(At, 0, 0); PG8_STAGE(PG8_SA(1, 1), a1 + hstep, voffA);
            PG8_WAIT_L(8); PG8_BAR; PG8_WAIT_L(0); PG8_MMA(0, 0, At, B0); PG8_BAR; PG8_SCHED;
            PG8_LDB(B1, 0, 1); PG8_STAGE(PG8_SB(0, 0), b2, voffB);
            PG8_BAR; PG8_WAIT_L(0); PG8_MMA(0, 1, At, B1); PG8_BAR;
            PG8_LDA(At, 0, 1); PG8_STAGE(PG8_SA(0, 0), a2, voffA);
            PG8_BAR; PG8_WAIT_L(0); PG8_MMA(1, 0, At, B0); PG8_BAR; PG8_SCHED;
            PG8_STAGE(PG8_SB(0, 1), b2 + hstep, voffB);
            PG8_WAIT_V(6); PG8_BAR; PG8_MMA(1, 1, At, B1); PG8_BAR;
            PG8_LDB(B0, 1, 0); PG8_SCHED; PG8_LDA(At, 1, 0); PG8_STAGE(PG8_SA(0, 1), a2 + hstep, voffA);
            PG8_WAIT_L(8); PG8_BAR; PG8_WAIT_L(0); PG8_MMA(0, 0, At, B0); PG8_BAR; PG8_SCHED;
            PG8_LDB(B1, 1, 1); PG8_STAGE(PG8_SB(1, 0), b3, voffB);
            PG8_BAR; PG8_WAIT_L(0); PG8_MMA(0, 1, At, B1); PG8_BAR;
            PG8_LDA(At, 1, 1); PG8_STAGE(PG8_SA(1, 0), a3, voffA);
            PG8_BAR; PG8_WAIT_L(0); PG8_MMA(1, 0, At, B0); PG8_BAR; PG8_SCHED;
            PG8_STAGE(PG8_SB(1, 1), b3 + hstep, voffB);
            PG8_WAIT_V(6); PG8_BAR; PG8_MMA(1, 1, At, B1); PG8_BAR;
            }
        }
        if constexpr (ALIGN_EPI) { if (wr == 0) PG8_BAR; }
        if constexpr (!Epi::AFTER_DRAIN) { E(acc, cur, wr, wc, fr, fq); S.done(cur); }
        if (!has_next) break;
#pragma unroll
        for (int a = 0; a < 2; ++a)
#pragma unroll
            for (int b = 0; b < 2; ++b)
#pragma unroll
                for (int m = 0; m < 4; ++m)
#pragma unroll
                    for (int n = 0; n < 2; ++n) acc[a][b][m][n] = (f32x4){0.f, 0.f, 0.f, 0.f};
        cur = nxt; cA = nA; cB = nB; ++ui;
        if constexpr (ALIGN_EPI) { if (wr == 1) PG8_BAR; }
    }
    PG8_WAIT_V(0);
    if constexpr (!ALIGN_EPI) { if (wr == 0) PG8_BAR; }
    PG8_BAR;
    if constexpr (Epi::AFTER_DRAIN) { E.fused(acc, cur, wr, wc, fr, fq, lds, wid, lane); S.done(cur); }
#undef PG8_SA
#undef PG8_SB
#undef PG8_STAGE
#undef PG8_LDA
#undef PG8_LDB
#undef PG8_MMA
#undef PG8_WAIT_V
#undef PG8_WAIT_L
#undef PG8_BAR
#undef PG8_SCHED
}
}

namespace att {
#define ATT_LAS __attribute__((address_space(3)))
typedef unsigned short bf16_t;
typedef short bf16x8 __attribute__((ext_vector_type(8)));
typedef short s16x4 __attribute__((ext_vector_type(4)));
typedef float f32x16 __attribute__((ext_vector_type(16)));
typedef unsigned u32x4 __attribute__((ext_vector_type(4)));
constexpr int KROW = 400;
constexpr int SHM_K = 64 * KROW, SHM_V = 64 * 128 * 2;
constexpr int OFF_K = 0, OFF_V = 2 * SHM_K, OFF_SCR = 2 * SHM_K + 2 * SHM_V, ATT_LDS_BYTES = OFF_SCR + 8 * 64 * 4;
constexpr float SCALE = 0.07216878364870322f;
constexpr float THR = 8.f;
constexpr int LDQ = 3072, LDK = 3072, LDV = 4096, LDO = 2048, SEQ = 8192;
#define ATT_SBAR() __builtin_amdgcn_sched_barrier(0)
__device__ __forceinline__ int crow(int r, int hi) { return (r & 3) + 8 * (r >> 2) + 4 * hi; }
__device__ __forceinline__ unsigned cvtpk(float lo, float hi) { unsigned r; asm volatile("v_cvt_pk_bf16_f32 %0, %1, %2" : "=v"(r) : "v"(lo), "v"(hi)); return r; }

__device__ __forceinline__ void partialSM(f32x16& p0, f32x16& p1, float& m_reg, float& mn, float& alpha) {
  constexpr float C = SCALE * 1.4426950408889634f;
  float pmax = p0[0];
#pragma unroll
  for (int r = 1; r < 16; ++r) pmax = fmaxf(pmax, p0[r]);
#pragma unroll
  for (int r = 0; r < 16; ++r) pmax = fmaxf(pmax, p1[r]);
  { auto rr = __builtin_amdgcn_permlane32_swap(__float_as_uint(pmax), __float_as_uint(pmax), false, false);
    pmax = fmaxf(__uint_as_float(rr[0]), __uint_as_float(rr[1])); }
  if (__builtin_expect(__all(pmax - m_reg <= THR / SCALE), 1)) { mn = m_reg; alpha = 1.f; }
  else { mn = fmaxf(m_reg, pmax); alpha = __builtin_amdgcn_exp2f((m_reg - mn) * C); m_reg = mn; }
  const float mnC = -mn * C;
#pragma unroll
  for (int r = 0; r < 16; ++r) p0[r] = fmaf(p0[r], C, mnC);
#pragma unroll
  for (int r = 0; r < 16; ++r) p1[r] = fmaf(p1[r], C, mnC);
#pragma unroll
  for (int r = 0; r < 16; ++r) p0[r] = __builtin_amdgcn_exp2f(p0[r]);
}
__device__ __forceinline__ void finishSM(f32x16& p0, f32x16& p1, float alpha, float& l_reg, bf16x8& pa0, bf16x8& pa1, bf16x8& pa2, bf16x8& pa3) {
#pragma unroll
  for (int r = 0; r < 16; ++r) p1[r] = __builtin_amdgcn_exp2f(p1[r]);
  float ps = 0;
#pragma unroll
  for (int r = 0; r < 16; ++r) ps += p0[r];
#pragma unroll
  for (int r = 0; r < 16; ++r) ps += p1[r];
  { auto rr = __builtin_amdgcn_permlane32_swap(__float_as_uint(ps), __float_as_uint(ps), false, false);
    ps = __uint_as_float(rr[0]) + __uint_as_float(rr[1]); }
  l_reg = l_reg * alpha + ps;
#define ATT_PK4(P, BASE, OUT) do { unsigned a0 = cvtpk(P[BASE + 0], P[BASE + 1]), a1 = cvtpk(P[BASE + 2], P[BASE + 3]);   \
    unsigned b0 = cvtpk(P[BASE + 4], P[BASE + 5]), b1 = cvtpk(P[BASE + 6], P[BASE + 7]);                              \
    auto r0 = __builtin_amdgcn_permlane32_swap(a0, b0, false, false); auto r1 = __builtin_amdgcn_permlane32_swap(a1, b1, false, false); \
    u32x4 w = {r0[0], r1[0], r0[1], r1[1]}; OUT = *reinterpret_cast<bf16x8*>(&w); } while (0)
  ATT_PK4(p0, 0, pa0); ATT_PK4(p0, 8, pa1); ATT_PK4(p1, 0, pa2); ATT_PK4(p1, 8, pa3);
#undef ATT_PK4
}
__device__ __forceinline__ void qkt(f32x16& p0, f32x16& p1, const ATT_LAS unsigned char* Ks, const bf16x8 (&qr)[12], int r32, int hi) {
  p0 = f32x16{}; p1 = f32x16{};
#pragma unroll
  for (int d0 = 0; d0 < 12; ++d0) { const int cb = (d0 * 16 + hi * 8) * 2;
    const bf16x8 b0 = *(const ATT_LAS bf16x8*)(Ks + r32 * KROW + cb);
    const bf16x8 b1 = *(const ATT_LAS bf16x8*)(Ks + (32 + r32) * KROW + cb);
    p0 = __builtin_amdgcn_mfma_f32_32x32x16_bf16(b0, qr[d0], p0, 0, 0, 0);
    p1 = __builtin_amdgcn_mfma_f32_32x32x16_bf16(b1, qr[d0], p1, 0, 0, 0); }
}
__device__ __forceinline__ int v_st(int k, int c) { const int kk = (k & ~0xC) | ((k & 4) << 1) | ((k & 8) >> 1); return ((kk >> 3) * 4 + (c >> 5)) * 512 + ((kk & 7) * 32 + (c & 31)) * 2; }
__device__ __forceinline__ int v_rd_base(int lane) { return ((lane & 3) << 3) | (((lane >> 2) & 3) << 6) | (((lane >> 4) & 1) << 5) | (((lane >> 5) & 1) << 8); }
constexpr int v_rd_off(int d0, int ks, int half) { return d0 * 512 + ks * 4096 + half * 2048; }
template <int OFF> __device__ __forceinline__ s16x4 tr_read(int vb) {
  s16x4 r; asm volatile("ds_read_b64_tr_b16 %0, %1 offset:%2" : "=&v"(r) : "v"(vb), "i"(OFF) : "memory"); return r;
}
template <int D0> __device__ __forceinline__ void pv_one(f32x16& od, int vb, bf16x8 pa0, bf16x8 pa1, bf16x8 pa2, bf16x8 pa3) {
  const s16x4 l0 = tr_read<v_rd_off(D0, 0, 0)>(vb), h0 = tr_read<v_rd_off(D0, 0, 1)>(vb), l1 = tr_read<v_rd_off(D0, 1, 0)>(vb), h1 = tr_read<v_rd_off(D0, 1, 1)>(vb);
  const s16x4 l2 = tr_read<v_rd_off(D0, 2, 0)>(vb), h2 = tr_read<v_rd_off(D0, 2, 1)>(vb), l3 = tr_read<v_rd_off(D0, 3, 0)>(vb), h3 = tr_read<v_rd_off(D0, 3, 1)>(vb);
  asm volatile("s_waitcnt lgkmcnt(0)" ::: "memory"); ATT_SBAR();
#define ATT_PK(L, H) (bf16x8){L[0], L[1], L[2], L[3], H[0], H[1], H[2], H[3]}
  od = __builtin_amdgcn_mfma_f32_32x32x16_bf16(pa0, ATT_PK(l0, h0), od, 0, 0, 0);
  od = __builtin_amdgcn_mfma_f32_32x32x16_bf16(pa1, ATT_PK(l1, h1), od, 0, 0, 0);
  od = __builtin_amdgcn_mfma_f32_32x32x16_bf16(pa2, ATT_PK(l2, h2), od, 0, 0, 0);
  od = __builtin_amdgcn_mfma_f32_32x32x16_bf16(pa3, ATT_PK(l3, h3), od, 0, 0, 0);
#undef ATT_PK
}
__device__ __forceinline__ void pv_d0(f32x16 (&o)[4], int vb, bf16x8 pa0, bf16x8 pa1, bf16x8 pa2, bf16x8 pa3) {
  pv_one<0>(o[0], vb, pa0, pa1, pa2, pa3); pv_one<1>(o[1], vb, pa0, pa1, pa2, pa3); pv_one<2>(o[2], vb, pa0, pa1, pa2, pa3); pv_one<3>(o[3], vb, pa0, pa1, pa2, pa3);
}

__device__ __forceinline__ void attn_unit(const bf16_t* __restrict__ Qb, const bf16_t* __restrict__ Kh, const bf16_t* __restrict__ Vh, bf16_t* __restrict__ Ob, ATT_LAS unsigned char* lds) {
  int tid_l = threadIdx.x; asm volatile("" : "+v"(tid_l));
  const int tid = tid_l, wid = tid >> 6, lane = tid & 63, r32 = lane & 31, hi = lane >> 5;
  ATT_LAS unsigned char* Kl = lds + OFF_K; ATT_LAS unsigned char* Vl = lds + OFF_V;
  ATT_LAS float* scr = (ATT_LAS float*)(lds + OFF_SCR) + wid * 64; ATT_LAS float* li_l = scr; ATT_LAS float* al_l = scr + 32;
  float m_reg = -1e30f, l_reg = 0.f; f32x16 o[4] = {}; bf16x8 qr[12];
  const bf16_t* Qw = Qb + (size_t)(wid * 32 + r32) * LDQ + hi * 8;
#pragma unroll
  for (int d0 = 0; d0 < 12; ++d0) qr[d0] = *(const bf16x8*)(Qw + d0 * 16);
  int kg[3], kl[3];
#pragma unroll
  for (int i = 0; i < 3; ++i) { const int idx = tid + 512 * i, row = idx / 24, c16 = idx % 24; kg[i] = row * LDK + c16 * 8; kl[i] = row * KROW + c16 * 16; }
  const int sr = tid >> 4, sc = (tid & 15) * 8;
  const int vg0 = sr * LDV + sc, vg1 = (32 + sr) * LDV + sc, vl0 = v_st(sr, sc), vl1 = v_st(32 + sr, sc);
  const int vb0 = (int)(unsigned)(uintptr_t)Vl + v_rd_base(lane);
  bf16x8 ks0, ks1, ks2, vs0, vs1;
#define ATT_SLOAD(key0) do { const bf16_t* kp = Kh + (size_t)(key0) * LDK; const bf16_t* vp = Vh + (size_t)(key0) * LDV; \
    ks0 = *(const bf16x8*)(kp + kg[0]); ks1 = *(const bf16x8*)(kp + kg[1]); ks2 = *(const bf16x8*)(kp + kg[2]); vs0 = *(const bf16x8*)(vp + vg0); vs1 = *(const bf16x8*)(vp + vg1); } while (0)
#define ATT_SWRITE(b) do { *(ATT_LAS bf16x8*)(Kl + (b) * SHM_K + kl[0]) = ks0; *(ATT_LAS bf16x8*)(Kl + (b) * SHM_K + kl[1]) = ks1; *(ATT_LAS bf16x8*)(Kl + (b) * SHM_K + kl[2]) = ks2; \
    *(ATT_LAS bf16x8*)(Vl + (b) * SHM_V + vl0) = vs0; *(ATT_LAS bf16x8*)(Vl + (b) * SHM_V + vl1) = vs1; } while (0)
  constexpr int NT = SEQ / 64;
  ATT_SLOAD(0); ATT_SWRITE(0); __syncthreads();
  for (int j = 0; j < NT; ++j) {
    const int b = j & 1;
    if (j + 1 < NT) ATT_SLOAD((j + 1) * 64);
    f32x16 p0, p1; float mn, al; bf16x8 pa0, pa1, pa2, pa3;
    qkt(p0, p1, Kl + b * SHM_K, qr, r32, hi);
    partialSM(p0, p1, m_reg, mn, al);
    if (__any(al < 1.f)) { if (hi == 0) al_l[r32] = al; asm volatile("s_waitcnt lgkmcnt(0)" ::: "memory");
#pragma unroll
      for (int d = 0; d < 4; ++d)
#pragma unroll
        for (int r = 0; r < 16; ++r) o[d][r] *= al_l[crow(r, hi)]; }
    finishSM(p0, p1, al, l_reg, pa0, pa1, pa2, pa3);
    pv_d0(o, vb0 + b * SHM_V, pa0, pa1, pa2, pa3);
    if (j + 1 < NT) ATT_SWRITE(b ^ 1);
    __syncthreads();
  }
  if (hi == 0) li_l[r32] = l_reg;
  asm volatile("s_waitcnt lgkmcnt(0)" ::: "memory");
  float rli[16];
#pragma unroll
  for (int r = 0; r < 16; ++r) rli[r] = __builtin_amdgcn_rcpf(li_l[crow(r, hi)]);
  bf16_t* Ow = Ob + (size_t)(wid * 32) * LDO;
#pragma unroll
  for (int r = 0; r < 16; ++r) { const int orow = crow(r, hi);
#pragma unroll
    for (int d0 = 0; d0 < 4; ++d0) { const float v = o[d0][r] * rli[r]; Ow[(size_t)orow * LDO + d0 * 32 + r32] = (bf16_t)(cvtpk(v, v) & 0xffffu); } }
#undef ATT_SLOAD
#undef ATT_SWRITE
}
}

constexpr int NWAVES = 8;
constexpr int M = 24576, DM = 4096, SEQ = 8192, NSEQ = 3, MP = 16384;
constexpr int DFF = 11008, NUP = 22016, NIN = 12032;
constexpr float RMS_EPS = 1e-6f;
constexpr size_t MiB = 1u << 20;
constexpr size_t WS_CTL = 0, CTL_ZERO_BYTES = 1 * MiB;
constexpr size_t WS_ROPE = 1 * MiB;
constexpr size_t WS_BPOOL = 4 * MiB, WS_BUQ = 6 * MiB, WS_BUKV = 12 * MiB, WS_BBP = 16 * MiB, WS_BBM = 32 * MiB, WS_BO = 48 * MiB, WS_BIN = 80 * MiB;
constexpr size_t WS_A = 176 * MiB;
constexpr size_t WS_B = 368 * MiB;
constexpr size_t WS_ZK = 536 * MiB;
constexpr size_t WS_ZG = 548 * MiB;
constexpr size_t WS_AO = 932 * MiB;
constexpr size_t WS_F = 1028 * MiB;
constexpr size_t WS_BOUT = 1220 * MiB;
constexpr size_t WS_END1 = 1316 * MiB;
constexpr size_t WS_BUP = 4 * MiB, WS_BDOWN = 176 * MiB, WS_H2 = 262 * MiB, WS_ACT = 454 * MiB, WS_SIDE = 970 * MiB, WS_END2 = 1036 * MiB;
constexpr size_t WS_NEED = WS_END1;
constexpr int CW_TMO = 0, CW_CODE = 1, CW_BAR = 4096;
constexpr int RING_OFF = 0, RING_BYTES = 131072;
constexpr int LDSCTL_OFF = RING_BYTES, MISC_OFF = LDSCTL_OFF + 320;
constexpr int CONVSCR_OFF = LDSCTL_OFF + 512;
constexpr int LDS_BYTES = 149504;

#define GAS __attribute__((address_space(1)))
#define LAS __attribute__((address_space(3)))
typedef unsigned short bf16;
typedef unsigned v4u __attribute__((ext_vector_type(4)));
typedef unsigned v2u __attribute__((ext_vector_type(2)));
typedef float f32x4 __attribute__((ext_vector_type(4)));
typedef GAS unsigned gu32;
#define RLX_AGENT __ATOMIC_RELAXED, __HIP_MEMORY_SCOPE_AGENT
#define LDS_WAIT() asm volatile("s_waitcnt lgkmcnt(0)" ::: "memory")
#define VM_WAIT() asm volatile("s_waitcnt vmcnt(0)" ::: "memory")
__device__ __forceinline__ unsigned f2bf(float f) { unsigned u = __builtin_bit_cast(unsigned, f); return (u + 0x7fffu + ((u >> 16) & 1u)) >> 16; }
__device__ __forceinline__ unsigned pk2(float lo, float hi) { return f2bf(lo) | (f2bf(hi) << 16); }
__device__ __forceinline__ float bflo(unsigned w) { return __uint_as_float(w << 16); }
__device__ __forceinline__ float bfhi(unsigned w) { return __uint_as_float(w & 0xffff0000u); }
__device__ __forceinline__ void unpack8(const v4u w, float (&v)[8]) { v[0] = bflo(w.x); v[1] = bfhi(w.x); v[2] = bflo(w.y); v[3] = bfhi(w.y); v[4] = bflo(w.z); v[5] = bfhi(w.z); v[6] = bflo(w.w); v[7] = bfhi(w.w); }
__device__ __forceinline__ v4u pack8(const float (&v)[8]) { v4u w; w.x = pk2(v[0], v[1]); w.y = pk2(v[2], v[3]); w.z = pk2(v[4], v[5]); w.w = pk2(v[6], v[7]); return w; }
#define XB_TMO      128
#define XB_XCNT(j)  (256  + 64 * (j))
#define XB_XSUB(j)  (1280 + 64 * (j))
#define XB_XGEN(j)  (2304 + 64 * (j))
#define XB_TOP      3328
#define XB_TOPGEN   3392
#define XCD_BAR_WORDS 3456
#define XB_SPIN_CAP (1u << 18)

__device__ __forceinline__ unsigned xb_ld(unsigned* p)              { return __hip_atomic_load(p, __ATOMIC_RELAXED, __HIP_MEMORY_SCOPE_AGENT); }
__device__ __forceinline__ unsigned xb_add(unsigned* p, unsigned v) { return __hip_atomic_fetch_add(p, v, __ATOMIC_RELAXED, __HIP_MEMORY_SCOPE_AGENT); }
__device__ __forceinline__ unsigned xb_xcc_id() { return (unsigned)__builtin_amdgcn_s_getreg((3 << 11) | 20) & 0xFu; }
#define XB_SPIN(cond, bar) do { unsigned _sp = 0; while (cond) { __builtin_amdgcn_s_sleep(1); \
    if ((++_sp & 255u) == 0u) { if (xb_ld(&(bar)[XB_TMO])) break; if (_sp > XB_SPIN_CAP) { atomicAdd(&(bar)[XB_TMO], 1u); break; } } } } while (0)

struct XcdBarrier {
    unsigned* bar; unsigned x;
    volatile LAS unsigned* st;
};

__device__ __forceinline__ XcdBarrier xcd_barrier_post(unsigned* bar, volatile LAS unsigned* st) {
    XcdBarrier b; b.bar = bar; b.x = xb_xcc_id(); b.st = st;
    if (threadIdx.x == 0) (void)xb_add(&bar[XB_XCNT(b.x)], 1u);
    return b;
}
__device__ __forceinline__ void xcd_barrier_complete(unsigned* bar, unsigned x, unsigned& nloc, unsigned& nx) {
    const unsigned G = gridDim.x * gridDim.y * gridDim.z;
    unsigned sum, cnt, mine, sp = 0u;
    for (;;) {
        sum = 0u; cnt = 0u; mine = 0u;
#pragma unroll
        for (unsigned j = 0; j < 16; ++j) { const unsigned c = xb_ld(&bar[XB_XCNT(j)]); sum += c; cnt += (c > 0u) ? 1u : 0u; mine = (j == x) ? c : mine; }
        if (sum == G) break;
        __builtin_amdgcn_s_sleep(1);
        if ((++sp & 255u) == 0u) { if (xb_ld(&bar[XB_TMO])) break; if (sp > XB_SPIN_CAP) { atomicAdd(&bar[XB_TMO], 1u); break; } }
    }
    nloc = mine > 0u ? mine : 1u; nx = cnt > 0u ? cnt : 1u;
}

__device__ __forceinline__ void xcd_barrier(const XcdBarrier& b) {
    asm volatile("s_waitcnt vmcnt(0)" ::: "memory");
    __syncthreads();
    if (threadIdx.x == 0) {
        unsigned* bar = b.bar;
        __builtin_amdgcn_s_waitcnt(0);
        unsigned nloc = b.st[0], nx = b.st[1];
        if (nloc == 0u) { xcd_barrier_complete(bar, b.x, nloc, nx); b.st[0] = nloc; b.st[1] = nx; }
        const unsigned old = xb_add(&bar[XB_XSUB(b.x)], 1u);
        const unsigned gen = old / nloc;
        if (old + 1u == (gen + 1u) * nloc) {
            __builtin_amdgcn_fence(__ATOMIC_RELEASE, "agent");
            asm volatile("s_waitcnt vmcnt(0)" ::: "memory");
            const unsigned og = xb_add(&bar[XB_TOP], 1u);
            const unsigned tg = og / nx;
            if (og + 1u == (tg + 1u) * nx) xb_add(&bar[XB_TOPGEN], 1u);
            else XB_SPIN(xb_ld(&bar[XB_TOPGEN]) == tg, bar);
            __builtin_amdgcn_fence(__ATOMIC_ACQUIRE, "agent");
            xb_add(&bar[XB_XGEN(b.x)], 1u);
            asm volatile("s_waitcnt vmcnt(0)" ::: "memory");
        } else {
            XB_SPIN(xb_ld(&bar[XB_XGEN(b.x)]) == gen, bar);
            __builtin_amdgcn_fence(__ATOMIC_ACQUIRE, "agent");
            asm volatile("s_waitcnt vmcnt(0)" ::: "memory");
        }
    }
    __syncthreads();
}

__device__ __forceinline__ float wave_sum(float v) {
#pragma unroll
    for (int o = 1; o < 64; o <<= 1) v += __shfl_xor(v, o);
    return v;
}
__device__ __forceinline__ void tr_item(const float* W, int N, bf16* WT, int ldt, int k0, int n0, int drow0, LAS float* scr, int lane) {
#pragma unroll 8
    for (int i = 0; i < 32; ++i) { const int kk = 2 * i + (lane >> 5); scr[kk * 33 + (lane & 31)] = W[(size_t)(k0 + kk) * N + n0 + (lane & 31)]; }
    LDS_WAIT(); asm volatile("" ::: "memory");
    const int c = lane & 7;
#pragma unroll
    for (int j = 0; j < 4; ++j) { const int n = (lane >> 3) + 8 * j; const LAS float* s = scr + (8 * c) * 33 + n;
        v4u o; o.x = pk2(s[0 * 33], s[1 * 33]); o.y = pk2(s[2 * 33], s[3 * 33]); o.z = pk2(s[4 * 33], s[5 * 33]); o.w = pk2(s[6 * 33], s[7 * 33]);
        *(GAS v4u*)(WT + (size_t)(drow0 + n) * ldt + k0 + 8 * c) = o; }
    LDS_WAIT(); asm volatile("" ::: "memory");
}
__device__ __forceinline__ void rms_row_4096(const float* xrow, const float* gain, bf16* orow, int lane) {
    const GAS f32x4* xr = (const GAS f32x4*)xrow + lane; const GAS f32x4* gr = (const GAS f32x4*)gain + lane;
    f32x4 v[16]; float s = 0.f;
#pragma unroll
    for (int j = 0; j < 16; ++j) { v[j] = xr[64 * j]; s += (v[j].x * v[j].x + v[j].y * v[j].y) + (v[j].z * v[j].z + v[j].w * v[j].w); }
    const float r = 1.0f / sqrtf(wave_sum(s) * (1.f / 4096.f) + RMS_EPS);
    GAS v2u* o8 = (GAS v2u*)orow + lane;
#pragma unroll
    for (int j = 0; j < 16; ++j) { const f32x4 g = gr[64 * j]; v2u w; w.x = pk2(v[j].x * r * g.x, v[j].y * r * g.y); w.y = pk2(v[j].z * r * g.z, v[j].w * r * g.w); o8[64 * j] = w; }
}
__device__ __forceinline__ void sincos_d(double a, double& s, double& c) {
    const double TWO_PI = 6.283185307179586476925286766559;
    const double n = __builtin_rint(a / TWO_PI); const double x = a - n * TWO_PI;
    const double x2 = x * x; double ts = 1.0, tc = 1.0; double ss = 1.0, cs = 1.0;
#pragma unroll
    for (int k = 1; k <= 14; ++k) { tc *= -x2 / (double)((2 * k - 1) * (2 * k)); cs += tc; ts *= -x2 / (double)((2 * k) * (2 * k + 1)); ss += ts; }
    s = x * ss; c = cs;
}

#ifndef PHM
#define PHM 0x3ff
#endif
typedef const __attribute__((address_space(4))) unsigned char* kptr_t;
__device__ __forceinline__ kptr_t karg() { kptr_t p = (kptr_t)__builtin_amdgcn_kernarg_segment_ptr(); asm volatile("" : "+s"(p)); return p; }
#define KIN(i) (*(const float* const __attribute__((address_space(4)))*)(kp + 8 * (i)))
#define KOUT() (*(float* const __attribute__((address_space(4)))*)(kp + 8 * 20))
#define KWS() (*(unsigned char* const __attribute__((address_space(4)))*)(kp + 8 * 21))
struct Args { const float* in[20]; float* out; unsigned char* ws; };
__global__ void __launch_bounds__(NWAVES * 64, 2) fwd_kernel(Args args) {
    extern __shared__ __attribute__((aligned(16))) unsigned char lds_raw[];
    LAS unsigned char* lds = (LAS unsigned char*)lds_raw;
    volatile LAS unsigned* MISC = (volatile LAS unsigned*)(lds + MISC_OFF);
    const int tid = threadIdx.x, lane = tid & 63, wave = __builtin_amdgcn_readfirstlane(tid >> 6);
    const int G = gridDim.x, bx = blockIdx.x;
    const int vcu = (G % 8 == 0) ? (bx % 8) * (G / 8) + bx / 8 : bx;
    gu32* ctl = (gu32*)(args.ws + WS_CTL);
    for (int u = tid; u < (LDS_BYTES - LDSCTL_OFF) / 4; u += NWAVES * 64) ((LAS unsigned*)(lds + LDSCTL_OFF))[u] = 0u;
    __syncthreads();
    XcdBarrier bar = xcd_barrier_post((unsigned*)(ctl + CW_BAR), MISC + 8);
#define GRID_BAR() xcd_barrier(bar)
    const int gw = vcu * NWAVES + wave, NGW = G * NWAVES;
    const int gt = vcu * (NWAVES * 64) + tid, NGT = G * NWAVES * 64;
    LAS float* scr = (LAS float*)(lds + RING_OFF + wave * 16384);

#if (PHM >> 0) & 1
    {
        kptr_t kp = karg(); unsigned char* ws = KWS();
        const float* x_prompt = KIN(0); const float* x_sample = KIN(1); const float* norm_mix_gain = KIN(2); const float* w_in = KIN(3); const float* pool_w = KIN(4);
        const float* w_uq = KIN(7); const float* w_ukv = KIN(9); const float* w_bp = KIN(12); const float* w_bm = KIN(13); const float* w_o = KIN(14);
        float* ropec = (float*)(ws + WS_ROPE); float* ropes = ropec + SEQ * 32;
        bf16* Bpool = (bf16*)(ws + WS_BPOOL); bf16* Buq = (bf16*)(ws + WS_BUQ); bf16* Bukv = (bf16*)(ws + WS_BUKV); bf16* Bbp = (bf16*)(ws + WS_BBP);
        bf16* Bbm = (bf16*)(ws + WS_BBM); bf16* Bo = (bf16*)(ws + WS_BO); bf16* Bin = (bf16*)(ws + WS_BIN); bf16* Hb = (bf16*)(ws + WS_A);
        constexpr int I_POOL = 512, I_UQ = 1536, I_UKV = 1024, I_BP = 4096, I_BM = 4096, I_O = 8192, I_IN = 23680;
        constexpr int NITEMS = I_POOL + I_UQ + I_UKV + I_BP + I_BM + I_O + I_IN;
        for (int it = gw; it < NITEMS; it += NGW) {
            int r = it;
            if (r < I_POOL) { const int g = r >> 7, q = r & 127; tr_item(pool_w + (size_t)g * 512 * 512, 512, Bpool, 512, 64 * (q >> 4), 32 * (q & 15), g * 512 + 32 * (q & 15), scr, lane); continue; } r -= I_POOL;
            if (r < I_UQ) { tr_item(w_uq, 3072, Buq, 1024, 64 * (r / 96), 32 * (r % 96), 32 * (r % 96), scr, lane); continue; } r -= I_UQ;
            if (r < I_UKV) { tr_item(w_ukv, 4096, Bukv, 512, 64 * (r / 128), 32 * (r % 128), 32 * (r % 128), scr, lane); continue; } r -= I_UKV;
            if (r < I_BP) { tr_item(w_bp, 4096, Bbp, 2048, 64 * (r / 128), 32 * (r % 128), 32 * (r % 128), scr, lane); continue; } r -= I_BP;
            if (r < I_BM) { tr_item(w_bm, 4096, Bbm, 2048, 64 * (r / 128), 32 * (r % 128), 32 * (r % 128), scr, lane); continue; } r -= I_BM;
            if (r < I_O) { tr_item(w_o, 4096, Bo, 4096, 64 * (r / 128), 32 * (r % 128), 32 * (r % 128), scr, lane); continue; } r -= I_O;
            { const int n0 = 32 * (r % 370); const int drow = (n0 < 3584) ? n0 : (n0 < 3648 ? 11776 + (n0 - 3584) : n0 - 64);
              tr_item(w_in, 11840, Bin, 4096, 64 * (r / 370), n0, drow, scr, lane); }
        }
        { GAS v4u* z = (GAS v4u*)(Bin + (size_t)11840 * 4096); const v4u zero = {0u, 0u, 0u, 0u};
          for (int i = gt; i < 192 * 4096 / 8; i += NGT) z[i] = zero; }
        for (int i = gt; i < SEQ * 32; i += NGT) { const int t = i >> 5, f = i & 31;
            const float inv = 1.0f / (float)exp2(13.287712379549449 * ((double)(2 * f) / 64.0));
            const float ang = (float)t * inv; double s, c; sincos_d((double)ang, s, c); ropec[i] = (float)c; ropes[i] = (float)s; }
        for (int m = gw; m < M; m += NGW) { const float* xr = (m < MP) ? x_prompt + (size_t)m * DM : x_sample + (size_t)(m - MP) * DM; rms_row_4096(xr, norm_mix_gain, Hb + (size_t)m * DM, lane); }
    }
    GRID_BAR();
#endif
#if (PHM >> 1) & 1
    {
        kptr_t kp = karg(); unsigned char* ws = KWS();
        bf16* Hb = (bf16*)(ws + WS_A); bf16* Bin = (bf16*)(ws + WS_BIN); bf16* ZA = (bf16*)(ws + WS_B); bf16* ZK = (bf16*)(ws + WS_ZK); bf16* ZG = (bf16*)(ws + WS_ZG);
        pg8::Gemm g{Hb, Bin, M, NIN, DM}; pg8::StaticOrder S; S.init(M, NIN, G, bx);
        pg8::EpiZ E{ZA, ZG, ZK};
        pg8::gemm_phase<pg8::EpiZ, pg8::StaticOrder, true, true>(lds + RING_OFF, g, S, E);
    }
    GRID_BAR();
#endif
#if (PHM >> 2) & 1
    {
        kptr_t kp = karg(); unsigned char* ws = KWS(); const float* q_a_gain = KIN(6); const float* kv_a_gain = KIN(8);
        bf16* ZA = (bf16*)(ws + WS_B); bf16* PAp = (bf16*)(ws + WS_A); bf16* CQN = PAp + (size_t)4 * M * 512; bf16* CKVN = CQN + (size_t)M * 1024;
    for (int m = gw; m < M; m += NGW) {
        const int t = m % SEQ; const bf16* zrow = ZA + (size_t)m * 3584;
#pragma unroll
        for (int g = 0; g < 4; ++g) {
            const int half = 1 << g; const int lo = (t - half < 0) ? 0 : t - half, hi = (t + half > SEQ) ? SEQ : t + half;
            float acc[8] = {0.f, 0.f, 0.f, 0.f, 0.f, 0.f, 0.f, 0.f}, self[8];
            for (int tt = lo; tt < hi; ++tt) { float v[8]; unpack8(*(const GAS v4u*)(zrow + (ptrdiff_t)(tt - t) * 3584 + g * 512 + lane * 8), v);
#pragma unroll
                for (int j = 0; j < 8; ++j) acc[j] += v[j]; }
            unpack8(*(const GAS v4u*)(zrow + g * 512 + lane * 8), self);
            const float cnt = (float)(hi - lo);
#pragma unroll
            for (int j = 0; j < 8; ++j) acc[j] = acc[j] / cnt - self[j];
            *(GAS v4u*)(PAp + ((size_t)g * M + m) * 512 + lane * 8) = pack8(acc);
        }
        { float a[8], b[8]; unpack8(*(const GAS v4u*)(zrow + 2048 + lane * 8), a); unpack8(*(const GAS v4u*)(zrow + 2560 + lane * 8), b);
          float s = 0.f;
#pragma unroll
          for (int j = 0; j < 8; ++j) s += a[j] * a[j] + b[j] * b[j];
          const float r = 1.0f / sqrtf(wave_sum(s) * (1.f / 1024.f) + RMS_EPS);
          const GAS f32x4* ga = (const GAS f32x4*)(q_a_gain + lane * 8); const GAS f32x4* gb = (const GAS f32x4*)(q_a_gain + 512 + lane * 8);
          const f32x4 ga0 = ga[0], ga1 = ga[1], gb0 = gb[0], gb1 = gb[1];
#pragma unroll
          for (int j = 0; j < 4; ++j) { a[j] *= r * ga0[j]; a[4 + j] *= r * ga1[j]; b[j] *= r * gb0[j]; b[4 + j] *= r * gb1[j]; }
          *(GAS v4u*)(CQN + (size_t)m * 1024 + lane * 8) = pack8(a); *(GAS v4u*)(CQN + (size_t)m * 1024 + 512 + lane * 8) = pack8(b); }
        { float a[8]; unpack8(*(const GAS v4u*)(zrow + 3072 + lane * 8), a);
          float s = 0.f;
#pragma unroll
          for (int j = 0; j < 8; ++j) s += a[j] * a[j];
          const float r = 1.0f / sqrtf(wave_sum(s) * (1.f / 512.f) + RMS_EPS);
          const GAS f32x4* ga = (const GAS f32x4*)(kv_a_gain + lane * 8); const f32x4 ga0 = ga[0], ga1 = ga[1];
#pragma unroll
          for (int j = 0; j < 4; ++j) { a[j] *= r * ga0[j]; a[4 + j] *= r * ga1[j]; }
          *(GAS v4u*)(CKVN + (size_t)m * 512 + lane * 8) = pack8(a); }
    }
    }
    GRID_BAR();
#endif
#if (PHM >> 3) & 1
    {
        kptr_t kp = karg(); unsigned char* ws = KWS(); const float* pool_scale = KIN(5);
        bf16* PAp = (bf16*)(ws + WS_A); bf16* CQN = PAp + (size_t)4 * M * 512; bf16* CKVN = CQN + (size_t)M * 1024;
        bf16* Bpool = (bf16*)(ws + WS_BPOOL); bf16* Buq = (bf16*)(ws + WS_BUQ); bf16* Bukv = (bf16*)(ws + WS_BUKV);
        bf16* AO = (bf16*)(ws + WS_AO); bf16* Qb = (bf16*)(ws + WS_B); bf16* KV = (bf16*)(ws + WS_F);
    {
        pg8::Gemm g{PAp, Bpool, 4 * M, 2048, 512}; pg8::PoolOrder S{G, bx};
        pg8::EpiPool E{AO, pool_scale};
        pg8::gemm_phase<pg8::EpiPool, pg8::PoolOrder, true, true>(lds + RING_OFF, g, S, E);
    }
    {
        pg8::Gemm g{CQN, Buq, M, 3072, 1024}; pg8::StaticOrder S; S.init(M, 3072, G, bx);
        pg8::EpiBf E{Qb, 3072};
        pg8::gemm_phase<pg8::EpiBf, pg8::StaticOrder, true, true>(lds + RING_OFF, g, S, E);
    }
    {
        pg8::Gemm g{CKVN, Bukv, M, 4096, 512}; pg8::StaticOrder S; S.init(M, 4096, G, bx);
        pg8::EpiBf E{KV, 4096};
        pg8::gemm_phase<pg8::EpiBf, pg8::StaticOrder, true, true>(lds + RING_OFF, g, S, E);
    }
    }
    GRID_BAR();
#endif
#if (PHM >> 4) & 1
    {
        kptr_t kp = karg(); unsigned char* ws = KWS(); const float* q_gain = KIN(10); const float* k_gain = KIN(11);
        const float* ropec = (const float*)(ws + WS_ROPE); const float* ropes = ropec + SEQ * 32;
        bf16* Qb = (bf16*)(ws + WS_B); bf16* KV = (bf16*)(ws + WS_F); bf16* ZK = (bf16*)(ws + WS_ZK); bf16* Kb = (bf16*)(ws + WS_A);
    for (int m = gw; m < M; m += NGW) {
        const int t = m % SEQ, h = lane >> 2, s4 = lane & 3;
        float cs[8], sn[8];
        { const GAS f32x4* cp = (const GAS f32x4*)(ropec + t * 32 + 8 * s4); const GAS f32x4* sp = (const GAS f32x4*)(ropes + t * 32 + 8 * s4);
          const f32x4 c0 = cp[0], c1 = cp[1], s0 = sp[0], s1 = sp[1];
#pragma unroll
          for (int j = 0; j < 4; ++j) { cs[j] = c0[j]; cs[4 + j] = c1[j]; sn[j] = s0[j]; sn[4 + j] = s1[j]; } }
#pragma unroll
        for (int which = 0; which < 2; ++which) {
            float v[6][8];
            const float* gain = which ? k_gain : q_gain;
            if (which == 0) { const bf16* qp = Qb + (size_t)m * 3072 + h * 192;
#pragma unroll
                for (int c = 0; c < 4; ++c) unpack8(*(const GAS v4u*)(qp + 32 * s4 + 8 * c), v[c]);
                unpack8(*(const GAS v4u*)(qp + 128 + 8 * s4), v[4]); unpack8(*(const GAS v4u*)(qp + 160 + 8 * s4), v[5]); }
            else { const bf16* kp = KV + (size_t)m * 4096 + h * 256; const bf16* rp = ZK + (size_t)m * 256;
#pragma unroll
                for (int c = 0; c < 4; ++c) unpack8(*(const GAS v4u*)(kp + 32 * s4 + 8 * c), v[c]);
                unpack8(*(const GAS v4u*)(rp + 8 * s4), v[4]); unpack8(*(const GAS v4u*)(rp + 32 + 8 * s4), v[5]); }
            float ss = 0.f;
#pragma unroll
            for (int c = 0; c < 6; ++c)
#pragma unroll
                for (int j = 0; j < 8; ++j) ss += v[c][j] * v[c][j];
            ss += __shfl_xor(ss, 1); ss += __shfl_xor(ss, 2);
            const float r = 1.0f / sqrtf(ss * (1.f / 192.f) + RMS_EPS);
#pragma unroll
            for (int c = 0; c < 6; ++c) { const int d = (c < 4) ? 32 * s4 + 8 * c : (c == 4 ? 128 + 8 * s4 : 160 + 8 * s4);
                const GAS f32x4* gp = (const GAS f32x4*)(gain + d); const f32x4 g0 = gp[0], g1 = gp[1];
#pragma unroll
                for (int j = 0; j < 4; ++j) { v[c][j] *= r * g0[j]; v[c][4 + j] *= r * g1[j]; } }
#pragma unroll
            for (int j = 0; j < 8; ++j) { const float x1 = v[4][j], x2 = v[5][j]; v[4][j] = x1 * cs[j] - x2 * sn[j]; v[5][j] = x2 * cs[j] + x1 * sn[j]; }
            bf16* op = (which == 0) ? Qb + (size_t)m * 3072 + h * 192 : Kb + (size_t)m * 3072 + h * 192;
#pragma unroll
            for (int c = 0; c < 4; ++c) *(GAS v4u*)(op + 32 * s4 + 8 * c) = pack8(v[c]);
            *(GAS v4u*)(op + 128 + 8 * s4) = pack8(v[4]); *(GAS v4u*)(op + 160 + 8 * s4) = pack8(v[5]);
        }
    }
    }
    GRID_BAR();
#endif
#if (PHM >> 5) & 1
    {
        kptr_t kp = karg(); unsigned char* ws = KWS();
        bf16* Qb = (bf16*)(ws + WS_B); bf16* KV = (bf16*)(ws + WS_F); bf16* Kb = (bf16*)(ws + WS_A); bf16* BOUT = (bf16*)(ws + WS_BOUT);
        for (int i = 0;; ++i) {
            int pair, qb;
            if (G == 256) { pair = i * 8 + (bx & 7); qb = bx >> 3; if (pair >= 48) break; }
            else { const int L = i * G + bx; if (L >= 48 * 32) break; pair = L >> 5; qb = L & 31; }
            const int sq = pair >> 4, h = pair & 15; const size_t tok0 = (size_t)sq * SEQ + (size_t)qb * 256;
            att::attn_unit(Qb + tok0 * 3072 + h * 192, Kb + (size_t)sq * SEQ * 3072 + h * 192, KV + (size_t)sq * SEQ * 4096 + h * 256 + 128, BOUT + tok0 * 2048 + h * 128, lds + RING_OFF);
        }
    }
    GRID_BAR();
#endif
#if (PHM >> 6) & 1
    {
        kptr_t kp = karg(); unsigned char* ws = KWS();
        bf16* AO = (bf16*)(ws + WS_AO); bf16* BOUT = (bf16*)(ws + WS_BOUT); bf16* Bbp = (bf16*)(ws + WS_BBP); bf16* Bbm = (bf16*)(ws + WS_BBM);
        bf16* Tb = (bf16*)(ws + WS_A); bf16* Mb = (bf16*)(ws + WS_F); bf16* ZG = (bf16*)(ws + WS_ZG);
    {
        pg8::Gemm g{AO, Bbp, M, 4096, 2048}; pg8::StaticOrder S; S.init(M, 4096, G, bx);
        pg8::EpiGateA E{Tb, ZG};
        pg8::gemm_phase<pg8::EpiGateA, pg8::StaticOrder, true, true>(lds + RING_OFF, g, S, E);
    }
    {
        pg8::Gemm g{BOUT, Bbm, M, 4096, 2048}; pg8::StaticOrder S; S.init(M, 4096, G, bx);
        pg8::EpiGateB E{Tb, Mb, ZG};
        pg8::gemm_phase<pg8::EpiGateB, pg8::StaticOrder, true, true>(lds + RING_OFF, g, S, E);
    }
    }
    GRID_BAR();
#endif
#if (PHM >> 7) & 1
    {
        kptr_t kp = karg(); unsigned char* ws = KWS(); const float* x_prompt = KIN(0); const float* x_sample = KIN(1); float* out = KOUT();
        bf16* Mb = (bf16*)(ws + WS_F); bf16* Bo = (bf16*)(ws + WS_BO);
        pg8::Gemm g{Mb, Bo, M, 4096, 4096}; pg8::StaticOrder S; S.init(M, 4096, G, bx);
        pg8::EpiResX E{x_prompt, x_sample, out};
        pg8::gemm_phase<pg8::EpiResX, pg8::StaticOrder, true, true>(lds + RING_OFF, g, S, E);
    }
    GRID_BAR();
#endif
#if (PHM >> 8) & 1
    {
        kptr_t kp = karg(); unsigned char* ws = KWS(); const float* norm_ffn_gain = KIN(15); const float* w_up = KIN(16); const float* w_down = KIN(19); float* out = KOUT();
        bf16* Bup = (bf16*)(ws + WS_BUP); bf16* Bdown = (bf16*)(ws + WS_BDOWN); bf16* H2 = (bf16*)(ws + WS_H2);
        constexpr int I_UP = 64 * 688, I_DOWN = 172 * 128;
        for (int it = gw; it < I_UP + I_DOWN; it += NGW) {
            int r = it;
            if (r < I_UP) { const int n0 = 32 * (r % 688); const int nn = (n0 < DFF) ? n0 : n0 - DFF; const int drow = 256 * (nn >> 7) + (nn & 127) + ((n0 < DFF) ? 0 : 128);
                tr_item(w_up, NUP, Bup, 4096, 64 * (r / 688), n0, drow, scr, lane); continue; } r -= I_UP;
            tr_item(w_down, 4096, Bdown, DFF, 64 * (r / 128), 32 * (r % 128), 32 * (r % 128), scr, lane);
        }
        for (int m = gw; m < M; m += NGW) rms_row_4096(out + (size_t)m * DM, norm_ffn_gain, H2 + (size_t)m * DM, lane);
    }
    GRID_BAR();
#endif
#if (PHM >> 9) & 1
    {
        kptr_t kp = karg(); unsigned char* ws = KWS(); const float* conv_w = KIN(17); const float* conv_b = KIN(18);
        bf16* H2 = (bf16*)(ws + WS_H2); bf16* Bup = (bf16*)(ws + WS_BUP); bf16* ACT = (bf16*)(ws + WS_ACT); bf16* SIDE = (bf16*)(ws + WS_SIDE);
        pg8::Gemm g{H2, Bup, M, NUP, DM}; pg8::StaticOrder S; S.init(M, NUP, G, bx);
        pg8::EpiConvGlu E{ACT, SIDE, conv_w, conv_b, lds + CONVSCR_OFF};
        pg8::gemm_phase<pg8::EpiConvGlu, pg8::StaticOrder, true, true>(lds + RING_OFF, g, S, E);
    }
    GRID_BAR();
    {
        kptr_t kp = karg(); unsigned char* ws = KWS(); const float* conv_w = KIN(17); const float* conv_b = KIN(18);
        bf16* ACT = (bf16*)(ws + WS_ACT); const bf16* SIDE = (const bf16*)(ws + WS_SIDE);
        for (int idx = gt; idx < 768 * 1376; idx += NGT) {
            const int rw = idx / 1376, ch = idx % 1376, blk = rw >> 1, last = rw & 1, tile = ch >> 4, j8 = (ch & 15) * 8, c = tile * 128 + j8, col = tile * 256 + j8;
            const bf16* sb = SIDE + (size_t)blk * 4 * NUP + col;
            const v4u zero = {0u, 0u, 0u, 0u};
            v4u gmv, g0v, gpv, vmv, v0v, vpv;
            if (!last) { const bool has = (blk & 127) != 0;
                gmv = has ? *(const GAS v4u*)(sb - NUP) : zero; vmv = has ? *(const GAS v4u*)(sb - NUP + 128) : zero;
                g0v = *(const GAS v4u*)(sb); v0v = *(const GAS v4u*)(sb + 128); gpv = *(const GAS v4u*)(sb + NUP); vpv = *(const GAS v4u*)(sb + NUP + 128); }
            else { const bool has = (blk & 127) != 127;
                gmv = *(const GAS v4u*)(sb + 2 * NUP); vmv = *(const GAS v4u*)(sb + 2 * NUP + 128); g0v = *(const GAS v4u*)(sb + 3 * NUP); v0v = *(const GAS v4u*)(sb + 3 * NUP + 128);
                gpv = has ? *(const GAS v4u*)(sb + 4 * NUP) : zero; vpv = has ? *(const GAS v4u*)(sb + 4 * NUP + 128) : zero; }
            float gm[8], g0[8], gp[8], vm[8], v0[8], vp[8], a[8];
            unpack8(gmv, gm); unpack8(g0v, g0); unpack8(gpv, gp); unpack8(vmv, vm); unpack8(v0v, v0); unpack8(vpv, vp);
#pragma unroll
            for (int j = 0; j < 8; ++j) {
                const float gg = gm[j] * conv_w[c + j] + g0[j] * conv_w[NUP + c + j] + gp[j] * conv_w[2 * NUP + c + j] + conv_b[c + j];
                const float vv = vm[j] * conv_w[DFF + c + j] + v0[j] * conv_w[NUP + DFF + c + j] + vp[j] * conv_w[2 * NUP + DFF + c + j] + conv_b[DFF + c + j];
                a[j] = gg * __builtin_amdgcn_rcpf(1.0f + __expf(-gg)) * vv; }
            *(GAS v4u*)(ACT + ((size_t)blk * 64 + (last ? 63 : 0)) * DFF + c) = pack8(a);
        }
    }
    GRID_BAR();
    {
        kptr_t kp = karg(); unsigned char* ws = KWS(); float* out = KOUT(); bf16* ACT = (bf16*)(ws + WS_ACT); bf16* Bdown = (bf16*)(ws + WS_BDOWN);
        pg8::Gemm g{ACT, Bdown, M, 4096, DFF}; pg8::StaticOrder S; S.init(M, 4096, G, bx);
        pg8::EpiResOut E{out};
        pg8::gemm_phase<pg8::EpiResOut, pg8::StaticOrder, true, true>(lds + RING_OFF, g, S, E);
    }
#endif
}

extern "C" void kernel_launch(void* const* d_in, const int* in_sizes, int n_in, void* d_out, int out_size, void* d_ws, size_t ws_size, hipStream_t stream) {
    static int grid = 0;
    if (grid == 0) {
        if (n_in != 20 || in_sizes[0] != MP * DM || in_sizes[1] != (M - MP) * DM || out_size != M * DM || ws_size < WS_NEED) {
            fprintf(stderr, "kernel_launch: shape mismatch (n_in %d, in0 %d, in1 %d, out %d, ws %zu, need %zu); nothing launched\n", n_in, n_in > 0 ? in_sizes[0] : -1, n_in > 1 ? in_sizes[1] : -1, out_size, ws_size, (size_t)WS_NEED); grid = -1; return; }
        int dev = 0, cus = 0, per_cu = 0;
        if (hipGetDevice(&dev) != hipSuccess || hipDeviceGetAttribute(&cus, hipDeviceAttributeMultiprocessorCount, dev) != hipSuccess) { fprintf(stderr, "kernel_launch: device query failed\n"); grid = -1; return; }
        if (hipFuncSetAttribute((const void*)fwd_kernel, hipFuncAttributeMaxDynamicSharedMemorySize, LDS_BYTES) != hipSuccess) { fprintf(stderr, "kernel_launch: hipFuncSetAttribute failed\n"); grid = -1; return; }
        if (hipOccupancyMaxActiveBlocksPerMultiprocessor(&per_cu, (const void*)fwd_kernel, NWAVES * 64, LDS_BYTES) != hipSuccess || per_cu < 1)
            fprintf(stderr, "kernel_launch: note: occupancy query reports %d workgroups per CU\n", per_cu);
        (void)hipGetLastError();
        grid = cus;
    }
    if (grid < 0) return;
    if (hipMemsetAsync((char*)d_ws + WS_CTL, 0, CTL_ZERO_BYTES, stream) != hipSuccess) { fprintf(stderr, "kernel_launch: memset failed\n"); return; }
    Args a{};
    for (int i = 0; i < 20; ++i) a.in[i] = (const float*)d_in[i];
    a.out = (float*)d_out; a.ws = (unsigned char*)d_ws;
    hipLaunchKernelGGL(fwd_kernel, dim3(grid), dim3(NWAVES * 64), LDS_BYTES, stream, a);
    const hipError_t le = hipPeekAtLastError();
    if (le != hipSuccess) fprintf(stderr, "kernel_launch: launch failed: %s\n", hipGetErrorName(le));
}
```

```cpp
#include <hip/hip_runtime.h>
#include <cstdio>
#include <cstdint>
namespace pg8 {
#define PG8_LAS __attribute__((address_space(3)))
typedef unsigned short bf16_t;
typedef short bf16x8 __attribute__((ext_vector_type(8)));
typedef float f32x4 __attribute__((ext_vector_type(4)));
typedef unsigned u32x4 __attribute__((ext_vector_type(4)));
constexpr int BM = 256, BK = 64, HALF = 128, HTB = HALF * BK * 2  , STAGE_BYTES = 8 * HTB, NXCD = 8, WGM = 8;

__host__ __device__ __forceinline__ int lds_byte(int r, int c) { const int st = (r >> 4) * 2 + (c >> 5), rr = r & 15, cc = c & 31, ob = rr * 64 + cc * 2; return st * 1024 + (ob ^ (((ob >> 9) & 1) << 5)); }
__host__ __device__ __forceinline__ void stage_rc(int b, int& R, int& C) { const int st = b / 1024, sb = b % 1024, swz = sb ^ (((sb >> 9) & 1) << 5); R = (st >> 1) * 16 + swz / 64; C = (st & 1) * 32 + (swz % 64) / 2; }
__host__ __device__ __forceinline__ int perm32(int rho) { const int n = rho >> 4, i = rho & 15; return 8 * (i >> 2) + 4 * n + (i & 3); }

struct Unit { int pm, pn; };
struct Gemm { const bf16_t* A; const bf16_t* Bt; int M, N, K; };

struct StaticOrder {
    int nM, nN, nwg, G, c;
    __host__ __device__ void init(int M, int N, int G_, int c_) { nM = M / BM; nN = N / BM; nwg = nM * nN; G = G_; c = c_; }
    __host__ __device__ bool next(int i, Unit& u) const {
        const long L = (long)i * G + c; if (L >= nwg) return false;
        int wgid = (int)L; { const int q = nwg / NXCD, r = nwg % NXCD, xcd = wgid % NXCD, off = wgid / NXCD; wgid = (xcd < r ? xcd * (q + 1) : r * (q + 1) + (xcd - r) * q) + off; }
        const int nig = WGM * nN, gid = wgid / nig, fm = gid * WGM, gsz = (nM - fm) < WGM ? (nM - fm) : WGM;
        u.pm = fm + ((wgid % nig) % gsz); u.pn = (wgid % nig) / gsz; return true;
    }
    __device__ __forceinline__ void a_ready(const Unit&) const {}
    __device__ __forceinline__ void done(const Unit&) const {}
};
__device__ __forceinline__ unsigned cvt_pk_bf16(float lo, float hi) { unsigned r; asm volatile("v_cvt_pk_bf16_f32 %0, %1, %2" : "=v"(r) : "v"(lo), "v"(hi)); return r; }
typedef float f32x2 __attribute__((ext_vector_type(2)));

struct DynTailOrder : StaticOrder {
    unsigned* ctr; volatile PG8_LAS unsigned* slot; int nfull, rem;
    __device__ void init2(int M, int N, int G_, int c_, unsigned* ctr_, volatile PG8_LAS unsigned* slot_) { init(M, N, G_, c_); ctr = ctr_; slot = slot_; nfull = nwg / G_; rem = nwg % G_; }
    __device__ __forceinline__ bool next(int i, Unit& u) const {
        if (i < nfull) return StaticOrder::next(i, u);
        if (i > nfull || rem == 0) return false;
        if (threadIdx.x < 64) {
            unsigned t = 0u; if (threadIdx.x == 0) t = __hip_atomic_fetch_add(ctr, 1u, __ATOMIC_RELAXED, __HIP_MEMORY_SCOPE_AGENT);
            asm volatile("s_waitcnt vmcnt(0)" ::: "memory");
            if (threadIdx.x == 0) *slot = t;
            asm volatile("s_waitcnt lgkmcnt(0)" ::: "memory");
        }
        asm volatile("" ::: "memory"); __builtin_amdgcn_s_barrier(); asm volatile("" ::: "memory");
        const unsigned t = *slot;
        if (t >= (unsigned)rem) return false;
        StaticOrder tmp = *this; tmp.c = (int)t; return tmp.StaticOrder::next(nfull, u);
    }
};
struct DynRoundsOrder : StaticOrder {
    unsigned* ctr; volatile PG8_LAS unsigned* slot; int nstat;
    __device__ void init2(int M, int N, int G_, int c_, unsigned* ctr_, volatile PG8_LAS unsigned* slot_, int R) { init(M, N, G_, c_); ctr = ctr_; slot = slot_; nstat = nwg / G_ - R; if (nstat < 0) nstat = 0; }
    __device__ __forceinline__ bool next(int i, Unit& u) const {
        if (i < nstat) return StaticOrder::next(i, u);
        const int q = nwg / NXCD, base = nstat * (G / NXCD);
        if (threadIdx.x < 64) {
            unsigned code = 0xffffffffu;
            if (threadIdx.x == 0) {
                const int x0 = c % NXCD;
                for (int k = 0; k < NXCD; ++k) { const int x = (x0 + k) % NXCD;
                    const unsigned t = __hip_atomic_fetch_add(ctr + 64 * x, 1u, __ATOMIC_RELAXED, __HIP_MEMORY_SCOPE_AGENT);
                    const int off = base + (int)t; if (off < q) { code = (unsigned)(x * q + off); break; } }
            }
            asm volatile("s_waitcnt vmcnt(0)" ::: "memory");
            if (threadIdx.x == 0) *slot = code;
            asm volatile("s_waitcnt lgkmcnt(0)" ::: "memory");
        }
        asm volatile("" ::: "memory"); __builtin_amdgcn_s_barrier(); asm volatile("" ::: "memory");
        const unsigned code = *slot;
        if (code == 0xffffffffu) return false;
        const int wgid = (int)code;
        const int nig = WGM * nN, gid = wgid / nig, fm = gid * WGM, gsz = (nM - fm) < WGM ? (nM - fm) : WGM;
        u.pm = fm + ((wgid % nig) % gsz); u.pn = (wgid % nig) / gsz; return true;
    }
};
struct PoolOrder {
    int G, c;
    __device__ __forceinline__ bool next(int i, Unit& u) const {
        const int L = i * G + c; if (L >= 768) return false;
        const int g = L / 192, r = L % 192; u.pm = g * 96 + (r >> 1); u.pn = g * 2 + (r & 1); return true;
    }
    __device__ __forceinline__ void a_ready(const Unit&) const {}
    __device__ __forceinline__ void done(const Unit&) const {}
};
typedef unsigned u32x2 __attribute__((ext_vector_type(2)));
__device__ __forceinline__ void st8(bf16_t* p, const f32x4 v0, const f32x4 v1) {
    u32x4 w; w.x = cvt_pk_bf16(v0[0], v0[1]); w.y = cvt_pk_bf16(v0[2], v0[3]); w.z = cvt_pk_bf16(v1[0], v1[1]); w.w = cvt_pk_bf16(v1[2], v1[3]);
    *(u32x4*)p = w;
}
__device__ __forceinline__ void ld8(const bf16_t* p, f32x4& v0, f32x4& v1) {
    const u32x4 w = *(const u32x4*)p;
    v0[0] = __uint_as_float(w.x << 16); v0[1] = __uint_as_float(w.x & 0xffff0000u); v0[2] = __uint_as_float(w.y << 16); v0[3] = __uint_as_float(w.y & 0xffff0000u);
    v1[0] = __uint_as_float(w.z << 16); v1[1] = __uint_as_float(w.z & 0xffff0000u); v1[2] = __uint_as_float(w.w << 16); v1[3] = __uint_as_float(w.w & 0xffff0000u);
}
__device__ __forceinline__ float sigmoidf_(float x) { return __builtin_amdgcn_rcpf(1.0f + __expf(-x)); }
__device__ __forceinline__ f32x4 sig4(const f32x4 x) { f32x4 r; r[0] = sigmoidf_(x[0]); r[1] = sigmoidf_(x[1]); r[2] = sigmoidf_(x[2]); r[3] = sigmoidf_(x[3]); return r; }

struct EpiBf {
    static constexpr bool PERM = true, AFTER_DRAIN = false;
    bf16_t* O; int ldc;
    __device__ __forceinline__ void operator()(const f32x4 (&acc)[2][2][4][2], const Unit& u, int wr, int wc, int fr_in, int fq_in) const {
        int fr = fr_in, fq = fq_in; asm volatile("" : "+v"(fr), "+v"(fq));
        const int row0 = u.pm * BM + wr * 64 + fr, col0 = u.pn * BM + wc * 32 + 8 * fq;
#pragma unroll
        for (int ai = 0; ai < 2; ++ai)
#pragma unroll
            for (int m = 0; m < 4; ++m) { bf16_t* rowp = O + (size_t)(row0 + ai * HALF + m * 16) * ldc + col0;
#pragma unroll
                for (int bj = 0; bj < 2; ++bj) st8(rowp + bj * HALF, acc[ai][bj][m][0], acc[ai][bj][m][1]); }
    }
};
struct EpiKV {
    static constexpr bool PERM = true, AFTER_DRAIN = false;
    bf16_t *KN, *VH;
    __device__ __forceinline__ void operator()(const f32x4 (&acc)[2][2][4][2], const Unit& u, int wr, int wc, int fr_in, int fq_in) const {
        int fr = fr_in, fq = fq_in; asm volatile("" : "+v"(fr), "+v"(fq));
        const int rl0 = wr * 64 + fr, c0 = wc * 32 + 8 * fq, sq = u.pm >> 5, t0 = (u.pm & 31) * BM;
        bf16_t* kn = KN + (size_t)u.pm * BM * 2048 + u.pn * 128 + c0;
        bf16_t* vh = VH + ((size_t)(sq * 16 + u.pn) * 8192 + t0) * 128 + c0;
#pragma unroll
        for (int ai = 0; ai < 2; ++ai)
#pragma unroll
            for (int m = 0; m < 4; ++m) { const int rl = rl0 + ai * HALF + m * 16;
                st8(kn + (size_t)rl * 2048, acc[ai][0][m][0], acc[ai][0][m][1]);
                st8(vh + (size_t)rl * 128, acc[ai][1][m][0], acc[ai][1][m][1]); }
    }
};
struct EpiKV8 {
    static constexpr bool PERM = true, AFTER_DRAIN = false;
    bf16_t *KN, *VH; float cs;
    __device__ __forceinline__ void operator()(const f32x4 (&acc)[2][2][4][2], const Unit& u, int wr, int wc, int fr_in, int fq_in) const {
        int fr = fr_in, fq = fq_in; asm volatile("" : "+v"(fr), "+v"(fq));
        const int rl0 = wr * 64 + fr, c0 = wc * 32 + 8 * fq, sq = u.pm >> 5, t0 = (u.pm & 31) * BM;
        bf16_t* kn = KN + (size_t)u.pm * BM * 2048 + u.pn * 128 + c0;
        bf16_t* vh = VH + ((size_t)(sq * 16 + u.pn) * 8192 + t0) * 128 + c0;
#pragma unroll
        for (int ai = 0; ai < 2; ++ai)
#pragma unroll
            for (int m = 0; m < 4; ++m) { const int rl = rl0 + ai * HALF + m * 16;
                st8(kn + (size_t)rl * 2048, acc[ai][0][m][0] * cs, acc[ai][0][m][1] * cs);
                st8(vh + (size_t)rl * 128, acc[ai][1][m][0] * cs, acc[ai][1][m][1] * cs); }
    }
};
struct EpiZa {
    static constexpr bool PERM = true, AFTER_DRAIN = false;
    bf16_t *ZA, *ZG;
    __device__ __forceinline__ void operator()(const f32x4 (&acc)[2][2][4][2], const Unit& u, int wr, int wc, int fr_in, int fq_in) const {
        int fr = fr_in, fq = fq_in; asm volatile("" : "+v"(fr), "+v"(fq));
        bf16_t* base; int ldc, colt;
        if (u.pn < 8) { base = ZA; ldc = 3584; colt = u.pn * 256; } else { base = ZG; ldc = 8192; colt = (u.pn - 8) * 256; }
        const int row0 = u.pm * BM + wr * 64 + fr, col0 = colt + wc * 32 + 8 * fq;
#pragma unroll
        for (int ai = 0; ai < 2; ++ai)
#pragma unroll
            for (int m = 0; m < 4; ++m) { bf16_t* rowp = base + (size_t)(row0 + ai * HALF + m * 16) * ldc + col0;
#pragma unroll
                for (int bj = 0; bj < 2; ++bj) st8(rowp + bj * HALF, acc[ai][bj][m][0], acc[ai][bj][m][1]); }
    }
};
struct EpiZb {
    static constexpr bool PERM = true, AFTER_DRAIN = false;
    bf16_t *ZA, *ZG, *ZK; float cs;
    __device__ __forceinline__ void operator()(const f32x4 (&acc)[2][2][4][2], const Unit& u, int wr, int wc, int fr_in, int fq_in) const {
        int fr = fr_in, fq = fq_in; asm volatile("" : "+v"(fr), "+v"(fq));
        bf16_t* base; int ldc, colt;
        if (u.pn < 6) { base = ZA; ldc = 3584; colt = 2048 + u.pn * 256; } else if (u.pn < 22) { base = ZG; ldc = 8192; colt = 4096 + (u.pn - 6) * 256; } else if (u.pn == 22) { base = ZK; ldc = 256; colt = 0; }
        else { base = ZG; ldc = 8192; colt = (u.pn - 23) * 256; }
        const int row0 = u.pm * BM + wr * 64 + fr, col0 = colt + wc * 32 + 8 * fq;
#pragma unroll
        for (int ai = 0; ai < 2; ++ai)
#pragma unroll
            for (int m = 0; m < 4; ++m) { bf16_t* rowp = base + (size_t)(row0 + ai * HALF + m * 16) * ldc + col0;
#pragma unroll
                for (int bj = 0; bj < 2; ++bj) st8(rowp + bj * HALF, acc[ai][bj][m][0] * cs, acc[ai][bj][m][1] * cs); }
    }
};
struct EpiZ {
    static constexpr bool PERM = true, AFTER_DRAIN = false;
    bf16_t *ZA, *ZG, *ZK;
    __device__ __forceinline__ void operator()(const f32x4 (&acc)[2][2][4][2], const Unit& u, int wr, int wc, int fr_in, int fq_in) const {
        int fr = fr_in, fq = fq_in; asm volatile("" : "+v"(fr), "+v"(fq));
        bf16_t* base; int ldc, colt;
        if (u.pn < 14) { base = ZA; ldc = 3584; colt = u.pn * 256; } else if (u.pn < 46) { base = ZG; ldc = 8192; colt = (u.pn - 14) * 256; } else { base = ZK; ldc = 256; colt = 0; }
        const int row0 = u.pm * BM + wr * 64 + fr, col0 = colt + wc * 32 + 8 * fq;
#pragma unroll
        for (int ai = 0; ai < 2; ++ai)
#pragma unroll
            for (int m = 0; m < 4; ++m) { bf16_t* rowp = base + (size_t)(row0 + ai * HALF + m * 16) * ldc + col0;
#pragma unroll
                for (int bj = 0; bj < 2; ++bj) st8(rowp + bj * HALF, acc[ai][bj][m][0], acc[ai][bj][m][1]); }
    }
};
struct EpiPool {
    static constexpr bool PERM = true, AFTER_DRAIN = false;
    bf16_t* O; const float* scale;
    __device__ __forceinline__ void operator()(const f32x4 (&acc)[2][2][4][2], const Unit& u, int wr, int wc, int fr_in, int fq_in) const {
        int fr = fr_in, fq = fq_in; asm volatile("" : "+v"(fr), "+v"(fq));
        const int g = u.pm / 96, row0 = (u.pm % 96) * BM + wr * 64 + fr, col0 = g * 512 + (u.pn & 1) * 256 + wc * 32 + 8 * fq;
        f32x4 sv[2][2];
#pragma unroll
        for (int bj = 0; bj < 2; ++bj)
#pragma unroll
            for (int n = 0; n < 2; ++n) sv[bj][n] = *(const f32x4*)(scale + col0 + bj * HALF + 4 * n);
#pragma unroll
        for (int ai = 0; ai < 2; ++ai)
#pragma unroll
            for (int m = 0; m < 4; ++m) { bf16_t* rowp = O + (size_t)(row0 + ai * HALF + m * 16) * 2048 + col0;
#pragma unroll
                for (int bj = 0; bj < 2; ++bj) st8(rowp + bj * HALF, acc[ai][bj][m][0] * sv[bj][0], acc[ai][bj][m][1] * sv[bj][1]); }
    }
};
struct EpiGateA {
    static constexpr bool PERM = true, AFTER_DRAIN = false;
    bf16_t* T; const bf16_t* ZG;
    __device__ __forceinline__ void operator()(const f32x4 (&acc)[2][2][4][2], const Unit& u, int wr, int wc, int fr_in, int fq_in) const {
        int fr = fr_in, fq = fq_in; asm volatile("" : "+v"(fr), "+v"(fq));
        const int row0 = u.pm * BM + wr * 64 + fr, col0 = u.pn * BM + wc * 32 + 8 * fq;
#pragma unroll
        for (int ai = 0; ai < 2; ++ai)
#pragma unroll
            for (int m = 0; m < 4; ++m) { const size_t r = (size_t)(row0 + ai * HALF + m * 16);
#pragma unroll
                for (int bj = 0; bj < 2; ++bj) { f32x4 g0, g1; ld8(ZG + r * 8192 + col0 + bj * HALF, g0, g1);
                    st8(T + r * 4096 + col0 + bj * HALF, acc[ai][bj][m][0] * sig4(g0), acc[ai][bj][m][1] * sig4(g1)); } }
    }
};
struct EpiGateB {
    static constexpr bool PERM = true, AFTER_DRAIN = false;
    const bf16_t* T; bf16_t* Mo; const bf16_t* ZG;
    __device__ __forceinline__ void operator()(const f32x4 (&acc)[2][2][4][2], const Unit& u, int wr, int wc, int fr_in, int fq_in) const {
        int fr = fr_in, fq = fq_in; asm volatile("" : "+v"(fr), "+v"(fq));
        const int row0 = u.pm * BM + wr * 64 + fr, col0 = u.pn * BM + wc * 32 + 8 * fq;
#pragma unroll
        for (int ai = 0; ai < 2; ++ai)
#pragma unroll
            for (int m = 0; m < 4; ++m) { const size_t r = (size_t)(row0 + ai * HALF + m * 16);
#pragma unroll
                for (int bj = 0; bj < 2; ++bj) { f32x4 g0, g1, t0, t1; ld8(ZG + r * 8192 + 4096 + col0 + bj * HALF, g0, g1); ld8(T + r * 4096 + col0 + bj * HALF, t0, t1);
                    st8(Mo + r * 4096 + col0 + bj * HALF, t0 + acc[ai][bj][m][0] * sig4(g0), t1 + acc[ai][bj][m][1] * sig4(g1)); } }
    }
};
struct EpiGateB8 {
    static constexpr bool PERM = true, AFTER_DRAIN = false;
    const bf16_t* T; bf16_t* Mo; const bf16_t* ZG; float cs;
    __device__ __forceinline__ void operator()(const f32x4 (&acc)[2][2][4][2], const Unit& u, int wr, int wc, int fr_in, int fq_in) const {
        int fr = fr_in, fq = fq_in; asm volatile("" : "+v"(fr), "+v"(fq));
        const int row0 = u.pm * BM + wr * 64 + fr, col0 = u.pn * BM + wc * 32 + 8 * fq;
#pragma unroll
        for (int ai = 0; ai < 2; ++ai)
#pragma unroll
            for (int m = 0; m < 4; ++m) { const size_t r = (size_t)(row0 + ai * HALF + m * 16);
#pragma unroll
                for (int bj = 0; bj < 2; ++bj) { f32x4 g0, g1, t0, t1; ld8(ZG + r * 8192 + 4096 + col0 + bj * HALF, g0, g1); ld8(T + r * 4096 + col0 + bj * HALF, t0, t1);
                    st8(Mo + r * 4096 + col0 + bj * HALF, t0 + acc[ai][bj][m][0] * (sig4(g0) * cs), t1 + acc[ai][bj][m][1] * (sig4(g1) * cs)); } }
    }
};
__device__ __forceinline__ float qsum16(float v) { auto r = __builtin_amdgcn_permlane16_swap(__float_as_uint(v), __float_as_uint(v), false, false); return __uint_as_float(r[0]) + __uint_as_float(r[1]); }
__device__ __forceinline__ float qsum32(float v) { auto r = __builtin_amdgcn_permlane32_swap(__float_as_uint(v), __float_as_uint(v), false, false); return __uint_as_float(r[0]) + __uint_as_float(r[1]); }
struct EpiX1 {
    static constexpr bool PERM = true, AFTER_DRAIN = false;
    const float *xp, *xs; bf16_t* X1; float* rowss;
    __device__ __forceinline__ void operator()(const f32x4 (&acc)[2][2][4][2], const Unit& u, int wr, int wc, int fr_in, int fq_in) const {
        int fr = fr_in, fq = fq_in; asm volatile("" : "+v"(fr), "+v"(fq));
        const float* xb = (u.pm < 64) ? xp + (size_t)u.pm * BM * 4096 : xs + (size_t)(u.pm - 64) * BM * 4096;
        const int rl0 = wr * 64 + fr, col0 = u.pn * BM + wc * 32 + 8 * fq;
        float ssr[2][4];
#pragma unroll
        for (int ai = 0; ai < 2; ++ai)
#pragma unroll
            for (int m = 0; m < 4; ++m) { const int rl = rl0 + ai * HALF + m * 16; const size_t off = (size_t)rl * 4096 + col0; float ss = 0.f;
#pragma unroll
                for (int bj = 0; bj < 2; ++bj) { const f32x4 v0 = *(const f32x4*)(xb + off + bj * HALF) + acc[ai][bj][m][0], v1 = *(const f32x4*)(xb + off + bj * HALF + 4) + acc[ai][bj][m][1];
                    ss += (v0[0] * v0[0] + v0[1] * v0[1]) + (v0[2] * v0[2] + v0[3] * v0[3]) + (v1[0] * v1[0] + v1[1] * v1[1]) + (v1[2] * v1[2] + v1[3] * v1[3]);
                    st8(X1 + (size_t)u.pm * BM * 4096 + off + bj * HALF, v0, v1); }
                ssr[ai][m] = ss;
                asm volatile("" ::: "memory"); }
#pragma unroll
        for (int ai = 0; ai < 2; ++ai)
#pragma unroll
            for (int m = 0; m < 4; ++m) { const float ss = qsum32(qsum16(ssr[ai][m]));
                if (fq == 0) __hip_atomic_fetch_add(rowss + u.pm * BM + rl0 + ai * HALF + m * 16, ss, __ATOMIC_RELAXED, __HIP_MEMORY_SCOPE_AGENT); }
    }
};
struct EpiOutX1 {
    static constexpr bool PERM = false, AFTER_DRAIN = false;
    const bf16_t* X1; float* out;
    __device__ __forceinline__ void operator()(const f32x4 (&acc)[2][2][4][2], const Unit& u, int wr, int wc, int fr_in, int fq_in) const {
        int fr = fr_in, fq = fq_in; asm volatile("" : "+v"(fr), "+v"(fq));
        const bf16_t* xb = X1 + (size_t)u.pm * BM * 4096; float* ob = out + (size_t)u.pm * BM * 4096;
        const int rl0 = wr * 64 + fr, col0 = u.pn * BM + wc * 32 + 4 * fq;
#pragma unroll
        for (int ai = 0; ai < 2; ++ai)
#pragma unroll
            for (int m = 0; m < 4; ++m) { const size_t off = (size_t)(rl0 + ai * HALF + m * 16) * 4096 + col0;
#pragma unroll
                for (int bj = 0; bj < 2; ++bj)
#pragma unroll
                    for (int n = 0; n < 2; ++n) { const u32x2 w = *(const u32x2*)(xb + off + bj * HALF + n * 16);
                        const f32x4 xv = {__uint_as_float(w.x << 16), __uint_as_float(w.x & 0xffff0000u), __uint_as_float(w.y << 16), __uint_as_float(w.y & 0xffff0000u)};
                        *(f32x4*)(ob + off + bj * HALF + n * 16) = xv + acc[ai][bj][m][n]; }
                asm volatile("" ::: "memory"); }
    }
};
struct EpiResX {
    static constexpr bool PERM = false, AFTER_DRAIN = false;
    const float *xp, *xs; float* out;
    __device__ __forceinline__ void operator()(const f32x4 (&acc)[2][2][4][2], const Unit& u, int wr, int wc, int fr_in, int fq_in) const {
        int fr = fr_in, fq = fq_in; asm volatile("" : "+v"(fr), "+v"(fq));
        const float* xb = (u.pm < 64) ? xp + (size_t)u.pm * BM * 4096 : xs + (size_t)(u.pm - 64) * BM * 4096;
        float* ob = out + (size_t)u.pm * BM * 4096;
        const int rl0 = wr * 64 + fr, col0 = u.pn * BM + wc * 32 + 4 * fq;
#pragma unroll
        for (int ai = 0; ai < 2; ++ai)
#pragma unroll
            for (int m = 0; m < 4; ++m) { const size_t off = (size_t)(rl0 + ai * HALF + m * 16) * 4096 + col0;
#pragma unroll
                for (int bj = 0; bj < 2; ++bj)
#pragma unroll
                    for (int n = 0; n < 2; ++n) { const f32x4 xv = *(const f32x4*)(xb + off + bj * HALF + n * 16); *(f32x4*)(ob + off + bj * HALF + n * 16) = xv + acc[ai][bj][m][n]; }
                asm volatile("" ::: "memory"); }
    }
};
struct EpiResOut {
    static constexpr bool PERM = false, AFTER_DRAIN = false;
    float* out;
    __device__ __forceinline__ void operator()(const f32x4 (&acc)[2][2][4][2], const Unit& u, int wr, int wc, int fr_in, int fq_in) const {
        int fr = fr_in, fq = fq_in; asm volatile("" : "+v"(fr), "+v"(fq));
        float* ob = out + (size_t)u.pm * BM * 4096;
        const int rl0 = wr * 64 + fr, col0 = u.pn * BM + wc * 32 + 4 * fq;
#pragma unroll
        for (int ai = 0; ai < 2; ++ai)
#pragma unroll
            for (int m = 0; m < 4; ++m) { const size_t off = (size_t)(rl0 + ai * HALF + m * 16) * 4096 + col0;
#pragma unroll
                for (int bj = 0; bj < 2; ++bj)
#pragma unroll
                    for (int n = 0; n < 2; ++n) { const f32x4 xv = *(const f32x4*)(ob + off + bj * HALF + n * 16); *(f32x4*)(ob + off + bj * HALF + n * 16) = xv + acc[ai][bj][m][n]; }
                asm volatile("" ::: "memory"); }
    }
};

__device__ __forceinline__ float silu_(float x) { return x * __builtin_amdgcn_rcpf(1.0f + __builtin_amdgcn_exp2f(-1.4426950408889634f * x)); }
constexpr int CONV_SLICE_BYTES = 66 * 32;
__device__ __forceinline__ void st4(bf16_t* p, const f32x4 v) { u32x2 w; w.x = cvt_pk_bf16(v[0], v[1]); w.y = cvt_pk_bf16(v[2], v[3]); *(u32x2*)p = w; }
struct EpiConvGlu {
    static constexpr bool PERM = false, AFTER_DRAIN = false;
    bf16_t* ACT; bf16_t* SIDE; const float* cw; const float* cb; PG8_LAS unsigned char* scr; const float* rowss;
    __device__ __forceinline__ void conv4(const f32x4 (&a)[4][2], int n, const float* wp, const float* bp, PG8_LAS unsigned char* sl, f32x4 (&out)[4]) const {
        const f32x4 w0 = *(const f32x4*)(wp), w1 = *(const f32x4*)(wp + 22016), w2 = *(const f32x4*)(wp + 2 * 22016), bb = *(const f32x4*)(bp);
#pragma unroll
        for (int m = 0; m < 4; ++m) { u32x2 w; w.x = cvt_pk_bf16(a[m][n][0], a[m][n][1]); w.y = cvt_pk_bf16(a[m][n][2], a[m][n][3]); *(PG8_LAS u32x2*)(sl + m * 512) = w; }
        asm volatile("s_waitcnt lgkmcnt(0)" ::: "memory");
        u32x2 pv[4], nx[4];
#pragma unroll
        for (int m = 0; m < 4; ++m) { pv[m] = *(const PG8_LAS u32x2*)(sl + m * 512 - 32); nx[m] = *(const PG8_LAS u32x2*)(sl + m * 512 + 32); }
        asm volatile("s_waitcnt lgkmcnt(0)" ::: "memory");
#pragma unroll
        for (int m = 0; m < 4; ++m) {
            const float p[4] = {__uint_as_float(pv[m].x << 16), __uint_as_float(pv[m].x & 0xffff0000u), __uint_as_float(pv[m].y << 16), __uint_as_float(pv[m].y & 0xffff0000u)};
            const float q[4] = {__uint_as_float(nx[m].x << 16), __uint_as_float(nx[m].x & 0xffff0000u), __uint_as_float(nx[m].y << 16), __uint_as_float(nx[m].y & 0xffff0000u)};
#pragma unroll
            for (int i = 0; i < 4; ++i) out[m][i] = fmaf(w0[i], p[i], fmaf(w1[i], a[m][n][i], fmaf(w2[i], q[i], bb[i])));
        }
    }
    __device__ __forceinline__ void operator()(f32x4 (&acc)[2][2][4][2], const Unit& u, int wr, int wc, int fr_in, int fq_in) const {
        int fr = fr_in, fq = fq_in; asm volatile("" : "+v"(fr), "+v"(fq));
#pragma unroll
        for (int ai = 0; ai < 2; ++ai)
#pragma unroll
            for (int m = 0; m < 4; ++m) { const float rs = 1.0f / sqrtf(rowss[u.pm * BM + ai * HALF + wr * 64 + m * 16 + fr] * (1.f / 4096.f) + 1e-6f);
#pragma unroll
                for (int bj = 0; bj < 2; ++bj)
#pragma unroll
                    for (int n = 0; n < 2; ++n) acc[ai][bj][m][n] *= rs; }
        const int chan0 = u.pn * 128 + wc * 32 + 4 * fq;
        const bool e0 = (fr == 0), e15 = (fr == 15);
        PG8_LAS unsigned char* sl = scr + (wr * 4 + wc) * CONV_SLICE_BYTES + (1 + fr) * 32 + fq * 8;
#pragma unroll
        for (int ai = 0; ai < 2; ++ai) {
            const int blk = u.pm * 4 + ai * 2 + wr;
#pragma unroll
            for (int bj = 0; bj < 2; ++bj)
#pragma unroll
                for (int n = 0; n < 2; ++n) { const int col = u.pn * 256 + bj * 128 + wc * 32 + 16 * n + 4 * fq;
                    if (fr < 2) st4(SIDE + ((size_t)blk * 4 + fr) * 22016 + col, acc[ai][bj][0][n]);
                    if (fr >= 14) st4(SIDE + ((size_t)blk * 4 + (fr - 12)) * 22016 + col, acc[ai][bj][3][n]); }
#pragma unroll
            for (int n = 0; n < 2; ++n) {
                f32x4 cg[4], cv[4];
                asm volatile("" ::: "memory");
                conv4(acc[ai][0], n, cw + chan0 + 16 * n, cb + chan0 + 16 * n, sl, cg);
                conv4(acc[ai][1], n, cw + 11008 + chan0 + 16 * n, cb + 11008 + chan0 + 16 * n, sl, cv);
#pragma unroll
                for (int m = 0; m < 4; ++m) {
                    f32x4 r;
#pragma unroll
                    for (int i = 0; i < 4; ++i) r[i] = silu_(cg[m][i]) * cv[m][i];
                    const bool skip = (m == 0 && e0) || (m == 3 && e15);
                    if (!skip) st4(ACT + (size_t)(u.pm * BM + ai * HALF + wr * 64 + m * 16 + fr) * 11008 + chan0 + 16 * n, r);
                }
            }
        }
    }
};
typedef int pg8_v8i __attribute__((ext_vector_type(8)));
typedef int pg8_v4i __attribute__((ext_vector_type(4)));
__device__ __forceinline__ f32x4 pg8_mfma128(const bf16x8 a0, const bf16x8 a1, const bf16x8 b0, const bf16x8 b1, const f32x4 c, int sc) {
    const pg8_v4i x0 = __builtin_bit_cast(pg8_v4i, a0), x1 = __builtin_bit_cast(pg8_v4i, a1), y0 = __builtin_bit_cast(pg8_v4i, b0), y1 = __builtin_bit_cast(pg8_v4i, b1);
    const pg8_v8i a = {x0.x, x0.y, x0.z, x0.w, x1.x, x1.y, x1.z, x1.w}, b = {y0.x, y0.y, y0.z, y0.w, y1.x, y1.y, y1.z, y1.w};
    f32x4 d = c;
    asm volatile("v_mfma_scale_f32_16x16x128_f8f6f4 %0, %1, %2, %0, %3, %3 op_sel_hi:[0,0,0]" : "+v"(d) : "v"(a), "v"(b), "v"(sc));
    return d;
}
template <class Epi, class Sched, bool ALIGN_EPI = false, bool SP2 = false, bool FP8 = false>
__device__ __forceinline__ void gemm_phase(PG8_LAS unsigned char* lds, const Gemm g, const Sched& S, const Epi& E) {
    int tid_l = threadIdx.x; asm volatile("" : "+v"(tid_l));
    const int tid = tid_l, wid = __builtin_amdgcn_readfirstlane(tid >> 6), lane = tid & 63, wr = wid >> 2, wc = wid & 3, fr = lane & 15, fq = lane >> 4;
    const int K = g.K, nt = K / BK;
    int f8sc = 0x7f7f7f7f; if constexpr (FP8) asm volatile("" : "+v"(f8sc)); (void)f8sc;
    unsigned voffA[2], voffB[2];
#pragma unroll
    for (int i = 0; i < 2; ++i) { int R, C; stage_rc(tid * 16 + i * 8192, R, C); const int Rb = Epi::PERM ? ((R & ~31) + perm32(R & 31)) : R;
        voffA[i] = (unsigned)(R * K + C) * 2u; voffB[i] = (unsigned)(Rb * K + C) * 2u; }
    const size_t kstep = (size_t)(BK * 2);
    const size_t hstep = (size_t)HALF * K * 2;
    const size_t tstep = 2 * hstep;
    const unsigned ldsw = (unsigned)wid * 1024u;
    const int aoff = lds_byte(wr * 64 + fr, fq * 8), boff = lds_byte(wc * 32 + fr, fq * 8);
#define PG8_SA(b, h) (((b) * 2 + (h)) * HTB)
#define PG8_SB(b, h) ((4 + (b) * 2 + (h)) * HTB)
#define PG8_STAGE(bufoff, gbase, voff) do { _Pragma("unroll") for (int _i = 0; _i < 2; ++_i) \
        __builtin_amdgcn_global_load_lds((const unsigned*)((const char*)(gbase) + (voff)[_i]), (PG8_LAS unsigned*)(lds + (bufoff) + ldsw + _i * 8192), 16, 0, 0); } while (0)
#define PG8_LDA(dst, b, h) do { _Pragma("unroll") for (int m = 0; m < 4; ++m) _Pragma("unroll") for (int k = 0; k < 2; ++k) dst[m][k] = *(const PG8_LAS bf16x8*)(lds + PG8_SA(b, h) + aoff + m * 2048 + k * 1024); } while (0)
#define PG8_LDB(dst, b, h) do { _Pragma("unroll") for (int n = 0; n < 2; ++n) _Pragma("unroll") for (int k = 0; k < 2; ++k) dst[n][k] = *(const PG8_LAS bf16x8*)(lds + PG8_SB(b, h) + boff + n * 2048 + k * 1024); } while (0)
#define PG8_MMA(ai, bj, At, Bt) do { __builtin_amdgcn_s_setprio(1); \
        if constexpr (FP8) { _Pragma("unroll") for (int m = 0; m < 4; ++m) _Pragma("unroll") for (int n = 0; n < 2; ++n) \
            acc[ai][bj][m][n] = pg8_mfma128(Bt[n][0], Bt[n][1], At[m][0], At[m][1], acc[ai][bj][m][n], f8sc); } \
        else { _Pragma("unroll") for (int m = 0; m < 4; ++m) _Pragma("unroll") for (int n = 0; n < 2; ++n) _Pragma("unroll") for (int k = 0; k < 2; ++k) \
            acc[ai][bj][m][n] = __builtin_amdgcn_mfma_f32_16x16x32_bf16(Bt[n][k], At[m][k], acc[ai][bj][m][n], 0, 0, 0); } \
        __builtin_amdgcn_s_setprio(0); } while (0)
#define PG8_WAIT_V(n) asm volatile("s_waitcnt vmcnt(" #n ")" ::: "memory")
#define PG8_WAIT_L(n) asm volatile("s_waitcnt lgkmcnt(" #n ")" ::: "memory")
#define PG8_BAR __builtin_amdgcn_s_barrier()
#define PG8_SCHED __builtin_amdgcn_sched_barrier(0)
    Unit cur, nxt; int ui = 0;
    if (!S.next(0, cur)) return;
    f32x4 acc[2][2][4][2];
#pragma unroll
    for (int a = 0; a < 2; ++a)
#pragma unroll
        for (int b = 0; b < 2; ++b)
#pragma unroll
            for (int m = 0; m < 4; ++m)
#pragma unroll
                for (int n = 0; n < 2; ++n) acc[a][b][m][n] = (f32x4){0.f, 0.f, 0.f, 0.f};
    bf16x8 At[4][2], B0[2][2], B1[2][2];
    const char* cA = (const char*)g.A + (size_t)cur.pm * tstep; const char* cB = (const char*)g.Bt + (size_t)cur.pn * tstep;
    S.a_ready(cur);
    if constexpr (SP2) {
        PG8_STAGE(PG8_SB(0, 0), cB, voffB); PG8_STAGE(PG8_SB(0, 1), cB + hstep, voffB); PG8_STAGE(PG8_SA(0, 0), cA, voffA); PG8_STAGE(PG8_SA(0, 1), cA + hstep, voffA);
        if (wr == 1) PG8_BAR;
        PG8_WAIT_V(2); PG8_BAR;
        PG8_STAGE(PG8_SB(1, 0), cB + kstep, voffB); PG8_STAGE(PG8_SA(1, 0), cA + kstep, voffA); PG8_STAGE(PG8_SB(1, 1), cB + hstep + kstep, voffB);
        PG8_WAIT_V(6); PG8_BAR;
    } else {
        PG8_STAGE(PG8_SB(0, 0), cB, voffB); PG8_STAGE(PG8_SA(0, 0), cA, voffA); PG8_STAGE(PG8_SB(0, 1), cB + hstep, voffB); PG8_STAGE(PG8_SA(0, 1), cA + hstep, voffA);
        if (wr == 1) PG8_BAR;
        PG8_WAIT_V(4); PG8_BAR;
        PG8_STAGE(PG8_SB(1, 0), cB + kstep, voffB); PG8_STAGE(PG8_SA(1, 0), cA + kstep, voffA); PG8_STAGE(PG8_SB(1, 1), cB + hstep + kstep, voffB);
        PG8_WAIT_V(6); PG8_BAR;
    }
    for (;;) {
        const bool has_next = S.next(ui + 1, nxt);
        const char* nA = has_next ? (const char*)g.A + (size_t)nxt.pm * tstep : cA; const char* nB = has_next ? (const char*)g.Bt + (size_t)nxt.pn * tstep : cB;
        for (int t = 0; t < nt; t += 2) {
            const bool last = (t == nt - 2);
            const char* a1 = cA + (size_t)(t + 1) * kstep;
            const char* a2 = last ? nA : cA + (size_t)(t + 2) * kstep; const char* b2 = last ? nB : cB + (size_t)(t + 2) * kstep;
            const char* a3 = a2 + kstep; const char* b3 = b2 + kstep;
            if (last && has_next) S.a_ready(nxt);
            if constexpr (SP2) {
            PG8_LDB(B0, 0, 0); PG8_LDB(B1, 0, 1); PG8_SCHED; PG8_LDA(At, 0, 0); PG8_STAGE(PG8_SA(1, 1), a1 + hstep, voffA);
            PG8_WAIT_V(8); PG8_WAIT_L(0); PG8_BAR; PG8_MMA(0, 0, At, B0); PG8_MMA(0, 1, At, B1); PG8_BAR; PG8_SCHED;
            PG8_LDA(At, 0, 1); PG8_STAGE(PG8_SB(0, 0), b2, voffB); PG8_STAGE(PG8_SB(0, 1), b2 + hstep, voffB); PG8_STAGE(PG8_SA(0, 0), a2, voffA);
            PG8_WAIT_V(8); PG8_WAIT_L(0); PG8_BAR; PG8_MMA(1, 0, At, B0); PG8_MMA(1, 1, At, B1); PG8_BAR; PG8_SCHED;
            PG8_LDB(B0, 1, 0); PG8_LDB(B1, 1, 1); PG8_SCHED; PG8_LDA(At, 1, 0); PG8_STAGE(PG8_SA(0, 1), a2 + hstep, voffA);
            PG8_WAIT_V(8); PG8_WAIT_L(0); PG8_BAR; PG8_MMA(0, 0, At, B0); PG8_MMA(0, 1, At, B1); PG8_BAR; PG8_SCHED;
            PG8_LDA(At, 1, 1); PG8_STAGE(PG8_SB(1, 0), b3, voffB); PG8_STAGE(PG8_SB(1, 1), b3 + hstep, voffB); PG8_STAGE(PG8_SA(1, 0), a3, voffA);
            PG8_WAIT_V(8); PG8_WAIT_L(0); PG8_BAR; PG8_MMA(1, 0, At, B0); PG8_MMA(1, 1, At, B1); PG8_BAR; PG8_SCHED;
            } else {
            PG8_LDB(B0, 0, 0); PG8_SCHED; PG8_LDA(At, 0, 0); PG8_STAGE(PG8_SA(1, 1), a1 + hstep, voffA);
            PG8_WAIT_L(8); PG8_BAR; PG8_WAIT_L(0); PG8_MMA(0, 0, At, B0); PG8_BAR; PG8_SCHED;
            PG8_LDB(B1, 0, 1); PG8_STAGE(PG8_SB(0, 0), b2, voffB);
            PG8_BAR; PG8_WAIT_L(0); PG8_MMA(0, 1, At, B1); PG8_BAR;
            PG8_LDA(At, 0, 1); PG8_STAGE(PG8_SA(0, 0), a2, voffA);
            PG8_BAR; PG8_WAIT_L(0); PG8_MMA(1, 0, At, B0); PG8_BAR; PG8_SCHED;
            PG8_STAGE(PG8_SB(0, 1), b2 + hstep, voffB);
            PG8_WAIT_V(6); PG8_BAR; PG8_MMA(1, 1, At, B1); PG8_BAR;
            PG8_LDB(B0, 1, 0); PG8_SCHED; PG8_LDA(At, 1, 0); PG8_STAGE(PG8_SA(0, 1), a2 + hstep, voffA);
            PG8_WAIT_L(8); PG8_BAR; PG8_WAIT_L(0); PG8_MMA(0, 0, At, B0); PG8_BAR; PG8_SCHED;
            PG8_LDB(B1, 1, 1); PG8_STAGE(PG8_SB(1, 0), b3, voffB);
            PG8_BAR; PG8_WAIT_L(0); PG8_MMA(0, 1, At, B1); PG8_BAR;
            PG8_LDA(At, 1, 1); PG8_STAGE(PG8_SA(1, 0), a3, voffA);
            PG8_BAR; PG8_WAIT_L(0); PG8_MMA(1, 0, At, B0); PG8_BAR; PG8_SCHED;
            PG8_STAGE(PG8_SB(1, 1), b3 + hstep, voffB);
            PG8_WAIT_V(6); PG8_BAR; PG8_MMA(1, 1, At, B1); PG8_BAR;
            }
        }
        if constexpr (ALIGN_EPI) { if (wr == 0) PG8_BAR; }
        if constexpr (FP8) asm volatile("s_nop 7\n\ts_nop 7" ::: "memory");
        if constexpr (!Epi::AFTER_DRAIN) { E(acc, cur, wr, wc, fr, fq); S.done(cur); }
        if (!has_next) break;
#pragma unroll
        for (int a = 0; a < 2; ++a)
#pragma unroll
            for (int b = 0; b < 2; ++b)
#pragma unroll
                for (int m = 0; m < 4; ++m)
#pragma unroll
                    for (int n = 0; n < 2; ++n) acc[a][b][m][n] = (f32x4){0.f, 0.f, 0.f, 0.f};
        cur = nxt; cA = nA; cB = nB; ++ui;
        if constexpr (ALIGN_EPI) { if (wr == 1) PG8_BAR; }
    }
    PG8_WAIT_V(0);
    if constexpr (!ALIGN_EPI) { if (wr == 0) PG8_BAR; }
    PG8_BAR;
    if constexpr (Epi::AFTER_DRAIN) { E.fused(acc, cur, wr, wc, fr, fq, lds, wid, lane); S.done(cur); }
#undef PG8_SA
#undef PG8_SB
#undef PG8_STAGE
#undef PG8_LDA
#undef PG8_LDB
#undef PG8_MMA
#undef PG8_WAIT_V
#undef PG8_WAIT_L
#undef PG8_BAR
#undef PG8_SCHED
}
}

namespace att {
#define ATT_LAS __attribute__((address_space(3)))
typedef unsigned short bf16_t;
typedef unsigned u32x4 __attribute__((ext_vector_type(4)));
typedef unsigned u32x2 __attribute__((ext_vector_type(2)));
constexpr int K_SLOT = 64 * 192, V_SLOT = 128 * 64;
constexpr int NKS = 3, NVS = 4;
constexpr int OFF_K = 0, OFF_V = NKS * K_SLOT, OFF_SCR = OFF_V + NVS * V_SLOT, ATT_LDS_BYTES = OFF_SCR + 8 * 64 * 4;
constexpr float BND = 360.f, SH0 = 4.0f, SHS = 6.0f;
constexpr int LDQ = 3072, LDK = 192, LDVT = 64, VT_TILE = 8192, LDO = 2048, SEQ = 8192;
constexpr float OSCALE = 32.f;
#define ATT_SBAR() __builtin_amdgcn_sched_barrier(0)
typedef float f32x4a __attribute__((ext_vector_type(4)));
__device__ __forceinline__ unsigned cvtpk(float lo, float hi) { unsigned r; asm volatile("v_cvt_pk_bf16_f32 %0, %1, %2" : "=v"(r) : "v"(lo), "v"(hi)); return r; }
__device__ __forceinline__ unsigned pk4f8(float a, float b, float c, float d) { int w = __builtin_amdgcn_cvt_pk_fp8_f32(a, b, 0, false); w = __builtin_amdgcn_cvt_pk_fp8_f32(c, d, w, true); return (unsigned)w; }
__device__ __forceinline__ f32x4a mfma8(unsigned a0, unsigned a1, unsigned b0, unsigned b1, f32x4a c) {
  return __builtin_amdgcn_mfma_f32_16x16x32_fp8_fp8(__builtin_bit_cast(long, (u32x2){a0, a1}), __builtin_bit_cast(long, (u32x2){b0, b1}), c, 0, 0, 0); }
__device__ __forceinline__ float max3f(float a, float b, float c) { float r; asm("v_max3_f32 %0, %1, %2, %3" : "=v"(r) : "v"(a), "v"(b), "v"(c)); return r; }
__device__ __forceinline__ float max2f(float a, float b) { float r; asm("v_max_f32_e32 %0, %1, %2" : "=v"(r) : "v"(a), "v"(b)); return r; }
__device__ __forceinline__ float xmax16(float v) { auto r = __builtin_amdgcn_permlane16_swap(__float_as_uint(v), __float_as_uint(v), false, false); return max2f(__uint_as_float(r[0]), __uint_as_float(r[1])); }
__device__ __forceinline__ float xmax32(float v) { auto r = __builtin_amdgcn_permlane32_swap(__float_as_uint(v), __float_as_uint(v), false, false); return max2f(__uint_as_float(r[0]), __uint_as_float(r[1])); }
__device__ __forceinline__ float xsum16(float v) { auto r = __builtin_amdgcn_permlane16_swap(__float_as_uint(v), __float_as_uint(v), false, false); return __uint_as_float(r[0]) + __uint_as_float(r[1]); }
__device__ __forceinline__ float xsum32(float v) { auto r = __builtin_amdgcn_permlane32_swap(__float_as_uint(v), __float_as_uint(v), false, false); return __uint_as_float(r[0]) + __uint_as_float(r[1]); }
__device__ __forceinline__ void glds16(const void* gsrc, unsigned lds_dst) { unsigned keep;
  asm volatile("s_mov_b32 %0, m0\n\ts_mov_b32 m0, %2\n\ts_nop 0\n\tglobal_load_lds_dwordx4 %1, off\n\ts_mov_b32 m0, %0" : "=&s"(keep) : "v"(gsrc), "s"(lds_dst) : "memory"); }
#define ATT_WAIT_BAR(N) asm volatile("s_waitcnt vmcnt(" #N ") lgkmcnt(0)\n\ts_barrier" ::: "memory")

__device__ __forceinline__ void attn_unit(const unsigned char* __restrict__ Qb, const unsigned char* __restrict__ Kh, const unsigned char* __restrict__ Vth, unsigned char* __restrict__ Ob, ATT_LAS unsigned char* lds) {
  int tid_l = threadIdx.x; asm volatile("" : "+v"(tid_l));
  const int tid = tid_l, wid = __builtin_amdgcn_readfirstlane(tid >> 6), lane = tid & 63, n16 = lane & 15, g = lane >> 4;
  ATT_LAS float* scr = (ATT_LAS float*)(lds + OFF_SCR) + wid * 64; ATT_LAS float* li_l = scr; ATT_LAS float* al_l = scr + 32;
  const unsigned ldsb = (unsigned)(uintptr_t)lds;
  float l_reg[2] = {0.f, 0.f}; f32x4a negm[2] = {(f32x4a){0.f, 0.f, 0.f, 0.f}, (f32x4a){0.f, 0.f, 0.f, 0.f}};
  f32x4a o[2][8];
#pragma unroll
  for (int qt = 0; qt < 2; ++qt)
#pragma unroll
    for (int c = 0; c < 8; ++c) o[qt][c] = (f32x4a){0.f, 0.f, 0.f, 0.f};
  u32x4 qr[2][3];
#pragma unroll
  for (int qt = 0; qt < 2; ++qt) { const unsigned char* Qw = Qb + (size_t)(wid * 32 + 16 * qt + n16) * LDQ + 16 * g;
#pragma unroll
    for (int sp = 0; sp < 3; ++sp) qr[qt][sp] = *(const u32x4*)(Qw + 64 * sp); }
  const int kb = 1024 * (n16 >> 2) + 64 * (n16 & 3) + 16 * (g ^ (n16 >> 2));
  const int vb = 64 * n16 + 16 * (g ^ (n16 >> 2));
  int kgo[2], vgo;
#pragma unroll
  for (int i = 0; i < 2; ++i) { const int p = wid + 8 * i, sp = p >> 2, r = 16 * (p & 3) + (lane >> 2), c = (lane & 3) ^ (p & 3); kgo[i] = r * LDK + 64 * sp + 16 * c; }
  { const int r = 16 * wid + (lane >> 2), c = (lane & 3) ^ ((lane >> 4) & 3); vgo = r * LDVT + 16 * c; }
#define ATT_ISSUE_K(kt, slot, two) do { const unsigned char* kp_ = Kh + (size_t)(kt) * (64 * LDK); const unsigned d_ = ldsb + OFF_K + (unsigned)(slot) * K_SLOT + (unsigned)wid * 1024u; \
    glds16(kp_ + kgo[0], d_); if (two) glds16(kp_ + kgo[1], d_ + 8192u); } while (0)
#define ATT_ISSUE_V(vt, slot) do { const unsigned char* vp_ = Vth + (size_t)(vt) * VT_TILE; const unsigned d_ = ldsb + OFF_V + (unsigned)(slot) * V_SLOT + (unsigned)wid * 1024u; \
    glds16(vp_ + vgo, d_); } while (0)
#define ATT_TOP_A(s, ks2) do { if ((s) < NT - 1) ATT_WAIT_BAR(3); else ATT_WAIT_BAR(0); \
    if ((s) + 2 < NT) { ATT_ISSUE_K((s) + 2, ks2, true); ATT_ISSUE_V((s) + 2, ((s) + 2) & 3); } } while (0)
#define ATT_TOP_B(s, ks2) do { if ((s) < NT - 1) ATT_WAIT_BAR(2); else ATT_WAIT_BAR(0); \
    if ((s) + 2 < NT) { ATT_ISSUE_K((s) + 2, ks2, false); ATT_ISSUE_V((s) + 2, ((s) + 2) & 3); } } while (0)
#define ATT_KLD(kslot, sp, kt) (*(const ATT_LAS u32x4*)((kslot) + kb + 4096 * (sp) + 512 * ((kt) >> 1) + 256 * ((kt) & 1)))
#define ATT_QKT(kslot_) do { const ATT_LAS unsigned char* ksl_ = (kslot_); u32x4 kf[2][4]; \
    _Pragma("unroll") for (int kt = 0; kt < 4; ++kt) { S[kt][0] = negm[0]; S[kt][1] = negm[1]; kf[0][kt] = ATT_KLD(ksl_, 0, kt); } \
    ATT_SBAR(); \
    _Pragma("unroll") for (int sp = 0; sp < 3; ++sp) { \
      if (sp + 1 < 3) { _Pragma("unroll") for (int kt = 0; kt < 4; ++kt) kf[(sp + 1) & 1][kt] = ATT_KLD(ksl_, sp + 1, kt); } \
      ATT_SBAR(); \
      _Pragma("unroll") for (int kt = 0; kt < 4; ++kt) { \
        S[kt][0] = mfma8(kf[sp & 1][kt].x, kf[sp & 1][kt].y, qr[0][sp].x, qr[0][sp].y, S[kt][0]); \
        S[kt][1] = mfma8(kf[sp & 1][kt].x, kf[sp & 1][kt].y, qr[1][sp].x, qr[1][sp].y, S[kt][1]); } \
      _Pragma("unroll") for (int kt = 0; kt < 4; ++kt) { \
        S[kt][0] = mfma8(kf[sp & 1][kt].z, kf[sp & 1][kt].w, qr[0][sp].z, qr[0][sp].w, S[kt][0]); \
        S[kt][1] = mfma8(kf[sp & 1][kt].z, kf[sp & 1][kt].w, qr[1][sp].z, qr[1][sp].w, S[kt][1]); } \
      ATT_SBAR(); } } while (0)
#define ATT_VLD(vslot_, c) (*(const ATT_LAS u32x4*)((vslot_) + vb + 1024 * (c)))
#define ATT_SOFTMAX_PV(vslot_, first_) do { const ATT_LAS unsigned char* vsl_ = (vslot_); float al_[2] = {1.f, 1.f}; u32x2 pa[2][2]; float ps_[2]; \
    u32x4 vf[8];     \
    _Pragma("unroll") for (int c = 0; c < 8; ++c) vf[c] = ATT_VLD(vsl_, c); \
    ATT_SBAR(); \
    _Pragma("unroll") for (int qt = 0; qt < 2; ++qt) { float ps = 0.f; \
      _Pragma("unroll") for (int kt = 0; kt < 4; ++kt) _Pragma("unroll") for (int i = 0; i < 4; ++i) { const float e = __builtin_amdgcn_exp2f(S[kt][qt][i]); S[kt][qt][i] = e; ps += e; } \
      ps_[qt] = xsum32(xsum16(ps)); } \
      \
    const bool keepw_ = !(first_) && __all(ps_[0] <= BND && ps_[1] <= BND); \
    if (!keepw_) {     \
      _Pragma("unroll") for (int qt = 0; qt < 2; ++qt) { float pm = max3f(S[0][qt][0], S[0][qt][1], S[0][qt][2]); pm = max3f(pm, S[0][qt][3], S[1][qt][0]); \
        pm = max3f(pm, S[1][qt][1], S[1][qt][2]); pm = max3f(pm, S[1][qt][3], S[2][qt][0]); pm = max3f(pm, S[2][qt][1], S[2][qt][2]); pm = max3f(pm, S[2][qt][3], S[3][qt][0]); \
        pm = max3f(pm, S[3][qt][1], S[3][qt][2]); pm = max2f(pm, S[3][qt][3]); pm = xmax32(xmax16(pm)); \
        float d = max2f(__builtin_amdgcn_logf(pm) - SH0, __builtin_amdgcn_logf(ps_[qt]) - SHS); if (!(first_)) d = max2f(d, 0.f); \
        al_[qt] = __builtin_amdgcn_exp2f(-d); negm[qt] -= d; ps_[qt] *= al_[qt]; \
        _Pragma("unroll") for (int kt = 0; kt < 4; ++kt) S[kt][qt] *= al_[qt]; } \
      if (g == 0) { al_l[n16] = al_[0]; al_l[16 + n16] = al_[1]; } asm volatile("s_waitcnt lgkmcnt(0)" ::: "memory"); \
      _Pragma("unroll") for (int qt = 0; qt < 2; ++qt) { const f32x4a av = *(const ATT_LAS f32x4a*)(al_l + 16 * qt + 4 * g); \
        _Pragma("unroll") for (int c = 0; c < 8; ++c) o[qt][c] *= av; } } \
    _Pragma("unroll") for (int qt = 0; qt < 2; ++qt) { l_reg[qt] = l_reg[qt] * al_[qt] + ps_[qt]; \
      _Pragma("unroll") for (int t = 0; t < 2; ++t) { pa[qt][t].x = pk4f8(S[2 * t][qt][0], S[2 * t][qt][1], S[2 * t][qt][2], S[2 * t][qt][3]); \
        pa[qt][t].y = pk4f8(S[2 * t + 1][qt][0], S[2 * t + 1][qt][1], S[2 * t + 1][qt][2], S[2 * t + 1][qt][3]); } } \
    ATT_SBAR(); \
    _Pragma("unroll") for (int gq = 0; gq < 2; ++gq) { \
      _Pragma("unroll") for (int c = 0; c < 4; ++c) { \
        o[0][4 * gq + c] = mfma8(pa[0][0].x, pa[0][0].y, vf[4 * gq + c].x, vf[4 * gq + c].y, o[0][4 * gq + c]); \
        o[1][4 * gq + c] = mfma8(pa[1][0].x, pa[1][0].y, vf[4 * gq + c].x, vf[4 * gq + c].y, o[1][4 * gq + c]); } \
      _Pragma("unroll") for (int c = 0; c < 4; ++c) { \
        o[0][4 * gq + c] = mfma8(pa[0][1].x, pa[0][1].y, vf[4 * gq + c].z, vf[4 * gq + c].w, o[0][4 * gq + c]); \
        o[1][4 * gq + c] = mfma8(pa[1][1].x, pa[1][1].y, vf[4 * gq + c].z, vf[4 * gq + c].w, o[1][4 * gq + c]); } } \
    ATT_SBAR(); } while (0)
  constexpr int NT = SEQ / 64;
  f32x4a S[4][2];
  if (wid < 4) { ATT_ISSUE_K(0, 0, true); ATT_ISSUE_V(0, 0); ATT_ISSUE_K(1, 1, true); ATT_ISSUE_V(1, 1); }
  else { ATT_ISSUE_K(0, 0, false); ATT_ISSUE_V(0, 0); ATT_ISSUE_K(1, 1, false); ATT_ISSUE_V(1, 1); }
  asm volatile("" : "+v"(qr[0][0]), "+v"(qr[0][1]), "+v"(qr[0][2]), "+v"(qr[1][0]), "+v"(qr[1][1]), "+v"(qr[1][2]));
  if (wid < 4) {
    int ks = 0;
    for (int s = 0; s < NT; ++s) {
      const int ks2 = ks == 0 ? 2 : ks - 1;
      ATT_TOP_A(s, ks2);
      ATT_QKT(lds + OFF_K + ks * K_SLOT);
      ATT_SOFTMAX_PV(lds + OFF_V + (s & 3) * V_SLOT, s == 0);
      ks = ks == 2 ? 0 : ks + 1;
    }
    ATT_WAIT_BAR(0);
  } else {
    __builtin_amdgcn_s_setprio(1);
    ATT_TOP_B(0, 2);
    ATT_QKT(lds + OFF_K);
    int ks = 1;
    for (int s = 1; s < NT; ++s) {
      const int ks2 = ks == 0 ? 2 : ks - 1;
      ATT_TOP_B(s, ks2);
      ATT_SOFTMAX_PV(lds + OFF_V + ((s - 1) & 3) * V_SLOT, s == 1);
      ATT_QKT(lds + OFF_K + ks * K_SLOT);
      ks = ks == 2 ? 0 : ks + 1;
    }
    ATT_WAIT_BAR(0);
    ATT_SOFTMAX_PV(lds + OFF_V + ((NT - 1) & 3) * V_SLOT, false);
    __builtin_amdgcn_s_setprio(0);
  }
  if (g == 0) { li_l[n16] = l_reg[0]; li_l[16 + n16] = l_reg[1]; }
  asm volatile("s_waitcnt lgkmcnt(0)" ::: "memory");
#pragma unroll
  for (int qt = 0; qt < 2; ++qt) { const f32x4a lv = *(const ATT_LAS f32x4a*)(li_l + 16 * qt + 4 * g);
    unsigned char* Ow = Ob + (size_t)(wid * 32 + 16 * qt + 4 * g) * LDO + n16;
#pragma unroll
    for (int i = 0; i < 4; ++i) { const float rl = __builtin_amdgcn_rcpf(lv[i]) * OSCALE;
#pragma unroll
      for (int c = 0; c < 8; ++c) { const float v = o[qt][c][i] * rl; Ow[(size_t)i * LDO + 16 * c] = (unsigned char)(__builtin_amdgcn_cvt_pk_fp8_f32(v, v, 0, false) & 0xff); } } }
  ATT_WAIT_BAR(0);
#undef ATT_ISSUE_K
#undef ATT_ISSUE_V
#undef ATT_TOP_A
#undef ATT_TOP_B
#undef ATT_KLD
#undef ATT_QKT
#undef ATT_VLD
#undef ATT_SOFTMAX_PV
}
}

constexpr int NWAVES = 8;
constexpr int M = 24576, DM = 4096, SEQ = 8192, NSEQ = 3, MP = 16384;
constexpr int DFF = 11008, NUP = 22016, NIN = 12032;
constexpr float RMS_EPS = 1e-6f;
constexpr size_t MiB = 1u << 20;
constexpr size_t WS_CTL = 0, CTL_ZERO_BYTES = 1 * MiB;
constexpr size_t WS_DYNCTR = 64 * 1024;
constexpr size_t WS_ROWSS = 128 * 1024;
constexpr size_t WS_ROPE = 1 * MiB;
constexpr size_t WS_BPOOL = 4 * MiB, WS_BUQ = 6 * MiB, WS_BUKV = 12 * MiB, WS_BBP = 16 * MiB, WS_BBM = 32 * MiB, WS_BO = 1316 * MiB, WS_BIN = 80 * MiB;
constexpr size_t WS_BINB = 128 * MiB, WS_H8 = 932 * MiB;
constexpr size_t WS_Q8 = 80 * MiB, WS_K8 = 176 * MiB, WS_VT8 = 248 * MiB;
constexpr size_t WS_A = 176 * MiB;
constexpr size_t WS_B = 368 * MiB;
constexpr size_t WS_ZK = 536 * MiB;
constexpr size_t WS_ZG = 548 * MiB;
constexpr size_t WS_AO = 932 * MiB;
constexpr size_t WS_F = 1028 * MiB;
constexpr size_t WS_BOUT = 1220 * MiB;
constexpr size_t WS_END1 = 1316 * MiB;
constexpr size_t WS_BUP = 4 * MiB, WS_BDOWN = 176 * MiB, WS_H2 = 262 * MiB, WS_ACT = 454 * MiB, WS_SIDE = 970 * MiB, WS_END2 = 1036 * MiB;
constexpr size_t WS_NEED = 1348 * MiB;
constexpr int CW_TMO = 0, CW_CODE = 1, CW_BAR = 4096;
constexpr int RING_OFF = 0, RING_BYTES = 131072;
constexpr int CONVSCR_OFF = RING_BYTES;
constexpr int LDSCTL_OFF = CONVSCR_OFF + 16896, MISC_OFF = LDSCTL_OFF;
constexpr int LDS_BYTES = LDSCTL_OFF + 512;

#define GAS __attribute__((address_space(1)))
#define LAS __attribute__((address_space(3)))
typedef unsigned short bf16;
typedef unsigned v4u __attribute__((ext_vector_type(4)));
typedef unsigned v2u __attribute__((ext_vector_type(2)));
typedef float f32x4 __attribute__((ext_vector_type(4)));
typedef GAS unsigned gu32;
#define RLX_AGENT __ATOMIC_RELAXED, __HIP_MEMORY_SCOPE_AGENT
#define LDS_WAIT() asm volatile("s_waitcnt lgkmcnt(0)" ::: "memory")
#define VM_WAIT() asm volatile("s_waitcnt vmcnt(0)" ::: "memory")
__device__ __forceinline__ unsigned f2bf(float f) { unsigned u = __builtin_bit_cast(unsigned, f); return (u + 0x7fffu + ((u >> 16) & 1u)) >> 16; }
__device__ __forceinline__ unsigned pk2(float lo, float hi) { return f2bf(lo) | (f2bf(hi) << 16); }
__device__ __forceinline__ float bflo(unsigned w) { return __uint_as_float(w << 16); }
__device__ __forceinline__ float bfhi(unsigned w) { return __uint_as_float(w & 0xffff0000u); }
__device__ __forceinline__ void unpack8(const v4u w, float (&v)[8]) { v[0] = bflo(w.x); v[1] = bfhi(w.x); v[2] = bflo(w.y); v[3] = bfhi(w.y); v[4] = bflo(w.z); v[5] = bfhi(w.z); v[6] = bflo(w.w); v[7] = bfhi(w.w); }
__device__ __forceinline__ v4u pack8(const float (&v)[8]) { v4u w; w.x = pk2(v[0], v[1]); w.y = pk2(v[2], v[3]); w.z = pk2(v[4], v[5]); w.w = pk2(v[6], v[7]); return w; }
#define XB_TMO      128
#define XB_XCNT(j)  (256  + 64 * (j))
#define XB_XSUB(j)  (1280 + 64 * (j))
#define XB_XGEN(j)  (2304 + 64 * (j))
#define XB_TOP      3328
#define XB_TOPGEN   3392
#define XCD_BAR_WORDS 3456
#define XB_SPIN_CAP (1u << 18)

__device__ __forceinline__ unsigned xb_ld(unsigned* p)              { return __hip_atomic_load(p, __ATOMIC_RELAXED, __HIP_MEMORY_SCOPE_AGENT); }
__device__ __forceinline__ unsigned xb_add(unsigned* p, unsigned v) { return __hip_atomic_fetch_add(p, v, __ATOMIC_RELAXED, __HIP_MEMORY_SCOPE_AGENT); }
__device__ __forceinline__ unsigned xb_xcc_id() { return (unsigned)__builtin_amdgcn_s_getreg((3 << 11) | 20) & 0xFu; }
#define XB_SPIN(cond, bar) do { unsigned _sp = 0; while (cond) { __builtin_amdgcn_s_sleep(1); \
    if ((++_sp & 255u) == 0u) { if (xb_ld(&(bar)[XB_TMO])) break; if (_sp > XB_SPIN_CAP) { atomicAdd(&(bar)[XB_TMO], 1u); break; } } } } while (0)

struct XcdBarrier {
    unsigned* bar; unsigned x;
    volatile LAS unsigned* st;
};

__device__ __forceinline__ XcdBarrier xcd_barrier_post(unsigned* bar, volatile LAS unsigned* st) {
    XcdBarrier b; b.bar = bar; b.x = xb_xcc_id(); b.st = st;
    if (threadIdx.x == 0) (void)xb_add(&bar[XB_XCNT(b.x)], 1u);
    return b;
}
__device__ __forceinline__ void xcd_barrier_complete(unsigned* bar, unsigned x, unsigned& nloc, unsigned& nx) {
    const unsigned G = gridDim.x * gridDim.y * gridDim.z;
    unsigned sum, cnt, mine, sp = 0u;
    for (;;) {
        sum = 0u; cnt = 0u; mine = 0u;
#pragma unroll
        for (unsigned j = 0; j < 16; ++j) { const unsigned c = xb_ld(&bar[XB_XCNT(j)]); sum += c; cnt += (c > 0u) ? 1u : 0u; mine = (j == x) ? c : mine; }
        if (sum == G) break;
        __builtin_amdgcn_s_sleep(1);
        if ((++sp & 255u) == 0u) { if (xb_ld(&bar[XB_TMO])) break; if (sp > XB_SPIN_CAP) { atomicAdd(&bar[XB_TMO], 1u); break; } }
    }
    nloc = mine > 0u ? mine : 1u; nx = cnt > 0u ? cnt : 1u;
}

__device__ __forceinline__ void xcd_barrier(const XcdBarrier& b) {
    asm volatile("s_waitcnt vmcnt(0)" ::: "memory");
    __syncthreads();
    if (threadIdx.x == 0) {
        unsigned* bar = b.bar;
        __builtin_amdgcn_s_waitcnt(0);
        unsigned nloc = b.st[0], nx = b.st[1];
        if (nloc == 0u) { xcd_barrier_complete(bar, b.x, nloc, nx); b.st[0] = nloc; b.st[1] = nx; }
        const unsigned old = xb_add(&bar[XB_XSUB(b.x)], 1u);
        const unsigned gen = old / nloc;
        if (old + 1u == (gen + 1u) * nloc) {
            __builtin_amdgcn_fence(__ATOMIC_RELEASE, "agent");
            asm volatile("s_waitcnt vmcnt(0)" ::: "memory");
            const unsigned og = xb_add(&bar[XB_TOP], 1u);
            const unsigned tg = og / nx;
            if (og + 1u == (tg + 1u) * nx) xb_add(&bar[XB_TOPGEN], 1u);
            else XB_SPIN(xb_ld(&bar[XB_TOPGEN]) == tg, bar);
            __builtin_amdgcn_fence(__ATOMIC_ACQUIRE, "agent");
            xb_add(&bar[XB_XGEN(b.x)], 1u);
            asm volatile("s_waitcnt vmcnt(0)" ::: "memory");
        } else {
            XB_SPIN(xb_ld(&bar[XB_XGEN(b.x)]) == gen, bar);
            __builtin_amdgcn_fence(__ATOMIC_ACQUIRE, "agent");
            asm volatile("s_waitcnt vmcnt(0)" ::: "memory");
        }
    }
    __syncthreads();
}

__device__ __forceinline__ float wave_sum(float v) {
#pragma unroll
    for (int o = 1; o < 64; o <<= 1) v += __shfl_xor(v, o);
    return v;
}
__device__ __forceinline__ void tr_item(const float* W, int N, bf16* WT, int ldt, int k0, int n0, int drow0, LAS float* scr, int lane, const float* kscale = nullptr) {
#pragma unroll 8
    for (int i = 0; i < 32; ++i) { const int kk = 2 * i + (lane >> 5); scr[kk * 33 + (lane & 31)] = W[(size_t)(k0 + kk) * N + n0 + (lane & 31)]; }
    LDS_WAIT(); asm volatile("" ::: "memory");
    const int c = lane & 7;
    f32x4 g0 = {1.f, 1.f, 1.f, 1.f}, g1 = g0;
    if (kscale) { g0 = *(const GAS f32x4*)(kscale + k0 + 8 * c); g1 = *(const GAS f32x4*)(kscale + k0 + 8 * c + 4); }
#pragma unroll
    for (int j = 0; j < 4; ++j) { const int n = (lane >> 3) + 8 * j; const LAS float* s = scr + (8 * c) * 33 + n;
        v4u o; o.x = pk2(s[0 * 33] * g0.x, s[1 * 33] * g0.y); o.y = pk2(s[2 * 33] * g0.z, s[3 * 33] * g0.w); o.z = pk2(s[4 * 33] * g1.x, s[5 * 33] * g1.y); o.w = pk2(s[6 * 33] * g1.z, s[7 * 33] * g1.w);
        *(GAS v4u*)(WT + (size_t)(drow0 + n) * ldt + k0 + 8 * c) = o; }
    LDS_WAIT(); asm volatile("" ::: "memory");
}
__device__ __forceinline__ void tr_item8(const float* W, int N, unsigned char* WT8, int ldt, int k0, int n0, int drow0, LAS float* scr, int lane, float sc) {
#pragma unroll 8
    for (int i = 0; i < 32; ++i) { const int kk = 2 * i + (lane >> 5); scr[kk * 33 + (lane & 31)] = W[(size_t)(k0 + kk) * N + n0 + (lane & 31)]; }
    LDS_WAIT(); asm volatile("" ::: "memory");
    const int c = lane & 7;
#pragma unroll
    for (int j = 0; j < 4; ++j) { const int n = (lane >> 3) + 8 * j; const LAS float* s = scr + (8 * c) * 33 + n;
        int a = __builtin_amdgcn_cvt_pk_fp8_f32(s[0 * 33] * sc, s[1 * 33] * sc, 0, false); a = __builtin_amdgcn_cvt_pk_fp8_f32(s[2 * 33] * sc, s[3 * 33] * sc, a, true);
        int b = __builtin_amdgcn_cvt_pk_fp8_f32(s[4 * 33] * sc, s[5 * 33] * sc, 0, false); b = __builtin_amdgcn_cvt_pk_fp8_f32(s[6 * 33] * sc, s[7 * 33] * sc, b, true);
        v2u o; o.x = (unsigned)a; o.y = (unsigned)b;
        *(GAS v2u*)(WT8 + (size_t)(drow0 + n) * ldt + k0 + 8 * c) = o; }
    LDS_WAIT(); asm volatile("" ::: "memory");
}
__device__ __forceinline__ void rms_row_4096(const float* xrow, const float* gain, bf16* orow, unsigned char* orow8, int lane) {
    const GAS f32x4* xr = (const GAS f32x4*)xrow + lane; const GAS f32x4* gr = (const GAS f32x4*)gain + lane;
    f32x4 v[16]; float s = 0.f;
#pragma unroll
    for (int j = 0; j < 16; ++j) { v[j] = xr[64 * j]; s += (v[j].x * v[j].x + v[j].y * v[j].y) + (v[j].z * v[j].z + v[j].w * v[j].w); }
    const float r = 1.0f / sqrtf(wave_sum(s) * (1.f / 4096.f) + RMS_EPS);
    GAS v2u* o8 = (GAS v2u*)orow + lane;
    GAS unsigned* o4 = (GAS unsigned*)orow8 + lane;
#pragma unroll
    for (int j = 0; j < 16; ++j) { const f32x4 g = gr[64 * j]; const float a = v[j].x * r * g.x, b = v[j].y * r * g.y, c = v[j].z * r * g.z, d = v[j].w * r * g.w;
        v2u w; w.x = pk2(a, b); w.y = pk2(c, d); o8[64 * j] = w;
        int q = __builtin_amdgcn_cvt_pk_fp8_f32(a, b, 0, false); q = __builtin_amdgcn_cvt_pk_fp8_f32(c, d, q, true); o4[64 * j] = (unsigned)q; }
}
__device__ __forceinline__ void sincos_d(double a, double& s, double& c) {
    const double TWO_PI = 6.283185307179586476925286766559;
    const double n = __builtin_rint(a / TWO_PI); const double x = a - n * TWO_PI;
    const double x2 = x * x; double ts = 1.0, tc = 1.0; double ss = 1.0, cs = 1.0;
#pragma unroll
    for (int k = 1; k <= 14; ++k) { tc *= -x2 / (double)((2 * k - 1) * (2 * k)); cs += tc; ts *= -x2 / (double)((2 * k) * (2 * k + 1)); ss += ts; }
    s = x * ss; c = cs;
}

__device__ __forceinline__ v2u pack8_f8(const float (&v)[8], float sc) {
    int a = __builtin_amdgcn_cvt_pk_fp8_f32(v[0] * sc, v[1] * sc, 0, false); a = __builtin_amdgcn_cvt_pk_fp8_f32(v[2] * sc, v[3] * sc, a, true);
    int b = __builtin_amdgcn_cvt_pk_fp8_f32(v[4] * sc, v[5] * sc, 0, false); b = __builtin_amdgcn_cvt_pk_fp8_f32(v[6] * sc, v[7] * sc, b, true);
    v2u w; w.x = (unsigned)a; w.y = (unsigned)b; return w;
}
__device__ __forceinline__ unsigned pk4_f8(float a, float b, float c, float d) { int w = __builtin_amdgcn_cvt_pk_fp8_f32(a, b, 0, false); w = __builtin_amdgcn_cvt_pk_fp8_f32(c, d, w, true); return (unsigned)w; }

#ifndef PHM
#define PHM 0x3ff
#endif
typedef const __attribute__((address_space(4))) unsigned char* kptr_t;
__device__ __forceinline__ kptr_t karg() { kptr_t p = (kptr_t)__builtin_amdgcn_kernarg_segment_ptr(); asm volatile("" : "+s"(p)); return p; }
#define KIN(i) (*(const float* const __attribute__((address_space(4)))*)(kp + 8 * (i)))
#define KOUT() (*(float* const __attribute__((address_space(4)))*)(kp + 8 * 20))
#define KWS() (*(unsigned char* const __attribute__((address_space(4)))*)(kp + 8 * 21))
struct Args { const float* in[20]; float* out; unsigned char* ws; };
__global__ void __launch_bounds__(NWAVES * 64, 2) fwd_kernel(Args args) {
    extern __shared__ __attribute__((aligned(16))) unsigned char lds_raw[];
    LAS unsigned char* lds = (LAS unsigned char*)lds_raw;
    volatile LAS unsigned* MISC = (volatile LAS unsigned*)(lds + MISC_OFF);
    const int tid = threadIdx.x;
    const int G = gridDim.x, bx = blockIdx.x;
    const int vcu = (G % 8 == 0) ? (bx % 8) * (G / 8) + bx / 8 : bx;
    gu32* ctl = (gu32*)(args.ws + WS_CTL);
    for (int u = tid; u < (LDS_BYTES - LDSCTL_OFF) / 4; u += NWAVES * 64) ((LAS unsigned*)(lds + LDSCTL_OFF))[u] = 0u;
    __syncthreads();
    XcdBarrier bar = xcd_barrier_post((unsigned*)(ctl + CW_BAR), MISC + 8);
#if defined(PROBE_BAR_BX)
#define GRID_BAR() do { const unsigned long long tb0_ = __builtin_amdgcn_s_memrealtime(); xcd_barrier(bar); if ((int)blockIdx.x == (PROBE_BAR_BX) && threadIdx.x == 0) MISC[31] = MISC[31] + (unsigned)(__builtin_amdgcn_s_memrealtime() - tb0_); } while (0)
#else
#define GRID_BAR() xcd_barrier(bar)
#endif
#if defined(PROBE_A)
#if defined(PROBE_CLK_A)
#define STAMP(k) do { if (bx == 0 && tid == 0) { MISC[16 + (k)] = (unsigned)__builtin_amdgcn_s_memrealtime(); if ((k) == PROBE_CLK_A) MISC[12] = (unsigned)__builtin_amdgcn_s_memtime(); if ((k) == PROBE_CLK_B) MISC[13] = (unsigned)__builtin_amdgcn_s_memtime(); } } while (0)
#else
#define STAMP(k) do { if (bx == 0 && tid == 0) MISC[16 + (k)] = (unsigned)__builtin_amdgcn_s_memrealtime(); } while (0)
#endif
#else
#define STAMP(k) do { } while (0)
#endif
    STAMP(0);
    const int NGW = G * NWAVES, NGT = G * NWAVES * 64;
#define PHASE_IDS() int tidp_ = threadIdx.x; asm volatile("" : "+v"(tidp_)); const int lane = tidp_ & 63, wavep_ = __builtin_amdgcn_readfirstlane(tidp_ >> 6); \
    const int gw = vcu * NWAVES + wavep_, gt = vcu * (NWAVES * 64) + tidp_; LAS float* scr = (LAS float*)(lds + RING_OFF + wavep_ * 16384); (void)gw; (void)gt; (void)scr; (void)lane

#if (PHM >> 0) & 1
    {
        PHASE_IDS();
        kptr_t kp = karg(); unsigned char* ws = KWS();
        const float* x_prompt = KIN(0); const float* x_sample = KIN(1); const float* norm_mix_gain = KIN(2); const float* w_in = KIN(3); const float* pool_w = KIN(4);
        const float* w_uq = KIN(7); const float* w_ukv = KIN(9); const float* w_bp = KIN(12); const float* w_bm = KIN(13); const float* w_o = KIN(14);
        float* ropec = (float*)(ws + WS_ROPE); float* ropes = ropec + SEQ * 32;
        bf16* Bpool = (bf16*)(ws + WS_BPOOL); bf16* Buq = (bf16*)(ws + WS_BUQ); bf16* Bukv = (bf16*)(ws + WS_BUKV); bf16* Bbp = (bf16*)(ws + WS_BBP);
        bf16* Bbm = (bf16*)(ws + WS_BBM); bf16* Bo = (bf16*)(ws + WS_BO); bf16* Bin = (bf16*)(ws + WS_BIN); unsigned char* BinB = ws + WS_BINB; bf16* Hb = (bf16*)(ws + WS_A); unsigned char* H8 = ws + WS_H8;
        constexpr int I_POOL = 512, I_UQ = 1536, I_UKV = 1024, I_BP = 4096, I_BM = 4096, I_O = 8192, I_IN = 23680;
        constexpr int NITEMS = I_POOL + I_UQ + I_UKV + I_BP + I_BM + I_O + I_IN;
        for (int it = gw; it < NITEMS; it += NGW) {
            int r = it;
            if (r < I_POOL) { const int g = r >> 7, q = r & 127; tr_item(pool_w + (size_t)g * 512 * 512, 512, Bpool, 512, 64 * (q >> 4), 32 * (q & 15), g * 512 + 32 * (q & 15), scr, lane); continue; } r -= I_POOL;
            if (r < I_UQ) { tr_item8(w_uq, 3072, (unsigned char*)Buq, 1024, 64 * (r / 96), 32 * (r % 96), 32 * (r % 96), scr, lane, 32.f); continue; } r -= I_UQ;
            if (r < I_UKV) { tr_item8(w_ukv, 4096, (unsigned char*)Bukv, 512, 64 * (r / 128), 32 * (r % 128), 32 * (r % 128), scr, lane, 16.f); continue; } r -= I_UKV;
            if (r < I_BP) { tr_item(w_bp, 4096, Bbp, 2048, 64 * (r / 128), 32 * (r % 128), 32 * (r % 128), scr, lane); continue; } r -= I_BP;
            if (r < I_BM) { tr_item8(w_bm, 4096, (unsigned char*)Bbm, 2048, 64 * (r / 128), 32 * (r % 128), 32 * (r % 128), scr, lane, 32.f); continue; } r -= I_BM;
            if (r < I_O) { tr_item(w_o, 4096, Bo, 4096, 64 * (r / 128), 32 * (r % 128), 32 * (r % 128), scr, lane); continue; } r -= I_O;
            { const int n0 = 32 * (r % 370), k0 = 64 * (r / 370);
              if (n0 < 2048) tr_item(w_in, 11840, Bin, 4096, k0, n0, n0, scr, lane);
              else { const int drow = (n0 < 3072) ? n0 - 2048 : (n0 < 3584) ? 1024 + (n0 - 3072) : (n0 < 3648) ? 5632 + (n0 - 3584) : (n0 < 7744) ? 5888 + (n0 - 3648) : 1536 + (n0 - 7744);
                     tr_item8(w_in, 11840, BinB, 4096, k0, n0, drow, scr, lane, 64.f); } }
        }
        { GAS v4u* z = (GAS v4u*)(BinB + (size_t)5696 * 4096); const v4u zero = {0u, 0u, 0u, 0u};
          for (int i = gt; i < 192 * 4096 / 16; i += NGT) z[i] = zero; }
        for (int i = gt; i < SEQ * 32; i += NGT) { const int t = i >> 5, f = i & 31;
            const float inv = 1.0f / (float)exp2(13.287712379549449 * ((double)(2 * f) / 64.0));
            const float ang = (float)t * inv; double s, c; sincos_d((double)ang, s, c); ropec[i] = (float)c; ropes[i] = (float)s; }
        for (int m = gw; m < M; m += NGW) { const float* xr = (m < MP) ? x_prompt + (size_t)m * DM : x_sample + (size_t)(m - MP) * DM; rms_row_4096(xr, norm_mix_gain, Hb + (size_t)m * DM, H8 + (size_t)m * DM, lane); }
    }
    GRID_BAR();
#endif
    STAMP(1);
#if (PHM >> 1) & 1
    {
        kptr_t kp = karg(); unsigned char* ws = KWS();
        bf16* Hb = (bf16*)(ws + WS_A); bf16* Bin = (bf16*)(ws + WS_BIN); bf16* ZA = (bf16*)(ws + WS_B); bf16* ZK = (bf16*)(ws + WS_ZK); bf16* ZG = (bf16*)(ws + WS_ZG);
        {
            pg8::Gemm g{Hb, Bin, M, 2048, DM}; pg8::StaticOrder S; S.init(M, 2048, G, bx);
            pg8::EpiZa E{ZA, ZG};
            pg8::gemm_phase<pg8::EpiZa, pg8::StaticOrder, true, true>(lds + RING_OFF, g, S, E);
        }
        {
            pg8::Gemm g{(const bf16*)(ws + WS_H8), (const bf16*)(ws + WS_BINB), M, 9984, DM / 2}; pg8::DynTailOrder S; S.init2(M, 9984, G, bx, (unsigned*)(ws + WS_DYNCTR), MISC + 4);
            pg8::EpiZb E{ZA, ZG, ZK, 1.0f / 64.0f};
            pg8::gemm_phase<pg8::EpiZb, pg8::DynTailOrder, true, true, true>(lds + RING_OFF, g, S, E);
        }
    }
    GRID_BAR();
#endif
    STAMP(2);
#if (PHM >> 2) & 1
    {
        PHASE_IDS();
        kptr_t kp = karg(); unsigned char* ws = KWS(); const float* q_a_gain = KIN(6); const float* kv_a_gain = KIN(8);
        bf16* ZA = (bf16*)(ws + WS_B); bf16* PAp = (bf16*)(ws + WS_A); unsigned char* CQN8 = (unsigned char*)(PAp + (size_t)4 * M * 512); unsigned char* CKVN8 = CQN8 + (size_t)M * 1024;
    for (int task = gw; task < 4 * (M / 64); task += NGW) {
        const int g = task & 3, m0 = (task >> 2) * 64, t0 = m0 % SEQ, half = 1 << g;
        const bf16* zc = ZA + (size_t)m0 * 3584 + g * 512 + lane * 8;
        bf16* pc = PAp + ((size_t)g * M + m0) * 512 + lane * 8;
        float sum[8] = {0.f, 0.f, 0.f, 0.f, 0.f, 0.f, 0.f, 0.f};
        for (int d = -half; d < half; ++d) { const int tt = t0 + d;
            if (tt >= 0 && tt < SEQ) { float v[8]; unpack8(*(const GAS v4u*)(zc + (ptrdiff_t)d * 3584), v);
#pragma unroll
                for (int j = 0; j < 8; ++j) sum[j] += v[j]; } }
#pragma unroll 4
        for (int i = 0; i < 64; ++i) {
            const int t = t0 + i, lo = (t - half < 0) ? 0 : t - half, hi = (t + half > SEQ) ? SEQ : t + half;
            const bool has_lead = (t + half < SEQ), has_trail = (t - half >= 0);
            const int il = has_lead ? i + half : i, it = has_trail ? i - half : i;
            const v4u ws_ = *(const GAS v4u*)(zc + (ptrdiff_t)i * 3584), wl = *(const GAS v4u*)(zc + (ptrdiff_t)il * 3584), wt = *(const GAS v4u*)(zc + (ptrdiff_t)it * 3584);
            float self[8], lead[8], trail[8], o[8]; unpack8(ws_, self); unpack8(wl, lead); unpack8(wt, trail);
            const float rc = 1.0f / (float)(hi - lo);
#pragma unroll
            for (int j = 0; j < 8; ++j) { o[j] = sum[j] * rc - self[j]; sum[j] += (has_lead ? lead[j] : 0.f) - (has_trail ? trail[j] : 0.f); }
            *(GAS v4u*)(pc + (size_t)i * 512) = pack8(o);
        }
    }
    for (int m = gw; m < M; m += NGW) {
        const bf16* zrow = ZA + (size_t)m * 3584;
        { float a[8], b[8]; unpack8(*(const GAS v4u*)(zrow + 2048 + lane * 8), a); unpack8(*(const GAS v4u*)(zrow + 2560 + lane * 8), b);
          float s = 0.f;
#pragma unroll
          for (int j = 0; j < 8; ++j) s += a[j] * a[j] + b[j] * b[j];
          const float r = 1.0f / sqrtf(wave_sum(s) * (1.f / 1024.f) + RMS_EPS);
          const GAS f32x4* ga = (const GAS f32x4*)(q_a_gain + lane * 8); const GAS f32x4* gb = (const GAS f32x4*)(q_a_gain + 512 + lane * 8);
          const f32x4 ga0 = ga[0], ga1 = ga[1], gb0 = gb[0], gb1 = gb[1];
#pragma unroll
          for (int j = 0; j < 4; ++j) { a[j] *= r * ga0[j]; a[4 + j] *= r * ga1[j]; b[j] *= r * gb0[j]; b[4 + j] *= r * gb1[j]; }
          *(GAS v2u*)(CQN8 + (size_t)m * 1024 + lane * 8) = pack8_f8(a, 1.0f); *(GAS v2u*)(CQN8 + (size_t)m * 1024 + 512 + lane * 8) = pack8_f8(b, 1.0f); }
        { float a[8]; unpack8(*(const GAS v4u*)(zrow + 3072 + lane * 8), a);
          float s = 0.f;
#pragma unroll
          for (int j = 0; j < 8; ++j) s += a[j] * a[j];
          const float r = 1.0f / sqrtf(wave_sum(s) * (1.f / 512.f) + RMS_EPS);
          const GAS f32x4* ga = (const GAS f32x4*)(kv_a_gain + lane * 8); const f32x4 ga0 = ga[0], ga1 = ga[1];
#pragma unroll
          for (int j = 0; j < 4; ++j) { a[j] *= r * ga0[j]; a[4 + j] *= r * ga1[j]; }
          *(GAS v2u*)(CKVN8 + (size_t)m * 512 + lane * 8) = pack8_f8(a, 1.0f); }
    }
    }
    GRID_BAR();
#endif
    STAMP(3);
#if (PHM >> 3) & 1
    {
        kptr_t kp = karg(); unsigned char* ws = KWS(); const float* pool_scale = KIN(5);
        bf16* PAp = (bf16*)(ws + WS_A); bf16* CQN = PAp + (size_t)4 * M * 512; bf16* CKVN = (bf16*)((unsigned char*)CQN + (size_t)M * 1024);
        bf16* Bpool = (bf16*)(ws + WS_BPOOL); bf16* Buq = (bf16*)(ws + WS_BUQ); bf16* Bukv = (bf16*)(ws + WS_BUKV);
        bf16* AO = (bf16*)(ws + WS_AO); bf16* Qb = (bf16*)(ws + WS_B); bf16* KN = (bf16*)(ws + WS_F); bf16* VH = (bf16*)(ws + WS_F + 96 * MiB);
    {
        pg8::Gemm g{PAp, Bpool, 4 * M, 2048, 512}; pg8::PoolOrder S{G, bx};
        pg8::EpiPool E{AO, pool_scale};
        pg8::gemm_phase<pg8::EpiPool, pg8::PoolOrder, true, true>(lds + RING_OFF, g, S, E);
    }
    {
        pg8::Gemm g{CQN, Buq, M, 3072, 512}; pg8::StaticOrder S; S.init(M, 3072, G, bx);
        pg8::EpiBf E{Qb, 3072};
        pg8::gemm_phase<pg8::EpiBf, pg8::StaticOrder, true, true, true>(lds + RING_OFF, g, S, E);
    }
    {
        pg8::Gemm g{CKVN, Bukv, M, 4096, 256}; pg8::StaticOrder S; S.init(M, 4096, G, bx);
        pg8::EpiKV8 E{KN, VH, 1.0f / 16.0f};
        pg8::gemm_phase<pg8::EpiKV8, pg8::StaticOrder, true, true, true>(lds + RING_OFF, g, S, E);
    }
    }
    GRID_BAR();
#endif
    STAMP(4);
#if (PHM >> 4) & 1
    {
        PHASE_IDS();
        kptr_t kp = karg(); unsigned char* ws = KWS(); const float* q_gain = KIN(10); const float* k_gain = KIN(11);
        const float* ropec = (const float*)(ws + WS_ROPE); const float* ropes = ropec + SEQ * 32;
        bf16* Qb = (bf16*)(ws + WS_B); bf16* KN = (bf16*)(ws + WS_F); bf16* ZK = (bf16*)(ws + WS_ZK); const bf16* VH = (const bf16*)(ws + WS_F + 96 * MiB);
        unsigned char* Q8 = ws + WS_Q8; unsigned char* K8 = ws + WS_K8; unsigned char* Vt8 = ws + WS_VT8;
    for (int m = gw; m < M; m += NGW) {
        const int t = m % SEQ, h = lane >> 2, s4 = lane & 3;
        float cs[8], sn[8];
        { const GAS f32x4* cp = (const GAS f32x4*)(ropec + t * 32 + 8 * s4); const GAS f32x4* sp = (const GAS f32x4*)(ropes + t * 32 + 8 * s4);
          const f32x4 c0 = cp[0], c1 = cp[1], s0 = sp[0], s1 = sp[1];
#pragma unroll
          for (int j = 0; j < 4; ++j) { cs[j] = c0[j]; cs[4 + j] = c1[j]; sn[j] = s0[j]; sn[4 + j] = s1[j]; } }
#pragma unroll
        for (int which = 0; which < 2; ++which) {
            float v[6][8];
            const float* gain = which ? k_gain : q_gain;
            if (which == 0) { const bf16* qp = Qb + (size_t)m * 3072 + h * 192;
#pragma unroll
                for (int c = 0; c < 4; ++c) unpack8(*(const GAS v4u*)(qp + 32 * s4 + 8 * c), v[c]);
                unpack8(*(const GAS v4u*)(qp + 128 + 8 * s4), v[4]); unpack8(*(const GAS v4u*)(qp + 160 + 8 * s4), v[5]); }
            else { const bf16* kp = KN + (size_t)m * 2048 + h * 128; const bf16* rp = ZK + (size_t)m * 256;
#pragma unroll
                for (int c = 0; c < 4; ++c) unpack8(*(const GAS v4u*)(kp + 32 * s4 + 8 * c), v[c]);
                unpack8(*(const GAS v4u*)(rp + 8 * s4), v[4]); unpack8(*(const GAS v4u*)(rp + 32 + 8 * s4), v[5]); }
            float ss = 0.f;
#pragma unroll
            for (int c = 0; c < 6; ++c)
#pragma unroll
                for (int j = 0; j < 8; ++j) ss += v[c][j] * v[c][j];
            ss += __shfl_xor(ss, 1); ss += __shfl_xor(ss, 2);
            const float r = 1.0f / sqrtf(ss * (1.f / 192.f) + RMS_EPS);
#pragma unroll
            for (int c = 0; c < 6; ++c) { const int d = (c < 4) ? 32 * s4 + 8 * c : (c == 4 ? 128 + 8 * s4 : 160 + 8 * s4);
                const GAS f32x4* gp = (const GAS f32x4*)(gain + d); const f32x4 g0 = gp[0], g1 = gp[1];
#pragma unroll
                for (int j = 0; j < 4; ++j) { v[c][j] *= r * g0[j]; v[c][4 + j] *= r * g1[j]; } }
#pragma unroll
            for (int j = 0; j < 8; ++j) { const float x1 = v[4][j], x2 = v[5][j]; v[4][j] = x1 * cs[j] - x2 * sn[j]; v[5][j] = x2 * cs[j] + x1 * sn[j]; }
            const float sc = (which == 0) ? 4.0f * 0.10411755178336285f : 0.25f;
            unsigned char* op = (which == 0) ? Q8 + (size_t)m * 3072 + h * 192 : K8 + ((size_t)((m / SEQ) * 16 + h) * SEQ + t) * 192;
#pragma unroll
            for (int c = 0; c < 4; ++c) *(GAS v2u*)(op + 32 * s4 + 8 * c) = pack8_f8(v[c], sc);
            *(GAS v2u*)(op + 128 + 8 * s4) = pack8_f8(v[4], sc); *(GAS v2u*)(op + 160 + 8 * s4) = pack8_f8(v[5], sc);
        }
    }
    for (int task = gw; task < 48 * 128; task += NGW) {
        const int pair = task >> 7, kb = task & 127;
        const bf16* vp = VH + ((size_t)pair * SEQ + (size_t)kb * 64) * 128 + 2 * lane;
        unsigned char* op = Vt8 + (((size_t)pair * 128 + kb) * 128 + 2 * lane) * 64;
#pragma unroll
        for (int hf = 0; hf < 2; ++hf) {
            unsigned w[32];
#pragma unroll
            for (int i = 0; i < 32; ++i) w[i] = *(const GAS unsigned*)(vp + (size_t)(hf * 32 + i) * 128);
            v4u d0[2], d1[2];
#pragma unroll
            for (int q4 = 0; q4 < 8; ++q4) {
                const unsigned a = w[4 * q4], b = w[4 * q4 + 1], c = w[4 * q4 + 2], d = w[4 * q4 + 3];
                const unsigned lo = pk4_f8(bflo(a), bflo(b), bflo(c), bflo(d)), hi = pk4_f8(bfhi(a), bfhi(b), bfhi(c), bfhi(d));
                if ((q4 & 3) == 0) { d0[q4 >> 2].x = lo; d1[q4 >> 2].x = hi; } else if ((q4 & 3) == 1) { d0[q4 >> 2].y = lo; d1[q4 >> 2].y = hi; }
                else if ((q4 & 3) == 2) { d0[q4 >> 2].z = lo; d1[q4 >> 2].z = hi; } else { d0[q4 >> 2].w = lo; d1[q4 >> 2].w = hi; }
            }
            *(GAS v4u*)(op + hf * 32) = d0[0]; *(GAS v4u*)(op + hf * 32 + 16) = d0[1];
            *(GAS v4u*)(op + 64 + hf * 32) = d1[0]; *(GAS v4u*)(op + 64 + hf * 32 + 16) = d1[1];
        }
    }
    }
    GRID_BAR();
#endif
    STAMP(5);
#if (PHM >> 5) & 1
    {
        kptr_t kp = karg(); unsigned char* ws = KWS();
        const unsigned char* Q8 = ws + WS_Q8; const unsigned char* K8 = ws + WS_K8; const unsigned char* Vt8 = ws + WS_VT8; unsigned char* BOUT = ws + WS_BOUT;
        for (int i = 0;; ++i) {
            int pair, qb;
            if (G == 256) { pair = i * 8 + (bx & 7); qb = bx >> 3; if (pair >= 48) break; }
            else { const int L = i * G + bx; if (L >= 48 * 32) break; pair = L >> 5; qb = L & 31; }
            const int sq = pair >> 4, h = pair & 15; const size_t tok0 = (size_t)sq * SEQ + (size_t)qb * 256;
            att::attn_unit(Q8 + tok0 * 3072 + h * 192, K8 + (size_t)pair * SEQ * 192, Vt8 + (size_t)pair * 128 * SEQ, BOUT + tok0 * 2048 + h * 128, lds + RING_OFF);
        }
    }
    GRID_BAR();
#endif
    STAMP(6);
#if (PHM >> 6) & 1
    {
        kptr_t kp = karg(); unsigned char* ws = KWS();
        bf16* AO = (bf16*)(ws + WS_AO); bf16* BOUT = (bf16*)(ws + WS_BOUT); bf16* Bbp = (bf16*)(ws + WS_BBP); bf16* Bbm = (bf16*)(ws + WS_BBM);
        bf16* Tb = (bf16*)(ws + WS_A); bf16* Mb = (bf16*)(ws + WS_F); bf16* ZG = (bf16*)(ws + WS_ZG);
    {
        pg8::Gemm g{AO, Bbp, M, 4096, 2048}; pg8::StaticOrder S; S.init(M, 4096, G, bx);
        pg8::EpiGateA E{Tb, ZG};
        pg8::gemm_phase<pg8::EpiGateA, pg8::StaticOrder, true, true>(lds + RING_OFF, g, S, E);
    }
    {
        pg8::Gemm g{BOUT, Bbm, M, 4096, 1024}; pg8::StaticOrder S; S.init(M, 4096, G, bx);
        pg8::EpiGateB8 E{Tb, Mb, ZG, 1.0f / 1024.0f};
        pg8::gemm_phase<pg8::EpiGateB8, pg8::StaticOrder, true, true, true>(lds + RING_OFF, g, S, E);
    }
    }
    GRID_BAR();
#endif
    STAMP(7);
#if (PHM >> 7) & 1
    {
        kptr_t kp = karg(); unsigned char* ws = KWS(); const float* x_prompt = KIN(0); const float* x_sample = KIN(1); float* out = KOUT();
        bf16* Mb = (bf16*)(ws + WS_F); bf16* Bo = (bf16*)(ws + WS_BO);
        pg8::Gemm g{Mb, Bo, M, 4096, 4096}; pg8::StaticOrder S; S.init(M, 4096, G, bx);
        pg8::EpiX1 E{x_prompt, x_sample, (bf16*)(ws + WS_H2), (float*)(ws + WS_ROWSS)};
        pg8::gemm_phase<pg8::EpiX1, pg8::StaticOrder, true, true>(lds + RING_OFF, g, S, E);
    }
#endif
    STAMP(8);
#if (PHM >> 8) & 1
    {
        PHASE_IDS();
        kptr_t kp = karg(); unsigned char* ws = KWS(); const float* norm_ffn_gain = KIN(15); const float* w_up = KIN(16); const float* w_down = KIN(19); float* out = KOUT();
        bf16* Bup = (bf16*)(ws + WS_BUP); bf16* Bdown = (bf16*)(ws + WS_BDOWN); bf16* H2 = (bf16*)(ws + WS_H2);
        constexpr int I_UP = 64 * 688, I_DOWN = 0;
        for (int it = gw; it < I_UP + I_DOWN; it += NGW) {
            int r = it;
            if (r < I_UP) { const int n0 = 32 * (r % 688); const int nn = (n0 < DFF) ? n0 : n0 - DFF; const int drow = 256 * (nn >> 7) + (nn & 127) + ((n0 < DFF) ? 0 : 128);
                tr_item(w_up, NUP, Bup, 4096, 64 * (r / 688), n0, drow, scr, lane, norm_ffn_gain); continue; } r -= I_UP;
            tr_item(w_down, 4096, Bdown, DFF, 64 * (r / 128), 32 * (r % 128), 32 * (r % 128), scr, lane);
        }
    }
    GRID_BAR();
#endif
    STAMP(9);
#if (PHM >> 9) & 1
    {
        kptr_t kp = karg(); unsigned char* ws = KWS(); const float* conv_w = KIN(17); const float* conv_b = KIN(18);
        bf16* H2 = (bf16*)(ws + WS_H2); bf16* Bup = (bf16*)(ws + WS_BUP); bf16* ACT = (bf16*)(ws + WS_ACT); bf16* SIDE = (bf16*)(ws + WS_SIDE);
        pg8::Gemm g{H2, Bup, M, NUP, DM}; pg8::DynRoundsOrder S; S.init2(M, NUP, G, bx, (unsigned*)(ws + WS_DYNCTR) + 1024, MISC + 4, 3);
        pg8::EpiConvGlu E{ACT, SIDE, conv_w, conv_b, lds + CONVSCR_OFF, (const float*)(ws + WS_ROWSS)};
        pg8::gemm_phase<pg8::EpiConvGlu, pg8::DynRoundsOrder, true, true>(lds + RING_OFF, g, S, E);
        {
            PHASE_IDS();
            const float* w_down = KIN(19); bf16* Bdown = (bf16*)(ws + WS_BDOWN); unsigned* qctr = (unsigned*)(ws + WS_DYNCTR) + 128;
            for (;;) {
                if (tidp_ == 0) MISC[5] = __hip_atomic_fetch_add(qctr, 1u, __ATOMIC_RELAXED, __HIP_MEMORY_SCOPE_AGENT);
                __syncthreads();
                const unsigned ch = MISC[5];
                __syncthreads();
                if (ch >= 172u * 128u / 16u) break;
#pragma unroll
                for (int j = 0; j < 2; ++j) { const int it = (int)ch * 16 + wavep_ * 2 + j;
                    tr_item(w_down, 4096, Bdown, DFF, 64 * (it / 128), 32 * (it % 128), 32 * (it % 128), scr, lane); }
            }
        }
    }
    GRID_BAR();
    STAMP(10);
    {
        PHASE_IDS();
        kptr_t kp = karg(); unsigned char* ws = KWS(); const float* conv_w = KIN(17); const float* conv_b = KIN(18);
        bf16* ACT = (bf16*)(ws + WS_ACT); const bf16* SIDE = (const bf16*)(ws + WS_SIDE);
        for (int idx = gt; idx < 768 * 1376; idx += NGT) {
            const int rw = idx / 1376, ch = idx % 1376, blk = rw >> 1, last = rw & 1, tile = ch >> 4, j8 = (ch & 15) * 8, c = tile * 128 + j8, col = tile * 256 + j8;
            const bf16* sb = SIDE + (size_t)blk * 4 * NUP + col;
            const v4u zero = {0u, 0u, 0u, 0u};
            v4u gmv, g0v, gpv, vmv, v0v, vpv;
            if (!last) { const bool has = (blk & 127) != 0;
                gmv = has ? *(const GAS v4u*)(sb - NUP) : zero; vmv = has ? *(const GAS v4u*)(sb - NUP + 128) : zero;
                g0v = *(const GAS v4u*)(sb); v0v = *(const GAS v4u*)(sb + 128); gpv = *(const GAS v4u*)(sb + NUP); vpv = *(const GAS v4u*)(sb + NUP + 128); }
            else { const bool has = (blk & 127) != 127;
                gmv = *(const GAS v4u*)(sb + 2 * NUP); vmv = *(const GAS v4u*)(sb + 2 * NUP + 128); g0v = *(const GAS v4u*)(sb + 3 * NUP); v0v = *(const GAS v4u*)(sb + 3 * NUP + 128);
                gpv = has ? *(const GAS v4u*)(sb + 4 * NUP) : zero; vpv = has ? *(const GAS v4u*)(sb + 4 * NUP + 128) : zero; }
            float gm[8], g0[8], gp[8], vm[8], v0[8], vp[8], a[8];
            unpack8(gmv, gm); unpack8(g0v, g0); unpack8(gpv, gp); unpack8(vmv, vm); unpack8(v0v, v0); unpack8(vpv, vp);
#pragma unroll
            for (int j = 0; j < 8; ++j) {
                const float gg = gm[j] * conv_w[c + j] + g0[j] * conv_w[NUP + c + j] + gp[j] * conv_w[2 * NUP + c + j] + conv_b[c + j];
                const float vv = vm[j] * conv_w[DFF + c + j] + v0[j] * conv_w[NUP + DFF + c + j] + vp[j] * conv_w[2 * NUP + DFF + c + j] + conv_b[DFF + c + j];
                a[j] = gg * __builtin_amdgcn_rcpf(1.0f + __expf(-gg)) * vv; }
            *(GAS v4u*)(ACT + ((size_t)blk * 64 + (last ? 63 : 0)) * DFF + c) = pack8(a);
        }
    }
    GRID_BAR();
    STAMP(11);
    {
        kptr_t kp = karg(); unsigned char* ws = KWS(); float* out = KOUT(); bf16* ACT = (bf16*)(ws + WS_ACT); bf16* Bdown = (bf16*)(ws + WS_BDOWN);
        pg8::Gemm g{ACT, Bdown, M, 4096, DFF}; pg8::StaticOrder S; S.init(M, 4096, G, bx);
        pg8::EpiOutX1 E{(const bf16*)(ws + WS_H2), out};
        pg8::gemm_phase<pg8::EpiOutX1, pg8::StaticOrder, true, true>(lds + RING_OFF, g, S, E);
    }
#endif
    STAMP(12);
#if defined(PROBE_A)
#if defined(PROBE_BAR_BX)
    if (bx == (PROBE_BAR_BX) && tid == 0) { unsigned d = MISC[31] * (unsigned)PROBE_MULT;
#else
    if (bx == 0 && tid == 0) { unsigned d = 0u;
#endif
        d += (MISC[16 + PROBE_B] - MISC[16 + PROBE_A]) * (unsigned)PROBE_MULT;
#if defined(PROBE_ATT)
        d += MISC[30] * (unsigned)PROBE_MULT;
#endif
#if defined(PROBE_CLK_A)
        d += (MISC[13] - MISC[12]) >> 4;
#endif
#if defined(PROBE_C)
        d += (MISC[16 + PROBE_D] - MISC[16 + PROBE_C]) * (unsigned)PROBE_MULT;
#endif
        if (d > 2000000u) d = 2000000u;
        const unsigned long long t0 = __builtin_amdgcn_s_memrealtime(); while ((unsigned)(__builtin_amdgcn_s_memrealtime() - t0) < d) __builtin_amdgcn_s_sleep(20); }
#endif
}

extern "C" void kernel_launch(void* const* d_in, const int* in_sizes, int n_in, void* d_out, int out_size, void* d_ws, size_t ws_size, hipStream_t stream) {
    static int grid = 0;
    if (grid == 0) {
        if (n_in != 20 || in_sizes[0] != MP * DM || in_sizes[1] != (M - MP) * DM || out_size != M * DM || ws_size < WS_NEED) {
            fprintf(stderr, "kernel_launch: shape mismatch (n_in %d, in0 %d, in1 %d, out %d, ws %zu, need %zu); nothing launched\n", n_in, n_in > 0 ? in_sizes[0] : -1, n_in > 1 ? in_sizes[1] : -1, out_size, ws_size, (size_t)WS_NEED); grid = -1; return; }
        int dev = 0, cus = 0, per_cu = 0;
        if (hipGetDevice(&dev) != hipSuccess || hipDeviceGetAttribute(&cus, hipDeviceAttributeMultiprocessorCount, dev) != hipSuccess) { fprintf(stderr, "kernel_launch: device query failed\n"); grid = -1; return; }
        if (hipFuncSetAttribute((const void*)fwd_kernel, hipFuncAttributeMaxDynamicSharedMemorySize, LDS_BYTES) != hipSuccess) { fprintf(stderr, "kernel_launch: hipFuncSetAttribute failed\n"); grid = -1; return; }
        if (hipOccupancyMaxActiveBlocksPerMultiprocessor(&per_cu, (const void*)fwd_kernel, NWAVES * 64, LDS_BYTES) != hipSuccess || per_cu < 1)
            fprintf(stderr, "kernel_launch: note: occupancy query reports %d workgroups per CU\n", per_cu);
        (void)hipGetLastError();
        grid = cus;
    }
    if (grid < 0) return;
    if (hipMemsetAsync((char*)d_ws + WS_CTL, 0, CTL_ZERO_BYTES, stream) != hipSuccess) { fprintf(stderr, "kernel_launch: memset failed\n"); return; }
    Args a{};
    for (int i = 0; i < 20; ++i) a.in[i] = (const float*)d_in[i];
    a.out = (float*)d_out; a.ws = (unsigned char*)d_ws;
    hipLaunchKernelGGL(fwd_kernel, dim3(grid), dim3(NWAVES * 64), LDS_BYTES, stream, a);
    const hipError_t le = hipPeekAtLastError();
    if (le != hipSuccess) fprintf(stderr, "kernel_launch: launch failed: %s\n", hipGetErrorName(le));
}
```

```cpp
#include <hip/hip_runtime.h>
#include <cstdio>
#include <cstdint>
namespace pg8 {
#define PG8_LAS __attribute__((address_space(3)))
typedef unsigned short bf16_t;
typedef short bf16x8 __attribute__((ext_vector_type(8)));
typedef float f32x4 __attribute__((ext_vector_type(4)));
typedef unsigned u32x4 __attribute__((ext_vector_type(4)));
constexpr int BM = 256, BK = 64, HALF = 128, HTB = HALF * BK * 2  , STAGE_BYTES = 8 * HTB, NXCD = 8, WGM = 8;

__host__ __device__ __forceinline__ int lds_byte(int r, int c) { const int st = (r >> 4) * 2 + (c >> 5), rr = r & 15, cc = c & 31, ob = rr * 64 + cc * 2; return st * 1024 + (ob ^ (((ob >> 9) & 1) << 5)); }
__host__ __device__ __forceinline__ void stage_rc(int b, int& R, int& C) { const int st = b / 1024, sb = b % 1024, swz = sb ^ (((sb >> 9) & 1) << 5); R = (st >> 1) * 16 + swz / 64; C = (st & 1) * 32 + (swz % 64) / 2; }
__host__ __device__ __forceinline__ int perm32(int rho) { const int n = rho >> 4, i = rho & 15; return 8 * (i >> 2) + 4 * n + (i & 3); }

struct Unit { int pm, pn; };
struct Gemm { const bf16_t* A; const bf16_t* Bt; int M, N, K; int lda; };

struct StaticOrder {
    int nM, nN, nwg, G, c;
    __host__ __device__ void init(int M, int N, int G_, int c_) { nM = M / BM; nN = N / BM; nwg = nM * nN; G = G_; c = c_; }
    __host__ __device__ bool next(int i, Unit& u) const {
        const long L = (long)i * G + c; if (L >= nwg) return false;
        int wgid = (int)L; { const int q = nwg / NXCD, r = nwg % NXCD, xcd = wgid % NXCD, off = wgid / NXCD; wgid = (xcd < r ? xcd * (q + 1) : r * (q + 1) + (xcd - r) * q) + off; }
        const int nig = WGM * nN, gid = wgid / nig, fm = gid * WGM, gsz = (nM - fm) < WGM ? (nM - fm) : WGM;
        u.pm = fm + ((wgid % nig) % gsz); u.pn = (wgid % nig) / gsz; return true;
    }
    __device__ __forceinline__ void a_ready(const Unit&) const {}
    __device__ __forceinline__ void done(const Unit&) const {}
};
__device__ __forceinline__ unsigned cvt_pk_bf16(float lo, float hi) { unsigned r; asm volatile("v_cvt_pk_bf16_f32 %0, %1, %2" : "=v"(r) : "v"(lo), "v"(hi)); return r; }
typedef float f32x2 __attribute__((ext_vector_type(2)));

struct DynTailOrder : StaticOrder {
    unsigned* ctr; volatile PG8_LAS unsigned* slot; int nfull, rem;
    __device__ void init2(int M, int N, int G_, int c_, unsigned* ctr_, volatile PG8_LAS unsigned* slot_) { init(M, N, G_, c_); ctr = ctr_; slot = slot_; nfull = nwg / G_; rem = nwg % G_; }
    __device__ __forceinline__ bool next(int i, Unit& u) const {
        if (i < nfull) return StaticOrder::next(i, u);
        if (i > nfull || rem == 0) return false;
        if (threadIdx.x < 64) {
            unsigned t = 0u; if (threadIdx.x == 0) t = __hip_atomic_fetch_add(ctr, 1u, __ATOMIC_RELAXED, __HIP_MEMORY_SCOPE_AGENT);
            asm volatile("s_waitcnt vmcnt(0)" ::: "memory");
            if (threadIdx.x == 0) *slot = t;
            asm volatile("s_waitcnt lgkmcnt(0)" ::: "memory");
        }
        asm volatile("" ::: "memory"); __builtin_amdgcn_s_barrier(); asm volatile("" ::: "memory");
        const unsigned t = *slot;
        if (t >= (unsigned)rem) return false;
        StaticOrder tmp = *this; tmp.c = (int)t; return tmp.StaticOrder::next(nfull, u);
    }
};
struct DynRoundsOrder : StaticOrder {
    unsigned* ctr; volatile PG8_LAS unsigned* slot; int nstat;
    __device__ void init2(int M, int N, int G_, int c_, unsigned* ctr_, volatile PG8_LAS unsigned* slot_, int R) { init(M, N, G_, c_); ctr = ctr_; slot = slot_; nstat = nwg / G_ - R; if (nstat < 0) nstat = 0; }
    __device__ __forceinline__ bool next(int i, Unit& u) const {
        if (i < nstat) return StaticOrder::next(i, u);
        const int q = nwg / NXCD, base = nstat * (G / NXCD);
        if (threadIdx.x < 64) {
            unsigned code = 0xffffffffu;
            if (threadIdx.x == 0) {
                const int x0 = c % NXCD;
                for (int k = 0; k < NXCD; ++k) { const int x = (x0 + k) % NXCD;
                    const unsigned t = __hip_atomic_fetch_add(ctr + 64 * x, 1u, __ATOMIC_RELAXED, __HIP_MEMORY_SCOPE_AGENT);
                    const int off = base + (int)t; if (off < q) { code = (unsigned)(x * q + off); break; } }
            }
            asm volatile("s_waitcnt vmcnt(0)" ::: "memory");
            if (threadIdx.x == 0) *slot = code;
            asm volatile("s_waitcnt lgkmcnt(0)" ::: "memory");
        }
        asm volatile("" ::: "memory"); __builtin_amdgcn_s_barrier(); asm volatile("" ::: "memory");
        const unsigned code = *slot;
        if (code == 0xffffffffu) return false;
        const int wgid = (int)code;
        const int nig = WGM * nN, gid = wgid / nig, fm = gid * WGM, gsz = (nM - fm) < WGM ? (nM - fm) : WGM;
        u.pm = fm + ((wgid % nig) % gsz); u.pn = (wgid % nig) / gsz; return true;
    }
};
struct PoolOrder {
    int G, c;
    __device__ __forceinline__ bool next(int i, Unit& u) const {
        const int L = i * G + c; if (L >= 768) return false;
        const int g = L / 192, r = L % 192; u.pm = g * 96 + (r >> 1); u.pn = g * 2 + (r & 1); return true;
    }
    __device__ __forceinline__ void a_ready(const Unit&) const {}
    __device__ __forceinline__ void done(const Unit&) const {}
};
typedef unsigned u32x2 __attribute__((ext_vector_type(2)));
__device__ __forceinline__ void st8(bf16_t* p, const f32x4 v0, const f32x4 v1) {
    u32x4 w; w.x = cvt_pk_bf16(v0[0], v0[1]); w.y = cvt_pk_bf16(v0[2], v0[3]); w.z = cvt_pk_bf16(v1[0], v1[1]); w.w = cvt_pk_bf16(v1[2], v1[3]);
    *(u32x4*)p = w;
}
__device__ __forceinline__ void ld8(const bf16_t* p, f32x4& v0, f32x4& v1) {
    const u32x4 w = *(const u32x4*)p;
    v0[0] = __uint_as_float(w.x << 16); v0[1] = __uint_as_float(w.x & 0xffff0000u); v0[2] = __uint_as_float(w.y << 16); v0[3] = __uint_as_float(w.y & 0xffff0000u);
    v1[0] = __uint_as_float(w.z << 16); v1[1] = __uint_as_float(w.z & 0xffff0000u); v1[2] = __uint_as_float(w.w << 16); v1[3] = __uint_as_float(w.w & 0xffff0000u);
}
__device__ __forceinline__ float sigmoidf_(float x) { return __builtin_amdgcn_rcpf(1.0f + __expf(-x)); }
__device__ __forceinline__ f32x4 sig4(const f32x4 x) { f32x4 r; r[0] = sigmoidf_(x[0]); r[1] = sigmoidf_(x[1]); r[2] = sigmoidf_(x[2]); r[3] = sigmoidf_(x[3]); return r; }

struct EpiBf {
    static constexpr bool PERM = true, AFTER_DRAIN = false;
    bf16_t* O; int ldc;
    __device__ __forceinline__ void operator()(const f32x4 (&acc)[2][2][4][2], const Unit& u, int wr, int wc, int fr_in, int fq_in) const {
        int fr = fr_in, fq = fq_in; asm volatile("" : "+v"(fr), "+v"(fq));
        const int row0 = u.pm * BM + wr * 64 + fr, col0 = u.pn * BM + wc * 32 + 8 * fq;
#pragma unroll
        for (int ai = 0; ai < 2; ++ai)
#pragma unroll
            for (int m = 0; m < 4; ++m) { bf16_t* rowp = O + (size_t)(row0 + ai * HALF + m * 16) * ldc + col0;
#pragma unroll
                for (int bj = 0; bj < 2; ++bj) st8(rowp + bj * HALF, acc[ai][bj][m][0], acc[ai][bj][m][1]); }
    }
};
struct EpiKV {
    static constexpr bool PERM = true, AFTER_DRAIN = false;
    bf16_t *KN, *VH;
    __device__ __forceinline__ void operator()(const f32x4 (&acc)[2][2][4][2], const Unit& u, int wr, int wc, int fr_in, int fq_in) const {
        int fr = fr_in, fq = fq_in; asm volatile("" : "+v"(fr), "+v"(fq));
        const int rl0 = wr * 64 + fr, c0 = wc * 32 + 8 * fq, sq = u.pm >> 5, t0 = (u.pm & 31) * BM;
        bf16_t* kn = KN + (size_t)u.pm * BM * 2048 + u.pn * 128 + c0;
        bf16_t* vh = VH + ((size_t)(sq * 16 + u.pn) * 8192 + t0) * 128 + c0;
#pragma unroll
        for (int ai = 0; ai < 2; ++ai)
#pragma unroll
            for (int m = 0; m < 4; ++m) { const int rl = rl0 + ai * HALF + m * 16;
                st8(kn + (size_t)rl * 2048, acc[ai][0][m][0], acc[ai][0][m][1]);
                st8(vh + (size_t)rl * 128, acc[ai][1][m][0], acc[ai][1][m][1]); }
    }
};
struct EpiKV8 {
    static constexpr bool PERM = true, AFTER_DRAIN = false;
    bf16_t *KN, *VH; float cs;
    __device__ __forceinline__ void operator()(const f32x4 (&acc)[2][2][4][2], const Unit& u, int wr, int wc, int fr_in, int fq_in) const {
        int fr = fr_in, fq = fq_in; asm volatile("" : "+v"(fr), "+v"(fq));
        const int rl0 = wr * 64 + fr, c0 = wc * 32 + 8 * fq, sq = u.pm >> 5, t0 = (u.pm & 31) * BM;
        bf16_t* kn = KN + (size_t)u.pm * BM * 2048 + u.pn * 128 + c0;
        bf16_t* vh = VH + ((size_t)(sq * 16 + u.pn) * 8192 + t0) * 128 + c0;
#pragma unroll
        for (int ai = 0; ai < 2; ++ai)
#pragma unroll
            for (int m = 0; m < 4; ++m) { const int rl = rl0 + ai * HALF + m * 16;
                st8(kn + (size_t)rl * 2048, acc[ai][0][m][0] * cs, acc[ai][0][m][1] * cs);
                st8(vh + (size_t)rl * 128, acc[ai][1][m][0] * cs, acc[ai][1][m][1] * cs); }
    }
};
struct EpiZa {
    static constexpr bool PERM = true, AFTER_DRAIN = false;
    bf16_t *ZA, *ZG;
    __device__ __forceinline__ void operator()(const f32x4 (&acc)[2][2][4][2], const Unit& u, int wr, int wc, int fr_in, int fq_in) const {
        int fr = fr_in, fq = fq_in; asm volatile("" : "+v"(fr), "+v"(fq));
        bf16_t* base; int ldc, colt;
        if (u.pn < 8) { base = ZA; ldc = 3584; colt = u.pn * 256; } else { base = ZG; ldc = 8192; colt = (u.pn - 8) * 256; }
        const int row0 = u.pm * BM + wr * 64 + fr, col0 = colt + wc * 32 + 8 * fq;
#pragma unroll
        for (int ai = 0; ai < 2; ++ai)
#pragma unroll
            for (int m = 0; m < 4; ++m) { bf16_t* rowp = base + (size_t)(row0 + ai * HALF + m * 16) * ldc + col0;
#pragma unroll
                for (int bj = 0; bj < 2; ++bj) st8(rowp + bj * HALF, acc[ai][bj][m][0], acc[ai][bj][m][1]); }
    }
};
struct EpiZb {
    static constexpr bool PERM = true, AFTER_DRAIN = false;
    bf16_t *ZA, *ZG, *ZK; float cs;
    __device__ __forceinline__ void operator()(const f32x4 (&acc)[2][2][4][2], const Unit& u, int wr, int wc, int fr_in, int fq_in) const {
        int fr = fr_in, fq = fq_in; asm volatile("" : "+v"(fr), "+v"(fq));
        bf16_t* base; int ldc, colt;
        if (u.pn < 6) { base = ZA; ldc = 3584; colt = 2048 + u.pn * 256; } else if (u.pn < 22) { base = ZG; ldc = 8192; colt = 4096 + (u.pn - 6) * 256; } else if (u.pn == 22) { base = ZK; ldc = 256; colt = 0; }
        else { base = ZG; ldc = 8192; colt = (u.pn - 23) * 256; }
        const int row0 = u.pm * BM + wr * 64 + fr, col0 = colt + wc * 32 + 8 * fq;
#pragma unroll
        for (int ai = 0; ai < 2; ++ai)
#pragma unroll
            for (int m = 0; m < 4; ++m) { bf16_t* rowp = base + (size_t)(row0 + ai * HALF + m * 16) * ldc + col0;
#pragma unroll
                for (int bj = 0; bj < 2; ++bj) st8(rowp + bj * HALF, acc[ai][bj][m][0] * cs, acc[ai][bj][m][1] * cs); }
    }
};
struct EpiZ {
    static constexpr bool PERM = true, AFTER_DRAIN = false;
    bf16_t *ZA, *ZG, *ZK;
    __device__ __forceinline__ void operator()(const f32x4 (&acc)[2][2][4][2], const Unit& u, int wr, int wc, int fr_in, int fq_in) const {
        int fr = fr_in, fq = fq_in; asm volatile("" : "+v"(fr), "+v"(fq));
        bf16_t* base; int ldc, colt;
        if (u.pn < 14) { base = ZA; ldc = 3584; colt = u.pn * 256; } else if (u.pn < 46) { base = ZG; ldc = 8192; colt = (u.pn - 14) * 256; } else { base = ZK; ldc = 256; colt = 0; }
        const int row0 = u.pm * BM + wr * 64 + fr, col0 = colt + wc * 32 + 8 * fq;
#pragma unroll
        for (int ai = 0; ai < 2; ++ai)
#pragma unroll
            for (int m = 0; m < 4; ++m) { bf16_t* rowp = base + (size_t)(row0 + ai * HALF + m * 16) * ldc + col0;
#pragma unroll
                for (int bj = 0; bj < 2; ++bj) st8(rowp + bj * HALF, acc[ai][bj][m][0], acc[ai][bj][m][1]); }
    }
};
struct EpiPool {
    static constexpr bool PERM = true, AFTER_DRAIN = false;
    bf16_t* O; const float* scale;
    __device__ __forceinline__ void operator()(const f32x4 (&acc)[2][2][4][2], const Unit& u, int wr, int wc, int fr_in, int fq_in) const {
        int fr = fr_in, fq = fq_in; asm volatile("" : "+v"(fr), "+v"(fq));
        const int g = u.pm / 96, row0 = (u.pm % 96) * BM + wr * 64 + fr, col0 = g * 512 + (u.pn & 1) * 256 + wc * 32 + 8 * fq;
        f32x4 sv[2][2];
#pragma unroll
        for (int bj = 0; bj < 2; ++bj)
#pragma unroll
            for (int n = 0; n < 2; ++n) sv[bj][n] = *(const f32x4*)(scale + col0 + bj * HALF + 4 * n);
#pragma unroll
        for (int ai = 0; ai < 2; ++ai)
#pragma unroll
            for (int m = 0; m < 4; ++m) { bf16_t* rowp = O + (size_t)(row0 + ai * HALF + m * 16) * 2048 + col0;
#pragma unroll
                for (int bj = 0; bj < 2; ++bj) st8(rowp + bj * HALF, acc[ai][bj][m][0] * sv[bj][0], acc[ai][bj][m][1] * sv[bj][1]); }
    }
};
struct EpiGateA {
    static constexpr bool PERM = true, AFTER_DRAIN = false;
    bf16_t* T; const bf16_t* ZG;
    __device__ __forceinline__ void operator()(const f32x4 (&acc)[2][2][4][2], const Unit& u, int wr, int wc, int fr_in, int fq_in) const {
        int fr = fr_in, fq = fq_in; asm volatile("" : "+v"(fr), "+v"(fq));
        const int row0 = u.pm * BM + wr * 64 + fr, col0 = u.pn * BM + wc * 32 + 8 * fq;
#pragma unroll
        for (int ai = 0; ai < 2; ++ai)
#pragma unroll
            for (int m = 0; m < 4; ++m) { const size_t r = (size_t)(row0 + ai * HALF + m * 16);
#pragma unroll
                for (int bj = 0; bj < 2; ++bj) { f32x4 g0, g1; ld8(ZG + r * 8192 + col0 + bj * HALF, g0, g1);
                    st8(T + r * 4096 + col0 + bj * HALF, acc[ai][bj][m][0] * sig4(g0), acc[ai][bj][m][1] * sig4(g1)); } }
    }
};
struct EpiGateB {
    static constexpr bool PERM = true, AFTER_DRAIN = false;
    const bf16_t* T; bf16_t* Mo; const bf16_t* ZG;
    __device__ __forceinline__ void operator()(const f32x4 (&acc)[2][2][4][2], const Unit& u, int wr, int wc, int fr_in, int fq_in) const {
        int fr = fr_in, fq = fq_in; asm volatile("" : "+v"(fr), "+v"(fq));
        const int row0 = u.pm * BM + wr * 64 + fr, col0 = u.pn * BM + wc * 32 + 8 * fq;
#pragma unroll
        for (int ai = 0; ai < 2; ++ai)
#pragma unroll
            for (int m = 0; m < 4; ++m) { const size_t r = (size_t)(row0 + ai * HALF + m * 16);
#pragma unroll
                for (int bj = 0; bj < 2; ++bj) { f32x4 g0, g1, t0, t1; ld8(ZG + r * 8192 + 4096 + col0 + bj * HALF, g0, g1); ld8(T + r * 4096 + col0 + bj * HALF, t0, t1);
                    st8(Mo + r * 4096 + col0 + bj * HALF, t0 + acc[ai][bj][m][0] * sig4(g0), t1 + acc[ai][bj][m][1] * sig4(g1)); } }
    }
};
struct EpiGateB8 {
    static constexpr bool PERM = true, AFTER_DRAIN = false;
    const bf16_t* T; bf16_t* Mo; const bf16_t* ZG; float cs;
    __device__ __forceinline__ void operator()(const f32x4 (&acc)[2][2][4][2], const Unit& u, int wr, int wc, int fr_in, int fq_in) const {
        int fr = fr_in, fq = fq_in; asm volatile("" : "+v"(fr), "+v"(fq));
        const int row0 = u.pm * BM + wr * 64 + fr, col0 = u.pn * BM + wc * 32 + 8 * fq;
#pragma unroll
        for (int ai = 0; ai < 2; ++ai)
#pragma unroll
            for (int m = 0; m < 4; ++m) { const size_t r = (size_t)(row0 + ai * HALF + m * 16);
#pragma unroll
                for (int bj = 0; bj < 2; ++bj) { f32x4 g0, g1, t0, t1; ld8(ZG + r * 8192 + 4096 + col0 + bj * HALF, g0, g1); ld8(T + r * 4096 + col0 + bj * HALF, t0, t1);
                    st8(Mo + r * 4096 + col0 + bj * HALF, t0 + acc[ai][bj][m][0] * (sig4(g0) * cs), t1 + acc[ai][bj][m][1] * (sig4(g1) * cs)); } }
    }
};
__device__ __forceinline__ float qsum16(float v) { auto r = __builtin_amdgcn_permlane16_swap(__float_as_uint(v), __float_as_uint(v), false, false); return __uint_as_float(r[0]) + __uint_as_float(r[1]); }
__device__ __forceinline__ float qsum32(float v) { auto r = __builtin_amdgcn_permlane32_swap(__float_as_uint(v), __float_as_uint(v), false, false); return __uint_as_float(r[0]) + __uint_as_float(r[1]); }
struct EpiX1 {
    static constexpr bool PERM = true, AFTER_DRAIN = false;
    const float *xp, *xs; bf16_t* X1; float* rowss;
    __device__ __forceinline__ void operator()(const f32x4 (&acc)[2][2][4][2], const Unit& u, int wr, int wc, int fr_in, int fq_in) const {
        int fr = fr_in, fq = fq_in; asm volatile("" : "+v"(fr), "+v"(fq));
        const float* xb = (u.pm < 64) ? xp + (size_t)u.pm * BM * 4096 : xs + (size_t)(u.pm - 64) * BM * 4096;
        const int rl0 = wr * 64 + fr, col0 = u.pn * BM + wc * 32 + 8 * fq;
        float ssr[2][4];
#pragma unroll
        for (int ai = 0; ai < 2; ++ai)
#pragma unroll
            for (int m = 0; m < 4; ++m) { const int rl = rl0 + ai * HALF + m * 16; const size_t off = (size_t)rl * 4096 + col0; float ss = 0.f;
#pragma unroll
                for (int bj = 0; bj < 2; ++bj) { const f32x4 v0 = *(const f32x4*)(xb + off + bj * HALF) + acc[ai][bj][m][0], v1 = *(const f32x4*)(xb + off + bj * HALF + 4) + acc[ai][bj][m][1];
                    ss += (v0[0] * v0[0] + v0[1] * v0[1]) + (v0[2] * v0[2] + v0[3] * v0[3]) + (v1[0] * v1[0] + v1[1] * v1[1]) + (v1[2] * v1[2] + v1[3] * v1[3]);
                    st8(X1 + (size_t)u.pm * BM * 4096 + off + bj * HALF, v0, v1); }
                ssr[ai][m] = ss;
                asm volatile("" ::: "memory"); }
#pragma unroll
        for (int ai = 0; ai < 2; ++ai)
#pragma unroll
            for (int m = 0; m < 4; ++m) { const float ss = qsum32(qsum16(ssr[ai][m]));
                if (fq == 0) __hip_atomic_fetch_add(rowss + u.pm * BM + rl0 + ai * HALF + m * 16, ss, __ATOMIC_RELAXED, __HIP_MEMORY_SCOPE_AGENT); }
    }
};
struct EpiOutX1 {
    static constexpr bool PERM = false, AFTER_DRAIN = false;
    const bf16_t* X1; float* out;
    __device__ __forceinline__ void operator()(const f32x4 (&acc)[2][2][4][2], const Unit& u, int wr, int wc, int fr_in, int fq_in) const {
        int fr = fr_in, fq = fq_in; asm volatile("" : "+v"(fr), "+v"(fq));
        const bf16_t* xb = X1 + (size_t)u.pm * BM * 4096; float* ob = out + (size_t)u.pm * BM * 4096;
        const int rl0 = wr * 64 + fr, col0 = u.pn * BM + wc * 32 + 4 * fq;
#pragma unroll
        for (int ai = 0; ai < 2; ++ai)
#pragma unroll
            for (int m = 0; m < 4; ++m) { const size_t off = (size_t)(rl0 + ai * HALF + m * 16) * 4096 + col0;
#pragma unroll
                for (int bj = 0; bj < 2; ++bj)
#pragma unroll
                    for (int n = 0; n < 2; ++n) { const u32x2 w = *(const u32x2*)(xb + off + bj * HALF + n * 16);
                        const f32x4 xv = {__uint_as_float(w.x << 16), __uint_as_float(w.x & 0xffff0000u), __uint_as_float(w.y << 16), __uint_as_float(w.y & 0xffff0000u)};
                        *(f32x4*)(ob + off + bj * HALF + n * 16) = xv + acc[ai][bj][m][n]; }
                asm volatile("" ::: "memory"); }
    }
};
struct EpiResX {
    static constexpr bool PERM = false, AFTER_DRAIN = false;
    const float *xp, *xs; float* out;
    __device__ __forceinline__ void operator()(const f32x4 (&acc)[2][2][4][2], const Unit& u, int wr, int wc, int fr_in, int fq_in) const {
        int fr = fr_in, fq = fq_in; asm volatile("" : "+v"(fr), "+v"(fq));
        const float* xb = (u.pm < 64) ? xp + (size_t)u.pm * BM * 4096 : xs + (size_t)(u.pm - 64) * BM * 4096;
        float* ob = out + (size_t)u.pm * BM * 4096;
        const int rl0 = wr * 64 + fr, col0 = u.pn * BM + wc * 32 + 4 * fq;
#pragma unroll
        for (int ai = 0; ai < 2; ++ai)
#pragma unroll
            for (int m = 0; m < 4; ++m) { const size_t off = (size_t)(rl0 + ai * HALF + m * 16) * 4096 + col0;
#pragma unroll
                for (int bj = 0; bj < 2; ++bj)
#pragma unroll
                    for (int n = 0; n < 2; ++n) { const f32x4 xv = *(const f32x4*)(xb + off + bj * HALF + n * 16); *(f32x4*)(ob + off + bj * HALF + n * 16) = xv + acc[ai][bj][m][n]; }
                asm volatile("" ::: "memory"); }
    }
};
struct EpiResOut {
    static constexpr bool PERM = false, AFTER_DRAIN = false;
    float* out;
    __device__ __forceinline__ void operator()(const f32x4 (&acc)[2][2][4][2], const Unit& u, int wr, int wc, int fr_in, int fq_in) const {
        int fr = fr_in, fq = fq_in; asm volatile("" : "+v"(fr), "+v"(fq));
        float* ob = out + (size_t)u.pm * BM * 4096;
        const int rl0 = wr * 64 + fr, col0 = u.pn * BM + wc * 32 + 4 * fq;
#pragma unroll
        for (int ai = 0; ai < 2; ++ai)
#pragma unroll
            for (int m = 0; m < 4; ++m) { const size_t off = (size_t)(rl0 + ai * HALF + m * 16) * 4096 + col0;
#pragma unroll
                for (int bj = 0; bj < 2; ++bj)
#pragma unroll
                    for (int n = 0; n < 2; ++n) { const f32x4 xv = *(const f32x4*)(ob + off + bj * HALF + n * 16); *(f32x4*)(ob + off + bj * HALF + n * 16) = xv + acc[ai][bj][m][n]; }
                asm volatile("" ::: "memory"); }
    }
};

__device__ __forceinline__ float silu_(float x) { return x * __builtin_amdgcn_rcpf(1.0f + __builtin_amdgcn_exp2f(-1.4426950408889634f * x)); }
constexpr int CONV_SLICE_BYTES = 66 * 32;
__device__ __forceinline__ void st4(bf16_t* p, const f32x4 v) { u32x2 w; w.x = cvt_pk_bf16(v[0], v[1]); w.y = cvt_pk_bf16(v[2], v[3]); *(u32x2*)p = w; }
struct EpiConvGlu {
    static constexpr bool PERM = false, AFTER_DRAIN = false;
    bf16_t* ACT; bf16_t* SIDE; const float* cw; const float* cb; PG8_LAS unsigned char* scr; const float* rowss;
    __device__ __forceinline__ void conv4(const f32x4 (&a)[4][2], int n, const float* wp, const float* bp, PG8_LAS unsigned char* sl, f32x4 (&out)[4]) const {
        const f32x4 w0 = *(const f32x4*)(wp), w1 = *(const f32x4*)(wp + 22016), w2 = *(const f32x4*)(wp + 2 * 22016), bb = *(const f32x4*)(bp);
#pragma unroll
        for (int m = 0; m < 4; ++m) { u32x2 w; w.x = cvt_pk_bf16(a[m][n][0], a[m][n][1]); w.y = cvt_pk_bf16(a[m][n][2], a[m][n][3]); *(PG8_LAS u32x2*)(sl + m * 512) = w; }
        asm volatile("s_waitcnt lgkmcnt(0)" ::: "memory");
        u32x2 pv[4], nx[4];
#pragma unroll
        for (int m = 0; m < 4; ++m) { pv[m] = *(const PG8_LAS u32x2*)(sl + m * 512 - 32); nx[m] = *(const PG8_LAS u32x2*)(sl + m * 512 + 32); }
        asm volatile("s_waitcnt lgkmcnt(0)" ::: "memory");
#pragma unroll
        for (int m = 0; m < 4; ++m) {
            const float p[4] = {__uint_as_float(pv[m].x << 16), __uint_as_float(pv[m].x & 0xffff0000u), __uint_as_float(pv[m].y << 16), __uint_as_float(pv[m].y & 0xffff0000u)};
            const float q[4] = {__uint_as_float(nx[m].x << 16), __uint_as_float(nx[m].x & 0xffff0000u), __uint_as_float(nx[m].y << 16), __uint_as_float(nx[m].y & 0xffff0000u)};
#pragma unroll
            for (int i = 0; i < 4; ++i) out[m][i] = fmaf(w0[i], p[i], fmaf(w1[i], a[m][n][i], fmaf(w2[i], q[i], bb[i])));
        }
    }
    __device__ __forceinline__ void operator()(f32x4 (&acc)[2][2][4][2], const Unit& u, int wr, int wc, int fr_in, int fq_in) const {
        int fr = fr_in, fq = fq_in; asm volatile("" : "+v"(fr), "+v"(fq));
#pragma unroll
        for (int ai = 0; ai < 2; ++ai)
#pragma unroll
            for (int m = 0; m < 4; ++m) { const float rs = 1.0f / sqrtf(rowss[u.pm * BM + ai * HALF + wr * 64 + m * 16 + fr] * (1.f / 4096.f) + 1e-6f);
#pragma unroll
                for (int bj = 0; bj < 2; ++bj)
#pragma unroll
                    for (int n = 0; n < 2; ++n) acc[ai][bj][m][n] *= rs; }
        const int chan0 = u.pn * 128 + wc * 32 + 4 * fq;
        const bool e0 = (fr == 0), e15 = (fr == 15);
        PG8_LAS unsigned char* sl = scr + (wr * 4 + wc) * CONV_SLICE_BYTES + (1 + fr) * 32 + fq * 8;
#pragma unroll
        for (int ai = 0; ai < 2; ++ai) {
            const int blk = u.pm * 4 + ai * 2 + wr;
#pragma unroll
            for (int bj = 0; bj < 2; ++bj)
#pragma unroll
                for (int n = 0; n < 2; ++n) { const int col = u.pn * 256 + bj * 128 + wc * 32 + 16 * n + 4 * fq;
                    if (fr < 2) st4(SIDE + ((size_t)blk * 4 + fr) * 22016 + col, acc[ai][bj][0][n]);
                    if (fr >= 14) st4(SIDE + ((size_t)blk * 4 + (fr - 12)) * 22016 + col, acc[ai][bj][3][n]); }
#pragma unroll
            for (int n = 0; n < 2; ++n) {
                f32x4 cg[4], cv[4];
                asm volatile("" ::: "memory");
                conv4(acc[ai][0], n, cw + chan0 + 16 * n, cb + chan0 + 16 * n, sl, cg);
                conv4(acc[ai][1], n, cw + 11008 + chan0 + 16 * n, cb + 11008 + chan0 + 16 * n, sl, cv);
#pragma unroll
                for (int m = 0; m < 4; ++m) {
                    f32x4 r;
#pragma unroll
                    for (int i = 0; i < 4; ++i) r[i] = silu_(cg[m][i]) * cv[m][i];
                    const bool skip = (m == 0 && e0) || (m == 3 && e15);
                    if (!skip) st4(ACT + (size_t)(u.pm * BM + ai * HALF + wr * 64 + m * 16 + fr) * 11008 + chan0 + 16 * n, r);
                }
            }
        }
    }
};
typedef int pg8_v8i __attribute__((ext_vector_type(8)));
typedef int pg8_v4i __attribute__((ext_vector_type(4)));
__device__ __forceinline__ f32x4 pg8_mfma128(const bf16x8 a0, const bf16x8 a1, const bf16x8 b0, const bf16x8 b1, const f32x4 c, int sc) {
    const pg8_v4i x0 = __builtin_bit_cast(pg8_v4i, a0), x1 = __builtin_bit_cast(pg8_v4i, a1), y0 = __builtin_bit_cast(pg8_v4i, b0), y1 = __builtin_bit_cast(pg8_v4i, b1);
    const pg8_v8i a = {x0.x, x0.y, x0.z, x0.w, x1.x, x1.y, x1.z, x1.w}, b = {y0.x, y0.y, y0.z, y0.w, y1.x, y1.y, y1.z, y1.w};
    f32x4 d = c;
    asm volatile("v_mfma_scale_f32_16x16x128_f8f6f4 %0, %1, %2, %0, %3, %3 op_sel_hi:[0,0,0]" : "+v"(d) : "v"(a), "v"(b), "v"(sc));
    return d;
}
template <class Epi, class Sched, bool ALIGN_EPI = false, bool SP2 = false, bool FP8 = false>
__device__ __forceinline__ void gemm_phase(PG8_LAS unsigned char* lds, const Gemm g, const Sched& S, const Epi& E) {
    int tid_l = threadIdx.x; asm volatile("" : "+v"(tid_l));
    const int tid = tid_l, wid = __builtin_amdgcn_readfirstlane(tid >> 6), lane = tid & 63, wr = wid >> 2, wc = wid & 3, fr = lane & 15, fq = lane >> 4;
    const int K = g.K, nt = K / BK;
    const int LDA = g.lda ? g.lda : K;
    int f8sc = 0x7f7f7f7f; if constexpr (FP8) asm volatile("" : "+v"(f8sc)); (void)f8sc;
    unsigned voffA[2], voffB[2];
#pragma unroll
    for (int i = 0; i < 2; ++i) { int R, C; stage_rc(tid * 16 + i * 8192, R, C); const int Rb = Epi::PERM ? ((R & ~31) + perm32(R & 31)) : R;
        voffA[i] = (unsigned)(R * LDA + C) * 2u; voffB[i] = (unsigned)(Rb * K + C) * 2u; }
    const size_t kstep = (size_t)(BK * 2);
    const size_t hstepA = (size_t)HALF * LDA * 2, tstepA = 2 * hstepA;
    const size_t hstep = (size_t)HALF * K * 2;
    const size_t tstep = 2 * hstep;
    const unsigned ldsw = (unsigned)wid * 1024u;
    const int aoff = lds_byte(wr * 64 + fr, fq * 8), boff = lds_byte(wc * 32 + fr, fq * 8);
#define PG8_SA(b, h) (((b) * 2 + (h)) * HTB)
#define PG8_SB(b, h) ((4 + (b) * 2 + (h)) * HTB)
#define PG8_STAGE(bufoff, gbase, voff) do { _Pragma("unroll") for (int _i = 0; _i < 2; ++_i) \
        __builtin_amdgcn_global_load_lds((const unsigned*)((const char*)(gbase) + (voff)[_i]), (PG8_LAS unsigned*)(lds + (bufoff) + ldsw + _i * 8192), 16, 0, 0); } while (0)
#define PG8_LDA(dst, b, h) do { _Pragma("unroll") for (int m = 0; m < 4; ++m) _Pragma("unroll") for (int k = 0; k < 2; ++k) dst[m][k] = *(const PG8_LAS bf16x8*)(lds + PG8_SA(b, h) + aoff + m * 2048 + k * 1024); } while (0)
#define PG8_LDB(dst, b, h) do { _Pragma("unroll") for (int n = 0; n < 2; ++n) _Pragma("unroll") for (int k = 0; k < 2; ++k) dst[n][k] = *(const PG8_LAS bf16x8*)(lds + PG8_SB(b, h) + boff + n * 2048 + k * 1024); } while (0)
#define PG8_MMA(ai, bj, At, Bt) do { __builtin_amdgcn_s_setprio(1); \
        if constexpr (FP8) { _Pragma("unroll") for (int m = 0; m < 4; ++m) _Pragma("unroll") for (int n = 0; n < 2; ++n) \
            acc[ai][bj][m][n] = pg8_mfma128(Bt[n][0], Bt[n][1], At[m][0], At[m][1], acc[ai][bj][m][n], f8sc); } \
        else { _Pragma("unroll") for (int m = 0; m < 4; ++m) _Pragma("unroll") for (int n = 0; n < 2; ++n) _Pragma("unroll") for (int k = 0; k < 2; ++k) \
            acc[ai][bj][m][n] = __builtin_amdgcn_mfma_f32_16x16x32_bf16(Bt[n][k], At[m][k], acc[ai][bj][m][n], 0, 0, 0); } \
        __builtin_amdgcn_s_setprio(0); } while (0)
#define PG8_WAIT_V(n) asm volatile("s_waitcnt vmcnt(" #n ")" ::: "memory")
#define PG8_WAIT_L(n) asm volatile("s_waitcnt lgkmcnt(" #n ")" ::: "memory")
#define PG8_BAR __builtin_amdgcn_s_barrier()
#define PG8_SCHED __builtin_amdgcn_sched_barrier(0)
    Unit cur, nxt; int ui = 0;
    if (!S.next(0, cur)) return;
    f32x4 acc[2][2][4][2];
#pragma unroll
    for (int a = 0; a < 2; ++a)
#pragma unroll
        for (int b = 0; b < 2; ++b)
#pragma unroll
            for (int m = 0; m < 4; ++m)
#pragma unroll
                for (int n = 0; n < 2; ++n) acc[a][b][m][n] = (f32x4){0.f, 0.f, 0.f, 0.f};
    bf16x8 At[4][2], B0[2][2], B1[2][2];
    const char* cA = (const char*)g.A + (size_t)cur.pm * tstepA; const char* cB = (const char*)g.Bt + (size_t)cur.pn * tstep;
    S.a_ready(cur);
    if constexpr (SP2) {
        PG8_STAGE(PG8_SB(0, 0), cB, voffB); PG8_STAGE(PG8_SB(0, 1), cB + hstep, voffB); PG8_STAGE(PG8_SA(0, 0), cA, voffA); PG8_STAGE(PG8_SA(0, 1), cA + hstepA, voffA);
        if (wr == 1) PG8_BAR;
        PG8_WAIT_V(2); PG8_BAR;
        PG8_STAGE(PG8_SB(1, 0), cB + kstep, voffB); PG8_STAGE(PG8_SA(1, 0), cA + kstep, voffA); PG8_STAGE(PG8_SB(1, 1), cB + hstep + kstep, voffB);
        PG8_WAIT_V(6); PG8_BAR;
    } else {
        PG8_STAGE(PG8_SB(0, 0), cB, voffB); PG8_STAGE(PG8_SA(0, 0), cA, voffA); PG8_STAGE(PG8_SB(0, 1), cB + hstep, voffB); PG8_STAGE(PG8_SA(0, 1), cA + hstepA, voffA);
        if (wr == 1) PG8_BAR;
        PG8_WAIT_V(4); PG8_BAR;
        PG8_STAGE(PG8_SB(1, 0), cB + kstep, voffB); PG8_STAGE(PG8_SA(1, 0), cA + kstep, voffA); PG8_STAGE(PG8_SB(1, 1), cB + hstep + kstep, voffB);
        PG8_WAIT_V(6); PG8_BAR;
    }
    for (;;) {
        const bool has_next = S.next(ui + 1, nxt);
        const char* nA = has_next ? (const char*)g.A + (size_t)nxt.pm * tstepA : cA; const char* nB = has_next ? (const char*)g.Bt + (size_t)nxt.pn * tstep : cB;
        for (int t = 0; t < nt; t += 2) {
            const bool last = (t == nt - 2);
            const char* a1 = cA + (size_t)(t + 1) * kstep;
            const char* a2 = last ? nA : cA + (size_t)(t + 2) * kstep; const char* b2 = last ? nB : cB + (size_t)(t + 2) * kstep;
            const char* a3 = a2 + kstep; const char* b3 = b2 + kstep;
            if (last && has_next) S.a_ready(nxt);
            if constexpr (SP2) {
            PG8_LDB(B0, 0, 0); PG8_LDB(B1, 0, 1); PG8_SCHED; PG8_LDA(At, 0, 0); PG8_STAGE(PG8_SA(1, 1), a1 + hstepA, voffA);
            PG8_WAIT_V(8); PG8_WAIT_L(0); PG8_BAR; PG8_MMA(0, 0, At, B0); PG8_MMA(0, 1, At, B1); PG8_BAR; PG8_SCHED;
            PG8_LDA(At, 0, 1); PG8_STAGE(PG8_SB(0, 0), b2, voffB); PG8_STAGE(PG8_SB(0, 1), b2 + hstep, voffB); PG8_STAGE(PG8_SA(0, 0), a2, voffA);
            PG8_WAIT_V(8); PG8_WAIT_L(0); PG8_BAR; PG8_MMA(1, 0, At, B0); PG8_MMA(1, 1, At, B1); PG8_BAR; PG8_SCHED;
            PG8_LDB(B0, 1, 0); PG8_LDB(B1, 1, 1); PG8_SCHED; PG8_LDA(At, 1, 0); PG8_STAGE(PG8_SA(0, 1), a2 + hstepA, voffA);
            PG8_WAIT_V(8); PG8_WAIT_L(0); PG8_BAR; PG8_MMA(0, 0, At, B0); PG8_MMA(0, 1, At, B1); PG8_BAR; PG8_SCHED;
            PG8_LDA(At, 1, 1); PG8_STAGE(PG8_SB(1, 0), b3, voffB); PG8_STAGE(PG8_SB(1, 1), b3 + hstep, voffB); PG8_STAGE(PG8_SA(1, 0), a3, voffA);
            PG8_WAIT_V(8); PG8_WAIT_L(0); PG8_BAR; PG8_MMA(1, 0, At, B0); PG8_MMA(1, 1, At, B1); PG8_BAR; PG8_SCHED;
            } else {
            PG8_LDB(B0, 0, 0); PG8_SCHED; PG8_LDA(At, 0, 0); PG8_STAGE(PG8_SA(1, 1), a1 + hstepA, voffA);
            PG8_WAIT_L(8); PG8_BAR; PG8_WAIT_L(0); PG8_MMA(0, 0, At, B0); PG8_BAR; PG8_SCHED;
            PG8_LDB(B1, 0, 1); PG8_STAGE(PG8_SB(0, 0), b2, voffB);
            PG8_BAR; PG8_WAIT_L(0); PG8_MMA(0, 1, At, B1); PG8_BAR;
            PG8_LDA(At, 0, 1); PG8_STAGE(PG8_SA(0, 0), a2, voffA);
            PG8_BAR; PG8_WAIT_L(0); PG8_MMA(1, 0, At, B0); PG8_BAR; PG8_SCHED;
            PG8_STAGE(PG8_SB(0, 1), b2 + hstep, voffB);
            PG8_WAIT_V(6); PG8_BAR; PG8_MMA(1, 1, At, B1); PG8_BAR;
            PG8_LDB(B0, 1, 0); PG8_SCHED; PG8_LDA(At, 1, 0); PG8_STAGE(PG8_SA(0, 1), a2 + hstepA, voffA);
            PG8_WAIT_L(8); PG8_BAR; PG8_WAIT_L(0); PG8_MMA(0, 0, At, B0); PG8_BAR; PG8_SCHED;
            PG8_LDB(B1, 1, 1); PG8_STAGE(PG8_SB(1, 0), b3, voffB);
            PG8_BAR; PG8_WAIT_L(0); PG8_MMA(0, 1, At, B1); PG8_BAR;
            PG8_LDA(At, 1, 1); PG8_STAGE(PG8_SA(1, 0), a3, voffA);
            PG8_BAR; PG8_WAIT_L(0); PG8_MMA(1, 0, At, B0); PG8_BAR; PG8_SCHED;
            PG8_STAGE(PG8_SB(1, 1), b3 + hstep, voffB);
            PG8_WAIT_V(6); PG8_BAR; PG8_MMA(1, 1, At, B1); PG8_BAR;
            }
        }
        if constexpr (ALIGN_EPI) { if (wr == 0) PG8_BAR; }
        if constexpr (FP8) asm volatile("s_nop 7\n\ts_nop 7" ::: "memory");
        if constexpr (!Epi::AFTER_DRAIN) { E(acc, cur, wr, wc, fr, fq); S.done(cur); }
        if (!has_next) break;
#pragma unroll
        for (int a = 0; a < 2; ++a)
#pragma unroll
            for (int b = 0; b < 2; ++b)
#pragma unroll
                for (int m = 0; m < 4; ++m)
#pragma unroll
                    for (int n = 0; n < 2; ++n) acc[a][b][m][n] = (f32x4){0.f, 0.f, 0.f, 0.f};
        cur = nxt; cA = nA; cB = nB; ++ui;
        if constexpr (ALIGN_EPI) { if (wr == 1) PG8_BAR; }
    }
    PG8_WAIT_V(0);
    if constexpr (!ALIGN_EPI) { if (wr == 0) PG8_BAR; }
    PG8_BAR;
    if constexpr (Epi::AFTER_DRAIN) { E.fused(acc, cur, wr, wc, fr, fq, lds, wid, lane); S.done(cur); }
#undef PG8_SA
#undef PG8_SB
#undef PG8_STAGE
#undef PG8_LDA
#undef PG8_LDB
#undef PG8_MMA
#undef PG8_WAIT_V
#undef PG8_WAIT_L
#undef PG8_BAR
#undef PG8_SCHED
}
}

namespace att {
#define ATT_LAS __attribute__((address_space(3)))
typedef unsigned short bf16_t;
typedef unsigned u32x4 __attribute__((ext_vector_type(4)));
typedef unsigned u32x2 __attribute__((ext_vector_type(2)));
constexpr int K_SLOT = 64 * 192, V_SLOT = 128 * 64;
constexpr int NKS = 3, NVS = 4;
constexpr int OFF_K = 0, OFF_V = NKS * K_SLOT, OFF_SCR = OFF_V + NVS * V_SLOT, ATT_LDS_BYTES = OFF_SCR + 8 * 64 * 4;
constexpr float BND = 360.f, SH0 = 4.0f, SHS = 6.0f;
constexpr int LDQ = 3072, LDK = 192, LDVT = 8192, LDO = 2048, SEQ = 8192;
constexpr float OSCALE = 32.f;
#define ATT_SBAR() __builtin_amdgcn_sched_barrier(0)
typedef float f32x4a __attribute__((ext_vector_type(4)));
__device__ __forceinline__ unsigned cvtpk(float lo, float hi) { unsigned r; asm volatile("v_cvt_pk_bf16_f32 %0, %1, %2" : "=v"(r) : "v"(lo), "v"(hi)); return r; }
__device__ __forceinline__ unsigned pk4f8(float a, float b, float c, float d) { int w = __builtin_amdgcn_cvt_pk_fp8_f32(a, b, 0, false); w = __builtin_amdgcn_cvt_pk_fp8_f32(c, d, w, true); return (unsigned)w; }
__device__ __forceinline__ f32x4a mfma8(unsigned a0, unsigned a1, unsigned b0, unsigned b1, f32x4a c) {
  return __builtin_amdgcn_mfma_f32_16x16x32_fp8_fp8(__builtin_bit_cast(long, (u32x2){a0, a1}), __builtin_bit_cast(long, (u32x2){b0, b1}), c, 0, 0, 0); }
__device__ __forceinline__ float max3f(float a, float b, float c) { float r; asm("v_max3_f32 %0, %1, %2, %3" : "=v"(r) : "v"(a), "v"(b), "v"(c)); return r; }
__device__ __forceinline__ float max2f(float a, float b) { float r; asm("v_max_f32_e32 %0, %1, %2" : "=v"(r) : "v"(a), "v"(b)); return r; }
__device__ __forceinline__ float xmax16(float v) { auto r = __builtin_amdgcn_permlane16_swap(__float_as_uint(v), __float_as_uint(v), false, false); return max2f(__uint_as_float(r[0]), __uint_as_float(r[1])); }
__device__ __forceinline__ float xmax32(float v) { auto r = __builtin_amdgcn_permlane32_swap(__float_as_uint(v), __float_as_uint(v), false, false); return max2f(__uint_as_float(r[0]), __uint_as_float(r[1])); }
__device__ __forceinline__ float xsum16(float v) { auto r = __builtin_amdgcn_permlane16_swap(__float_as_uint(v), __float_as_uint(v), false, false); return __uint_as_float(r[0]) + __uint_as_float(r[1]); }
__device__ __forceinline__ float xsum32(float v) { auto r = __builtin_amdgcn_permlane32_swap(__float_as_uint(v), __float_as_uint(v), false, false); return __uint_as_float(r[0]) + __uint_as_float(r[1]); }
__device__ __forceinline__ void glds16(const void* gsrc, unsigned lds_dst) { unsigned keep;
  asm volatile("s_mov_b32 %0, m0\n\ts_mov_b32 m0, %2\n\ts_nop 0\n\tglobal_load_lds_dwordx4 %1, off\n\ts_mov_b32 m0, %0" : "=&s"(keep) : "v"(gsrc), "s"(lds_dst) : "memory"); }
#define ATT_WAIT_BAR(N) asm volatile("s_waitcnt vmcnt(" #N ") lgkmcnt(0)\n\ts_barrier" ::: "memory")

__device__ __forceinline__ void attn_unit(const unsigned char* __restrict__ Qb, const unsigned char* __restrict__ Kh, const unsigned char* __restrict__ Vth, unsigned char* __restrict__ Ob, ATT_LAS unsigned char* lds) {
  int tid_l = threadIdx.x; asm volatile("" : "+v"(tid_l));
  const int tid = tid_l, wid = __builtin_amdgcn_readfirstlane(tid >> 6), lane = tid & 63, n16 = lane & 15, g = lane >> 4;
  ATT_LAS float* scr = (ATT_LAS float*)(lds + OFF_SCR) + wid * 64; ATT_LAS float* li_l = scr; ATT_LAS float* al_l = scr + 32;
  const unsigned ldsb = (unsigned)(uintptr_t)lds;
  float l_reg[2] = {0.f, 0.f}; f32x4a negm[2] = {(f32x4a){0.f, 0.f, 0.f, 0.f}, (f32x4a){0.f, 0.f, 0.f, 0.f}};
  f32x4a o[2][8];
#pragma unroll
  for (int qt = 0; qt < 2; ++qt)
#pragma unroll
    for (int c = 0; c < 8; ++c) o[qt][c] = (f32x4a){0.f, 0.f, 0.f, 0.f};
  u32x4 qr[2][3];
#pragma unroll
  for (int qt = 0; qt < 2; ++qt) { const unsigned char* Qw = Qb + (size_t)(wid * 32 + 16 * qt + n16) * LDQ + 16 * g;
#pragma unroll
    for (int sp = 0; sp < 3; ++sp) qr[qt][sp] = *(const u32x4*)(Qw + 64 * sp); }
  const int kb = 1024 * (n16 >> 2) + 64 * (n16 & 3) + 16 * (g ^ (n16 >> 2));
  const int vb = 64 * n16 + 16 * (g ^ (n16 >> 2));
  int kgo[2], vgo;
#pragma unroll
  for (int i = 0; i < 2; ++i) { const int p = wid + 8 * i, sp = p >> 2, r = 16 * (p & 3) + (lane >> 2), c = (lane & 3) ^ (p & 3); kgo[i] = r * LDK + 64 * sp + 16 * c; }
  { const int r = 16 * wid + (lane >> 2), c = (lane & 3) ^ ((lane >> 4) & 3); vgo = r * LDVT + 16 * c; }
#define ATT_ISSUE_K(kt, slot, two) do { const unsigned char* kp_ = Kh + (size_t)(kt) * (64 * LDK); const unsigned d_ = ldsb + OFF_K + (unsigned)(slot) * K_SLOT + (unsigned)wid * 1024u; \
    glds16(kp_ + kgo[0], d_); if (two) glds16(kp_ + kgo[1], d_ + 8192u); } while (0)
#define ATT_ISSUE_V(vt, slot) do { const unsigned char* vp_ = Vth + (size_t)(vt) * 64; const unsigned d_ = ldsb + OFF_V + (unsigned)(slot) * V_SLOT + (unsigned)wid * 1024u; \
    glds16(vp_ + vgo, d_); } while (0)
#define ATT_TOP_A(s, ks2) do { if ((s) < NT - 1) ATT_WAIT_BAR(3); else ATT_WAIT_BAR(0); \
    if ((s) + 2 < NT) { ATT_ISSUE_K((s) + 2, ks2, true); ATT_ISSUE_V((s) + 2, ((s) + 2) & 3); } } while (0)
#define ATT_TOP_B(s, ks2) do { if ((s) < NT - 1) ATT_WAIT_BAR(2); else ATT_WAIT_BAR(0); \
    if ((s) + 2 < NT) { ATT_ISSUE_K((s) + 2, ks2, false); ATT_ISSUE_V((s) + 2, ((s) + 2) & 3); } } while (0)
#define ATT_KLD(kslot, sp, kt) (*(const ATT_LAS u32x4*)((kslot) + kb + 4096 * (sp) + 512 * ((kt) >> 1) + 256 * ((kt) & 1)))
#define ATT_QKT(kslot_) do { const ATT_LAS unsigned char* ksl_ = (kslot_); u32x4 kf[2][4]; \
    _Pragma("unroll") for (int kt = 0; kt < 4; ++kt) { S[kt][0] = negm[0]; S[kt][1] = negm[1]; kf[0][kt] = ATT_KLD(ksl_, 0, kt); } \
    ATT_SBAR(); \
    _Pragma("unroll") for (int sp = 0; sp < 3; ++sp) { \
      if (sp + 1 < 3) { _Pragma("unroll") for (int kt = 0; kt < 4; ++kt) kf[(sp + 1) & 1][kt] = ATT_KLD(ksl_, sp + 1, kt); } \
      ATT_SBAR(); \
      _Pragma("unroll") for (int kt = 0; kt < 4; ++kt) { \
        S[kt][0] = mfma8(kf[sp & 1][kt].x, kf[sp & 1][kt].y, qr[0][sp].x, qr[0][sp].y, S[kt][0]); \
        S[kt][1] = mfma8(kf[sp & 1][kt].x, kf[sp & 1][kt].y, qr[1][sp].x, qr[1][sp].y, S[kt][1]); } \
      _Pragma("unroll") for (int kt = 0; kt < 4; ++kt) { \
        S[kt][0] = mfma8(kf[sp & 1][kt].z, kf[sp & 1][kt].w, qr[0][sp].z, qr[0][sp].w, S[kt][0]); \
        S[kt][1] = mfma8(kf[sp & 1][kt].z, kf[sp & 1][kt].w, qr[1][sp].z, qr[1][sp].w, S[kt][1]); } \
      ATT_SBAR(); } } while (0)
#define ATT_VLD(vslot_, c) (*(const ATT_LAS u32x4*)((vslot_) + vb + 1024 * (c)))
#define ATT_SOFTMAX_PV(vslot_, first_) do { const ATT_LAS unsigned char* vsl_ = (vslot_); float al_[2] = {1.f, 1.f}; u32x2 pa[2][2]; float ps_[2]; \
    u32x4 vf[8];     \
    _Pragma("unroll") for (int c = 0; c < 8; ++c) vf[c] = ATT_VLD(vsl_, c); \
    ATT_SBAR(); \
    _Pragma("unroll") for (int qt = 0; qt < 2; ++qt) { float ps = 0.f; \
      _Pragma("unroll") for (int kt = 0; kt < 4; ++kt) _Pragma("unroll") for (int i = 0; i < 4; ++i) { const float e = __builtin_amdgcn_exp2f(S[kt][qt][i]); S[kt][qt][i] = e; ps += e; } \
      ps_[qt] = xsum32(xsum16(ps)); } \
      \
    const bool keepw_ = !(first_) && __all(ps_[0] <= BND && ps_[1] <= BND); \
    if (!keepw_) {     \
      _Pragma("unroll") for (int qt = 0; qt < 2; ++qt) { float pm = max3f(S[0][qt][0], S[0][qt][1], S[0][qt][2]); pm = max3f(pm, S[0][qt][3], S[1][qt][0]); \
        pm = max3f(pm, S[1][qt][1], S[1][qt][2]); pm = max3f(pm, S[1][qt][3], S[2][qt][0]); pm = max3f(pm, S[2][qt][1], S[2][qt][2]); pm = max3f(pm, S[2][qt][3], S[3][qt][0]); \
        pm = max3f(pm, S[3][qt][1], S[3][qt][2]); pm = max2f(pm, S[3][qt][3]); pm = xmax32(xmax16(pm)); \
        float d = max2f(__builtin_amdgcn_logf(pm) - SH0, __builtin_amdgcn_logf(ps_[qt]) - SHS); if (!(first_)) d = max2f(d, 0.f); \
        al_[qt] = __builtin_amdgcn_exp2f(-d); negm[qt] -= d; ps_[qt] *= al_[qt]; \
        _Pragma("unroll") for (int kt = 0; kt < 4; ++kt) S[kt][qt] *= al_[qt]; } \
      if (g == 0) { al_l[n16] = al_[0]; al_l[16 + n16] = al_[1]; } asm volatile("s_waitcnt lgkmcnt(0)" ::: "memory"); \
      _Pragma("unroll") for (int qt = 0; qt < 2; ++qt) { const f32x4a av = *(const ATT_LAS f32x4a*)(al_l + 16 * qt + 4 * g); \
        _Pragma("unroll") for (int c = 0; c < 8; ++c) o[qt][c] *= av; } } \
    _Pragma("unroll") for (int qt = 0; qt < 2; ++qt) { l_reg[qt] = l_reg[qt] * al_[qt] + ps_[qt]; \
      _Pragma("unroll") for (int t = 0; t < 2; ++t) { pa[qt][t].x = pk4f8(S[2 * t][qt][0], S[2 * t][qt][1], S[2 * t][qt][2], S[2 * t][qt][3]); \
        pa[qt][t].y = pk4f8(S[2 * t + 1][qt][0], S[2 * t + 1][qt][1], S[2 * t + 1][qt][2], S[2 * t + 1][qt][3]); } } \
    ATT_SBAR(); \
    _Pragma("unroll") for (int gq = 0; gq < 2; ++gq) { \
      _Pragma("unroll") for (int c = 0; c < 4; ++c) { \
        o[0][4 * gq + c] = mfma8(pa[0][0].x, pa[0][0].y, vf[4 * gq + c].x, vf[4 * gq + c].y, o[0][4 * gq + c]); \
        o[1][4 * gq + c] = mfma8(pa[1][0].x, pa[1][0].y, vf[4 * gq + c].x, vf[4 * gq + c].y, o[1][4 * gq + c]); } \
      _Pragma("unroll") for (int c = 0; c < 4; ++c) { \
        o[0][4 * gq + c] = mfma8(pa[0][1].x, pa[0][1].y, vf[4 * gq + c].z, vf[4 * gq + c].w, o[0][4 * gq + c]); \
        o[1][4 * gq + c] = mfma8(pa[1][1].x, pa[1][1].y, vf[4 * gq + c].z, vf[4 * gq + c].w, o[1][4 * gq + c]); } } \
    ATT_SBAR(); } while (0)
  constexpr int NT = SEQ / 64;
  f32x4a S[4][2];
  if (wid < 4) { ATT_ISSUE_K(0, 0, true); ATT_ISSUE_V(0, 0); ATT_ISSUE_K(1, 1, true); ATT_ISSUE_V(1, 1); }
  else { ATT_ISSUE_K(0, 0, false); ATT_ISSUE_V(0, 0); ATT_ISSUE_K(1, 1, false); ATT_ISSUE_V(1, 1); }
  asm volatile("" : "+v"(qr[0][0]), "+v"(qr[0][1]), "+v"(qr[0][2]), "+v"(qr[1][0]), "+v"(qr[1][1]), "+v"(qr[1][2]));
  if (wid < 4) {
    int ks = 0;
    for (int s = 0; s < NT; ++s) {
      const int ks2 = ks == 0 ? 2 : ks - 1;
      ATT_TOP_A(s, ks2);
      ATT_QKT(lds + OFF_K + ks * K_SLOT);
      ATT_SOFTMAX_PV(lds + OFF_V + (s & 3) * V_SLOT, s == 0);
      ks = ks == 2 ? 0 : ks + 1;
    }
    ATT_WAIT_BAR(0);
  } else {
    __builtin_amdgcn_s_setprio(1);
    ATT_TOP_B(0, 2);
    ATT_QKT(lds + OFF_K);
    int ks = 1;
    for (int s = 1; s < NT; ++s) {
      const int ks2 = ks == 0 ? 2 : ks - 1;
      ATT_TOP_B(s, ks2);
      ATT_SOFTMAX_PV(lds + OFF_V + ((s - 1) & 3) * V_SLOT, s == 1);
      ATT_QKT(lds + OFF_K + ks * K_SLOT);
      ks = ks == 2 ? 0 : ks + 1;
    }
    ATT_WAIT_BAR(0);
    ATT_SOFTMAX_PV(lds + OFF_V + ((NT - 1) & 3) * V_SLOT, false);
    __builtin_amdgcn_s_setprio(0);
  }
  if (g == 0) { li_l[n16] = l_reg[0]; li_l[16 + n16] = l_reg[1]; }
  asm volatile("s_waitcnt lgkmcnt(0)" ::: "memory");
#pragma unroll
  for (int qt = 0; qt < 2; ++qt) { const f32x4a lv = *(const ATT_LAS f32x4a*)(li_l + 16 * qt + 4 * g);
    unsigned char* Ow = Ob + (size_t)(wid * 32 + 16 * qt + 4 * g) * LDO + n16;
#pragma unroll
    for (int i = 0; i < 4; ++i) { const float rl = __builtin_amdgcn_rcpf(lv[i]) * OSCALE;
#pragma unroll
      for (int c = 0; c < 8; ++c) { const float v = o[qt][c][i] * rl; Ow[(size_t)i * LDO + 16 * c] = (unsigned char)(__builtin_amdgcn_cvt_pk_fp8_f32(v, v, 0, false) & 0xff); } } }
  ATT_WAIT_BAR(0);
#undef ATT_ISSUE_K
#undef ATT_ISSUE_V
#undef ATT_TOP_A
#undef ATT_TOP_B
#undef ATT_KLD
#undef ATT_QKT
#undef ATT_VLD
#undef ATT_SOFTMAX_PV
}
}

constexpr int NWAVES = 8;
constexpr int M = 24576, DM = 4096, SEQ = 8192, NSEQ = 3, MP = 16384;
constexpr int DFF = 11008, NUP = 22016, NIN = 12032;
constexpr float RMS_EPS = 1e-6f;
constexpr size_t MiB = 1u << 20;
constexpr size_t WS_CTL = 0, CTL_ZERO_BYTES = 1 * MiB;
constexpr size_t WS_DYNCTR = 64 * 1024;
constexpr size_t WS_ROWSS = 128 * 1024;
constexpr size_t WS_ROPE = 1 * MiB;
constexpr size_t WS_BPOOL = 4 * MiB, WS_BUQ = 6 * MiB, WS_BUKV = 12 * MiB, WS_BBP = 16 * MiB, WS_BBM = 32 * MiB, WS_BO = 1316 * MiB, WS_BIN = 80 * MiB;
constexpr size_t WS_BINB = 128 * MiB, WS_H8 = 932 * MiB;
constexpr size_t WS_WP = 48 * MiB;
constexpr size_t WS_Q8 = 80 * MiB, WS_K8 = 932 * MiB, WS_VT8 = 308 * MiB;
constexpr size_t WS_A = 176 * MiB;
constexpr size_t WS_B = 368 * MiB;
constexpr size_t WS_ZK = 536 * MiB;
constexpr size_t WS_ZG = 548 * MiB;
constexpr size_t WS_AO = 932 * MiB;
constexpr size_t WS_F = 1028 * MiB;
constexpr size_t WS_BOUT = 1220 * MiB;
constexpr size_t WS_END1 = 1316 * MiB;
constexpr size_t WS_BUP = 4 * MiB, WS_BDOWN = 176 * MiB, WS_H2 = 262 * MiB, WS_ACT = 454 * MiB, WS_SIDE = 970 * MiB, WS_END2 = 1036 * MiB;
constexpr size_t WS_NEED = 1348 * MiB;
constexpr int CW_TMO = 0, CW_CODE = 1, CW_BAR = 4096;
constexpr int RING_OFF = 0, RING_BYTES = 131072;
constexpr int CONVSCR_OFF = RING_BYTES;
constexpr int LDSCTL_OFF = CONVSCR_OFF + 16896, MISC_OFF = LDSCTL_OFF;
constexpr int LDS_BYTES = LDSCTL_OFF + 512;

#define GAS __attribute__((address_space(1)))
#define LAS __attribute__((address_space(3)))
typedef unsigned short bf16;
typedef unsigned v4u __attribute__((ext_vector_type(4)));
typedef unsigned v2u __attribute__((ext_vector_type(2)));
typedef float f32x4 __attribute__((ext_vector_type(4)));
typedef GAS unsigned gu32;
#define RLX_AGENT __ATOMIC_RELAXED, __HIP_MEMORY_SCOPE_AGENT
#define LDS_WAIT() asm volatile("s_waitcnt lgkmcnt(0)" ::: "memory")
#define VM_WAIT() asm volatile("s_waitcnt vmcnt(0)" ::: "memory")
__device__ __forceinline__ unsigned f2bf(float f) { unsigned u = __builtin_bit_cast(unsigned, f); return (u + 0x7fffu + ((u >> 16) & 1u)) >> 16; }
__device__ __forceinline__ unsigned pk2(float lo, float hi) { return f2bf(lo) | (f2bf(hi) << 16); }
__device__ __forceinline__ float bflo(unsigned w) { return __uint_as_float(w << 16); }
__device__ __forceinline__ float bfhi(unsigned w) { return __uint_as_float(w & 0xffff0000u); }
__device__ __forceinline__ void unpack8(const v4u w, float (&v)[8]) { v[0] = bflo(w.x); v[1] = bfhi(w.x); v[2] = bflo(w.y); v[3] = bfhi(w.y); v[4] = bflo(w.z); v[5] = bfhi(w.z); v[6] = bflo(w.w); v[7] = bfhi(w.w); }
__device__ __forceinline__ v4u pack8(const float (&v)[8]) { v4u w; w.x = pk2(v[0], v[1]); w.y = pk2(v[2], v[3]); w.z = pk2(v[4], v[5]); w.w = pk2(v[6], v[7]); return w; }
#define XB_TMO      128
#define XB_XCNT(j)  (256  + 64 * (j))
#define XB_XSUB(j)  (1280 + 64 * (j))
#define XB_XGEN(j)  (2304 + 64 * (j))
#define XB_TOP      3328
#define XB_TOPGEN   3392
#define XCD_BAR_WORDS 3456
#define XB_SPIN_CAP (1u << 18)

__device__ __forceinline__ unsigned xb_ld(unsigned* p)              { return __hip_atomic_load(p, __ATOMIC_RELAXED, __HIP_MEMORY_SCOPE_AGENT); }
__device__ __forceinline__ unsigned xb_add(unsigned* p, unsigned v) { return __hip_atomic_fetch_add(p, v, __ATOMIC_RELAXED, __HIP_MEMORY_SCOPE_AGENT); }
__device__ __forceinline__ unsigned xb_xcc_id() { return (unsigned)__builtin_amdgcn_s_getreg((3 << 11) | 20) & 0xFu; }
#define XB_SPIN(cond, bar) do { unsigned _sp = 0; while (cond) { __builtin_amdgcn_s_sleep(1); \
    if ((++_sp & 255u) == 0u) { if (xb_ld(&(bar)[XB_TMO])) break; if (_sp > XB_SPIN_CAP) { atomicAdd(&(bar)[XB_TMO], 1u); break; } } } } while (0)

struct XcdBarrier {
    unsigned* bar; unsigned x;
    volatile LAS unsigned* st;
};

__device__ __forceinline__ XcdBarrier xcd_barrier_post(unsigned* bar, volatile LAS unsigned* st) {
    XcdBarrier b; b.bar = bar; b.x = xb_xcc_id(); b.st = st;
    if (threadIdx.x == 0) (void)xb_add(&bar[XB_XCNT(b.x)], 1u);
    return b;
}
__device__ __forceinline__ void xcd_barrier_complete(unsigned* bar, unsigned x, unsigned& nloc, unsigned& nx) {
    const unsigned G = gridDim.x * gridDim.y * gridDim.z;
    unsigned sum, cnt, mine, sp = 0u;
    for (;;) {
        sum = 0u; cnt = 0u; mine = 0u;
#pragma unroll
        for (unsigned j = 0; j < 16; ++j) { const unsigned c = xb_ld(&bar[XB_XCNT(j)]); sum += c; cnt += (c > 0u) ? 1u : 0u; mine = (j == x) ? c : mine; }
        if (sum == G) break;
        __builtin_amdgcn_s_sleep(1);
        if ((++sp & 255u) == 0u) { if (xb_ld(&bar[XB_TMO])) break; if (sp > XB_SPIN_CAP) { atomicAdd(&bar[XB_TMO], 1u); break; } }
    }
    nloc = mine > 0u ? mine : 1u; nx = cnt > 0u ? cnt : 1u;
}

__device__ __forceinline__ void xcd_barrier(const XcdBarrier& b) {
    asm volatile("s_waitcnt vmcnt(0)" ::: "memory");
    __syncthreads();
    if (threadIdx.x == 0) {
        unsigned* bar = b.bar;
        __builtin_amdgcn_s_waitcnt(0);
        unsigned nloc = b.st[0], nx = b.st[1];
        if (nloc == 0u) { xcd_barrier_complete(bar, b.x, nloc, nx); b.st[0] = nloc; b.st[1] = nx; }
        const unsigned old = xb_add(&bar[XB_XSUB(b.x)], 1u);
        const unsigned gen = old / nloc;
        if (old + 1u == (gen + 1u) * nloc) {
            __builtin_amdgcn_fence(__ATOMIC_RELEASE, "agent");
            asm volatile("s_waitcnt vmcnt(0)" ::: "memory");
            const unsigned og = xb_add(&bar[XB_TOP], 1u);
            const unsigned tg = og / nx;
            if (og + 1u == (tg + 1u) * nx) xb_add(&bar[XB_TOPGEN], 1u);
            else XB_SPIN(xb_ld(&bar[XB_TOPGEN]) == tg, bar);
            __builtin_amdgcn_fence(__ATOMIC_ACQUIRE, "agent");
            xb_add(&bar[XB_XGEN(b.x)], 1u);
            asm volatile("s_waitcnt vmcnt(0)" ::: "memory");
        } else {
            XB_SPIN(xb_ld(&bar[XB_XGEN(b.x)]) == gen, bar);
            __builtin_amdgcn_fence(__ATOMIC_ACQUIRE, "agent");
            asm volatile("s_waitcnt vmcnt(0)" ::: "memory");
        }
    }
    __syncthreads();
}

__device__ __forceinline__ float wave_sum(float v) {
#pragma unroll
    for (int o = 1; o < 64; o <<= 1) v += __shfl_xor(v, o);
    return v;
}
__device__ __forceinline__ void tr_item(const float* W, int N, bf16* WT, int ldt, int k0, int n0, int drow0, LAS float* scr, int lane, const float* kscale = nullptr) {
#pragma unroll 8
    for (int i = 0; i < 32; ++i) { const int kk = 2 * i + (lane >> 5); scr[kk * 33 + (lane & 31)] = W[(size_t)(k0 + kk) * N + n0 + (lane & 31)]; }
    LDS_WAIT(); asm volatile("" ::: "memory");
    const int c = lane & 7;
    f32x4 g0 = {1.f, 1.f, 1.f, 1.f}, g1 = g0;
    if (kscale) { g0 = *(const GAS f32x4*)(kscale + k0 + 8 * c); g1 = *(const GAS f32x4*)(kscale + k0 + 8 * c + 4); }
#pragma unroll
    for (int j = 0; j < 4; ++j) { const int n = (lane >> 3) + 8 * j; const LAS float* s = scr + (8 * c) * 33 + n;
        v4u o; o.x = pk2(s[0 * 33] * g0.x, s[1 * 33] * g0.y); o.y = pk2(s[2 * 33] * g0.z, s[3 * 33] * g0.w); o.z = pk2(s[4 * 33] * g1.x, s[5 * 33] * g1.y); o.w = pk2(s[6 * 33] * g1.z, s[7 * 33] * g1.w);
        *(GAS v4u*)(WT + (size_t)(drow0 + n) * ldt + k0 + 8 * c) = o; }
    LDS_WAIT(); asm volatile("" ::: "memory");
}
__device__ __forceinline__ void tr_item8(const float* W, int N, unsigned char* WT8, int ldt, int k0, int n0, int drow0, LAS float* scr, int lane, float sc) {
#pragma unroll 8
    for (int i = 0; i < 32; ++i) { const int kk = 2 * i + (lane >> 5); scr[kk * 33 + (lane & 31)] = W[(size_t)(k0 + kk) * N + n0 + (lane & 31)]; }
    LDS_WAIT(); asm volatile("" ::: "memory");
    const int c = lane & 7;
#pragma unroll
    for (int j = 0; j < 4; ++j) { const int n = (lane >> 3) + 8 * j; const LAS float* s = scr + (8 * c) * 33 + n;
        int a = __builtin_amdgcn_cvt_pk_fp8_f32(s[0 * 33] * sc, s[1 * 33] * sc, 0, false); a = __builtin_amdgcn_cvt_pk_fp8_f32(s[2 * 33] * sc, s[3 * 33] * sc, a, true);
        int b = __builtin_amdgcn_cvt_pk_fp8_f32(s[4 * 33] * sc, s[5 * 33] * sc, 0, false); b = __builtin_amdgcn_cvt_pk_fp8_f32(s[6 * 33] * sc, s[7 * 33] * sc, b, true);
        v2u o; o.x = (unsigned)a; o.y = (unsigned)b;
        *(GAS v2u*)(WT8 + (size_t)(drow0 + n) * ldt + k0 + 8 * c) = o; }
    LDS_WAIT(); asm volatile("" ::: "memory");
}
__device__ __forceinline__ void rms_row_4096(const float* xrow, const float* gain, bf16* orow, unsigned char* orow8, int lane) {
    const GAS f32x4* xr = (const GAS f32x4*)xrow + lane; const GAS f32x4* gr = (const GAS f32x4*)gain + lane;
    f32x4 v[16]; float s = 0.f;
#pragma unroll
    for (int j = 0; j < 16; ++j) { v[j] = xr[64 * j]; s += (v[j].x * v[j].x + v[j].y * v[j].y) + (v[j].z * v[j].z + v[j].w * v[j].w); }
    const float r = 1.0f / sqrtf(wave_sum(s) * (1.f / 4096.f) + RMS_EPS);
    GAS v2u* o8 = (GAS v2u*)orow + lane;
    GAS unsigned* o4 = (GAS unsigned*)orow8 + lane;
#pragma unroll
    for (int j = 0; j < 16; ++j) { const f32x4 g = gr[64 * j]; const float a = v[j].x * r * g.x, b = v[j].y * r * g.y, c = v[j].z * r * g.z, d = v[j].w * r * g.w;
        v2u w; w.x = pk2(a, b); w.y = pk2(c, d); o8[64 * j] = w;
        int q = __builtin_amdgcn_cvt_pk_fp8_f32(a, b, 0, false); q = __builtin_amdgcn_cvt_pk_fp8_f32(c, d, q, true); o4[64 * j] = (unsigned)q; }
}
__device__ __forceinline__ void sincos_d(double a, double& s, double& c) {
    const double TWO_PI = 6.283185307179586476925286766559;
    const double n = __builtin_rint(a / TWO_PI); const double x = a - n * TWO_PI;
    const double x2 = x * x; double ts = 1.0, tc = 1.0; double ss = 1.0, cs = 1.0;
#pragma unroll
    for (int k = 1; k <= 14; ++k) { tc *= -x2 / (double)((2 * k - 1) * (2 * k)); cs += tc; ts *= -x2 / (double)((2 * k) * (2 * k + 1)); ss += ts; }
    s = x * ss; c = cs;
}

__device__ __forceinline__ v2u pack8_f8(const float (&v)[8], float sc) {
    int a = __builtin_amdgcn_cvt_pk_fp8_f32(v[0] * sc, v[1] * sc, 0, false); a = __builtin_amdgcn_cvt_pk_fp8_f32(v[2] * sc, v[3] * sc, a, true);
    int b = __builtin_amdgcn_cvt_pk_fp8_f32(v[4] * sc, v[5] * sc, 0, false); b = __builtin_amdgcn_cvt_pk_fp8_f32(v[6] * sc, v[7] * sc, b, true);
    v2u w; w.x = (unsigned)a; w.y = (unsigned)b; return w;
}
__device__ __forceinline__ unsigned pk4_f8(float a, float b, float c, float d) { int w = __builtin_amdgcn_cvt_pk_fp8_f32(a, b, 0, false); w = __builtin_amdgcn_cvt_pk_fp8_f32(c, d, w, true); return (unsigned)w; }

#ifndef PHM
#define PHM 0x3ff
#endif
typedef const __attribute__((address_space(4))) unsigned char* kptr_t;
__device__ __forceinline__ kptr_t karg() { kptr_t p = (kptr_t)__builtin_amdgcn_kernarg_segment_ptr(); asm volatile("" : "+s"(p)); return p; }
#define KIN(i) (*(const float* const __attribute__((address_space(4)))*)(kp + 8 * (i)))
#define KOUT() (*(float* const __attribute__((address_space(4)))*)(kp + 8 * 20))
#define KWS() (*(unsigned char* const __attribute__((address_space(4)))*)(kp + 8 * 21))
struct Args { const float* in[20]; float* out; unsigned char* ws; };
__global__ void __launch_bounds__(NWAVES * 64, 2) fwd_kernel(Args args) {
    extern __shared__ __attribute__((aligned(16))) unsigned char lds_raw[];
    LAS unsigned char* lds = (LAS unsigned char*)lds_raw;
    volatile LAS unsigned* MISC = (volatile LAS unsigned*)(lds + MISC_OFF);
    const int tid = threadIdx.x;
    const int G = gridDim.x, bx = blockIdx.x;
    const int vcu = (G % 8 == 0) ? (bx % 8) * (G / 8) + bx / 8 : bx;
    gu32* ctl = (gu32*)(args.ws + WS_CTL);
    for (int u = tid; u < (LDS_BYTES - LDSCTL_OFF) / 4; u += NWAVES * 64) ((LAS unsigned*)(lds + LDSCTL_OFF))[u] = 0u;
    __syncthreads();
    XcdBarrier bar = xcd_barrier_post((unsigned*)(ctl + CW_BAR), MISC + 8);
#if defined(PROBE_BAR_BX)
#define GRID_BAR() do { const unsigned long long tb0_ = __builtin_amdgcn_s_memrealtime(); xcd_barrier(bar); if ((int)blockIdx.x == (PROBE_BAR_BX) && threadIdx.x == 0) MISC[31] = MISC[31] + (unsigned)(__builtin_amdgcn_s_memrealtime() - tb0_); } while (0)
#else
#define GRID_BAR() xcd_barrier(bar)
#endif
#if defined(PROBE_A)
#if defined(PROBE_CLK_A)
#define STAMP(k) do { if (bx == 0 && tid == 0) { MISC[16 + (k)] = (unsigned)__builtin_amdgcn_s_memrealtime(); if ((k) == PROBE_CLK_A) MISC[12] = (unsigned)__builtin_amdgcn_s_memtime(); if ((k) == PROBE_CLK_B) MISC[13] = (unsigned)__builtin_amdgcn_s_memtime(); } } while (0)
#else
#define STAMP(k) do { if (bx == 0 && tid == 0) MISC[16 + (k)] = (unsigned)__builtin_amdgcn_s_memrealtime(); } while (0)
#endif
#else
#define STAMP(k) do { } while (0)
#endif
    STAMP(0);
    const int NGW = G * NWAVES, NGT = G * NWAVES * 64;
#define PHASE_IDS() int tidp_ = threadIdx.x; asm volatile("" : "+v"(tidp_)); const int lane = tidp_ & 63, wavep_ = __builtin_amdgcn_readfirstlane(tidp_ >> 6); \
    const int gw = vcu * NWAVES + wavep_, gt = vcu * (NWAVES * 64) + tidp_; LAS float* scr = (LAS float*)(lds + RING_OFF + wavep_ * 16384); (void)gw; (void)gt; (void)scr; (void)lane

#if (PHM >> 0) & 1
    {
        PHASE_IDS();
        kptr_t kp = karg(); unsigned char* ws = KWS();
        const float* x_prompt = KIN(0); const float* x_sample = KIN(1); const float* norm_mix_gain = KIN(2); const float* w_in = KIN(3); const float* pool_w = KIN(4);
        const float* w_uq = KIN(7); const float* w_ukv = KIN(9); const float* w_bp = KIN(12); const float* w_bm = KIN(13); const float* w_o = KIN(14);
        float* ropec = (float*)(ws + WS_ROPE); float* ropes = ropec + SEQ * 32;
        bf16* Bpool = (bf16*)(ws + WS_BPOOL); bf16* Buq = (bf16*)(ws + WS_BUQ); bf16* Bukv = (bf16*)(ws + WS_BUKV); bf16* Bbp = (bf16*)(ws + WS_BBP);
        bf16* Bbm = (bf16*)(ws + WS_BBM); bf16* Bo = (bf16*)(ws + WS_BO); bf16* Bin = (bf16*)(ws + WS_BIN); unsigned char* BinB = ws + WS_BINB; bf16* Hb = (bf16*)(ws + WS_A); unsigned char* H8 = ws + WS_H8;
        constexpr int I_POOL = 0, I_UQ = 1536, I_UKV = 1024, I_BP = 4096, I_BM = 4096, I_O = 8192, I_IN = 23680;
        constexpr int NITEMS = I_POOL + I_UQ + I_UKV + I_BP + I_BM + I_O + I_IN;
        for (int it = gw; it < NITEMS; it += NGW) {
            int r = it;
            if (r < I_POOL) { const int g = r >> 7, q = r & 127; tr_item(pool_w + (size_t)g * 512 * 512, 512, Bpool, 512, 64 * (q >> 4), 32 * (q & 15), g * 512 + 32 * (q & 15), scr, lane); continue; } r -= I_POOL;
            if (r < I_UQ) { tr_item8(w_uq, 3072, (unsigned char*)Buq, 1024, 64 * (r / 96), 32 * (r % 96), 32 * (r % 96), scr, lane, 32.f); continue; } r -= I_UQ;
            if (r < I_UKV) { tr_item8(w_ukv, 4096, (unsigned char*)Bukv, 512, 64 * (r / 128), 32 * (r % 128), 32 * (r % 128), scr, lane, 16.f); continue; } r -= I_UKV;
            if (r < I_BP) { tr_item(w_bp, 4096, Bbp, 2048, 64 * (r / 128), 32 * (r % 128), 32 * (r % 128), scr, lane); continue; } r -= I_BP;
            if (r < I_BM) { tr_item8(w_bm, 4096, (unsigned char*)Bbm, 2048, 64 * (r / 128), 32 * (r % 128), 32 * (r % 128), scr, lane, 32.f); continue; } r -= I_BM;
            if (r < I_O) { tr_item(w_o, 4096, Bo, 4096, 64 * (r / 128), 32 * (r % 128), 32 * (r % 128), scr, lane); continue; } r -= I_O;
            { const int n0 = 32 * (r % 370), k0 = 64 * (r / 370);
              if (n0 < 2048) tr_item(w_in, 11840, Bin, 4096, k0, n0, n0, scr, lane);
              else { const int drow = (n0 < 3072) ? n0 - 2048 : (n0 < 3584) ? 1024 + (n0 - 3072) : (n0 < 3648) ? 5632 + (n0 - 3584) : (n0 < 7744) ? 5888 + (n0 - 3648) : 1536 + (n0 - 7744);
                     tr_item8(w_in, 11840, BinB, 4096, k0, n0, drow, scr, lane, 64.f); } }
        }
        { const float* pool_scale = KIN(5);
          for (int i = gt; i < 4 * 512 * 512 / 8; i += NGT) { const int e = i * 8, g = e >> 18, d = e & 511;
            const GAS f32x4* wp = (const GAS f32x4*)(pool_w + e); const GAS f32x4* sp = (const GAS f32x4*)(pool_scale + g * 512 + d);
            const f32x4 w0 = wp[0], w1 = wp[1], s0 = sp[0], s1 = sp[1];
            float o[8] = {w0.x * s0.x, w0.y * s0.y, w0.z * s0.z, w0.w * s0.w, w1.x * s1.x, w1.y * s1.y, w1.z * s1.z, w1.w * s1.w};
            *(GAS v4u*)(Bpool + e) = pack8(o); } }
        { GAS v4u* z = (GAS v4u*)(BinB + (size_t)5696 * 4096); const v4u zero = {0u, 0u, 0u, 0u};
          for (int i = gt; i < 192 * 4096 / 16; i += NGT) z[i] = zero; }
        for (int i = gt; i < SEQ * 32; i += NGT) { const int t = i >> 5, f = i & 31;
            const float inv = 1.0f / (float)exp2(13.287712379549449 * ((double)(2 * f) / 64.0));
            const float ang = (float)t * inv; double s, c; sincos_d((double)ang, s, c); ropec[i] = (float)c; ropes[i] = (float)s; }
        for (int m = gw; m < M; m += NGW) { const float* xr = (m < MP) ? x_prompt + (size_t)m * DM : x_sample + (size_t)(m - MP) * DM; rms_row_4096(xr, norm_mix_gain, Hb + (size_t)m * DM, H8 + (size_t)m * DM, lane); }
    }
    GRID_BAR();
#endif
    STAMP(1);
#if (PHM >> 1) & 1
    {
        kptr_t kp = karg(); unsigned char* ws = KWS();
        bf16* Hb = (bf16*)(ws + WS_A); bf16* Bin = (bf16*)(ws + WS_BIN); bf16* ZA = (bf16*)(ws + WS_B); bf16* ZK = (bf16*)(ws + WS_ZK); bf16* ZG = (bf16*)(ws + WS_ZG);
        {
            pg8::Gemm g{Hb, Bin, M, 2048, DM}; pg8::StaticOrder S; S.init(M, 2048, G, bx);
            pg8::EpiZa E{ZA, ZG};
            pg8::gemm_phase<pg8::EpiZa, pg8::StaticOrder, true, true>(lds + RING_OFF, g, S, E);
        }
        {
            pg8::Gemm g{(const bf16*)(ws + WS_H8), (const bf16*)(ws + WS_BINB), M, 9984, DM / 2}; pg8::DynTailOrder S; S.init2(M, 9984, G, bx, (unsigned*)(ws + WS_DYNCTR), MISC + 4);
            pg8::EpiZb E{ZA, ZG, ZK, 1.0f / 64.0f};
            pg8::gemm_phase<pg8::EpiZb, pg8::DynTailOrder, true, true, true>(lds + RING_OFF, g, S, E);
        }
    }
    GRID_BAR();
#endif
    STAMP(2);
#if (PHM >> 2) & 1
    {
        PHASE_IDS();
        kptr_t kp = karg(); unsigned char* ws = KWS(); const float* q_a_gain = KIN(6); const float* kv_a_gain = KIN(8);
        bf16* ZA = (bf16*)(ws + WS_B); bf16* PAp = (bf16*)(ws + WS_A); unsigned char* CQN8 = (unsigned char*)(PAp + (size_t)4 * M * 512); unsigned char* CKVN8 = CQN8 + (size_t)M * 1024;
    for (int task = gw; task < 4 * (M / 64); task += NGW) {
        const int g = task & 3, m0 = (task >> 2) * 64, t0 = m0 % SEQ, half = 1 << g;
        const bf16* zc = ZA + (size_t)m0 * 3584 + g * 512 + lane * 8;
        bf16* pc = PAp + (size_t)m0 * 2048 + g * 512 + lane * 8;
        float sum[8] = {0.f, 0.f, 0.f, 0.f, 0.f, 0.f, 0.f, 0.f};
        for (int d = -half; d < half; ++d) { const int tt = t0 + d;
            if (tt >= 0 && tt < SEQ) { float v[8]; unpack8(*(const GAS v4u*)(zc + (ptrdiff_t)d * 3584), v);
#pragma unroll
                for (int j = 0; j < 8; ++j) sum[j] += v[j]; } }
#pragma unroll 4
        for (int i = 0; i < 64; ++i) {
            const int t = t0 + i, lo = (t - half < 0) ? 0 : t - half, hi = (t + half > SEQ) ? SEQ : t + half;
            const bool has_lead = (t + half < SEQ), has_trail = (t - half >= 0);
            const int il = has_lead ? i + half : i, it = has_trail ? i - half : i;
            const v4u ws_ = *(const GAS v4u*)(zc + (ptrdiff_t)i * 3584), wl = *(const GAS v4u*)(zc + (ptrdiff_t)il * 3584), wt = *(const GAS v4u*)(zc + (ptrdiff_t)it * 3584);
            float self[8], lead[8], trail[8], o[8]; unpack8(ws_, self); unpack8(wl, lead); unpack8(wt, trail);
            const float rc = 1.0f / (float)(hi - lo);
#pragma unroll
            for (int j = 0; j < 8; ++j) { o[j] = sum[j] * rc - self[j]; sum[j] += (has_lead ? lead[j] : 0.f) - (has_trail ? trail[j] : 0.f); }
            *(GAS v4u*)(pc + (size_t)i * 2048) = pack8(o);
        }
    }
    for (int m = gw; m < M; m += NGW) {
        const bf16* zrow = ZA + (size_t)m * 3584;
        { float a[8], b[8]; unpack8(*(const GAS v4u*)(zrow + 2048 + lane * 8), a); unpack8(*(const GAS v4u*)(zrow + 2560 + lane * 8), b);
          float s = 0.f;
#pragma unroll
          for (int j = 0; j < 8; ++j) s += a[j] * a[j] + b[j] * b[j];
          const float r = 1.0f / sqrtf(wave_sum(s) * (1.f / 1024.f) + RMS_EPS);
          const GAS f32x4* ga = (const GAS f32x4*)(q_a_gain + lane * 8); const GAS f32x4* gb = (const GAS f32x4*)(q_a_gain + 512 + lane * 8);
          const f32x4 ga0 = ga[0], ga1 = ga[1], gb0 = gb[0], gb1 = gb[1];
#pragma unroll
          for (int j = 0; j < 4; ++j) { a[j] *= r * ga0[j]; a[4 + j] *= r * ga1[j]; b[j] *= r * gb0[j]; b[4 + j] *= r * gb1[j]; }
          *(GAS v2u*)(CQN8 + (size_t)m * 1024 + lane * 8) = pack8_f8(a, 1.0f); *(GAS v2u*)(CQN8 + (size_t)m * 1024 + 512 + lane * 8) = pack8_f8(b, 1.0f); }
        { float a[8]; unpack8(*(const GAS v4u*)(zrow + 3072 + lane * 8), a);
          float s = 0.f;
#pragma unroll
          for (int j = 0; j < 8; ++j) s += a[j] * a[j];
          const float r = 1.0f / sqrtf(wave_sum(s) * (1.f / 512.f) + RMS_EPS);
          const GAS f32x4* ga = (const GAS f32x4*)(kv_a_gain + lane * 8); const f32x4 ga0 = ga[0], ga1 = ga[1];
#pragma unroll
          for (int j = 0; j < 4; ++j) { a[j] *= r * ga0[j]; a[4 + j] *= r * ga1[j]; }
          *(GAS v2u*)(CKVN8 + (size_t)m * 512 + lane * 8) = pack8_f8(a, 1.0f); }
    }
    }
    GRID_BAR();
#endif
    STAMP(3);
#if (PHM >> 3) & 1
    {
        kptr_t kp = karg(); unsigned char* ws = KWS();
        bf16* PAp = (bf16*)(ws + WS_A); bf16* CQN = PAp + (size_t)4 * M * 512; bf16* CKVN = (bf16*)((unsigned char*)CQN + (size_t)M * 1024);
        bf16* Bpool = (bf16*)(ws + WS_BPOOL); bf16* Buq = (bf16*)(ws + WS_BUQ); bf16* Bukv = (bf16*)(ws + WS_BUKV);
        bf16* Qb = (bf16*)(ws + WS_B); bf16* KN = (bf16*)(ws + WS_F); bf16* VH = (bf16*)(ws + WS_F + 96 * MiB);
    for (int gi = 0; gi < 4; ++gi) {
        pg8::Gemm g{(const bf16*)(ws + WS_BBP) + gi * 512, Bpool + (size_t)gi * 512 * 512, 4096, 512, 512, 2048}; pg8::StaticOrder S; S.init(4096, 512, G, (bx + 2 * G - 128 - 32 * gi) % G);
        pg8::EpiBf E{(bf16*)(ws + WS_WP) + gi * 512, 2048};
        pg8::gemm_phase<pg8::EpiBf, pg8::StaticOrder, true, true>(lds + RING_OFF, g, S, E);
    }
    {
        pg8::Gemm g{CQN, Buq, M, 3072, 512}; pg8::StaticOrder S; S.init(M, 3072, G, bx);
        pg8::EpiBf E{Qb, 3072};
        pg8::gemm_phase<pg8::EpiBf, pg8::StaticOrder, true, true, true>(lds + RING_OFF, g, S, E);
    }
    {
        pg8::Gemm g{CKVN, Bukv, M, 4096, 256}; pg8::StaticOrder S; S.init(M, 4096, G, bx);
        pg8::EpiKV8 E{KN, VH, 1.0f / 16.0f};
        pg8::gemm_phase<pg8::EpiKV8, pg8::StaticOrder, true, true, true>(lds + RING_OFF, g, S, E);
    }
    }
    GRID_BAR();
#endif
    STAMP(4);
#if (PHM >> 4) & 1
    {
        PHASE_IDS();
        kptr_t kp = karg(); unsigned char* ws = KWS(); const float* q_gain = KIN(10); const float* k_gain = KIN(11);
        const float* ropec = (const float*)(ws + WS_ROPE); const float* ropes = ropec + SEQ * 32;
        bf16* Qb = (bf16*)(ws + WS_B); bf16* KN = (bf16*)(ws + WS_F); bf16* ZK = (bf16*)(ws + WS_ZK); const bf16* VH = (const bf16*)(ws + WS_F + 96 * MiB);
        unsigned char* Q8 = ws + WS_Q8; unsigned char* K8 = ws + WS_K8; unsigned char* Vt8 = ws + WS_VT8;
    for (int m = gw; m < M; m += NGW) {
        const int t = m % SEQ, h = lane >> 2, s4 = lane & 3;
        float cs[8], sn[8];
        { const GAS f32x4* cp = (const GAS f32x4*)(ropec + t * 32 + 8 * s4); const GAS f32x4* sp = (const GAS f32x4*)(ropes + t * 32 + 8 * s4);
          const f32x4 c0 = cp[0], c1 = cp[1], s0 = sp[0], s1 = sp[1];
#pragma unroll
          for (int j = 0; j < 4; ++j) { cs[j] = c0[j]; cs[4 + j] = c1[j]; sn[j] = s0[j]; sn[4 + j] = s1[j]; } }
#pragma unroll
        for (int which = 0; which < 2; ++which) {
            float v[6][8];
            const float* gain = which ? k_gain : q_gain;
            if (which == 0) { const bf16* qp = Qb + (size_t)m * 3072 + h * 192;
#pragma unroll
                for (int c = 0; c < 4; ++c) unpack8(*(const GAS v4u*)(qp + 32 * s4 + 8 * c), v[c]);
                unpack8(*(const GAS v4u*)(qp + 128 + 8 * s4), v[4]); unpack8(*(const GAS v4u*)(qp + 160 + 8 * s4), v[5]); }
            else { const bf16* kp = KN + (size_t)m * 2048 + h * 128; const bf16* rp = ZK + (size_t)m * 256;
#pragma unroll
                for (int c = 0; c < 4; ++c) unpack8(*(const GAS v4u*)(kp + 32 * s4 + 8 * c), v[c]);
                unpack8(*(const GAS v4u*)(rp + 8 * s4), v[4]); unpack8(*(const GAS v4u*)(rp + 32 + 8 * s4), v[5]); }
            float ss = 0.f;
#pragma unroll
            for (int c = 0; c < 6; ++c)
#pragma unroll
                for (int j = 0; j < 8; ++j) ss += v[c][j] * v[c][j];
            ss += __shfl_xor(ss, 1); ss += __shfl_xor(ss, 2);
            const float r = 1.0f / sqrtf(ss * (1.f / 192.f) + RMS_EPS);
#pragma unroll
            for (int c = 0; c < 6; ++c) { const int d = (c < 4) ? 32 * s4 + 8 * c : (c == 4 ? 128 + 8 * s4 : 160 + 8 * s4);
                const GAS f32x4* gp = (const GAS f32x4*)(gain + d); const f32x4 g0 = gp[0], g1 = gp[1];
#pragma unroll
                for (int j = 0; j < 4; ++j) { v[c][j] *= r * g0[j]; v[c][4 + j] *= r * g1[j]; } }
#pragma unroll
            for (int j = 0; j < 8; ++j) { const float x1 = v[4][j], x2 = v[5][j]; v[4][j] = x1 * cs[j] - x2 * sn[j]; v[5][j] = x2 * cs[j] + x1 * sn[j]; }
            const float sc = (which == 0) ? 4.0f * 0.10411755178336285f : 0.25f;
            unsigned char* op = (which == 0) ? Q8 + (size_t)m * 3072 + h * 192 : K8 + ((size_t)((m / SEQ) * 16 + h) * SEQ + t) * 192;
#pragma unroll
            for (int c = 0; c < 4; ++c) *(GAS v2u*)(op + 32 * s4 + 8 * c) = pack8_f8(v[c], sc);
            *(GAS v2u*)(op + 128 + 8 * s4) = pack8_f8(v[4], sc); *(GAS v2u*)(op + 160 + 8 * s4) = pack8_f8(v[5], sc);
        }
    }
    for (int task = gw; task < 48 * 128; task += NGW) {
        const int pair = task >> 7, kb = task & 127;
        const bf16* vp = VH + ((size_t)pair * SEQ + (size_t)kb * 64) * 128 + 2 * lane;
        unsigned char* op = Vt8 + ((size_t)pair * 128 + 2 * lane) * SEQ + kb * 64;
#pragma unroll
        for (int hf = 0; hf < 2; ++hf) {
            unsigned w[32];
#pragma unroll
            for (int i = 0; i < 32; ++i) w[i] = *(const GAS unsigned*)(vp + (size_t)(hf * 32 + i) * 128);
            v4u d0[2], d1[2];
#pragma unroll
            for (int q4 = 0; q4 < 8; ++q4) {
                const unsigned a = w[4 * q4], b = w[4 * q4 + 1], c = w[4 * q4 + 2], d = w[4 * q4 + 3];
                const unsigned lo = pk4_f8(bflo(a), bflo(b), bflo(c), bflo(d)), hi = pk4_f8(bfhi(a), bfhi(b), bfhi(c), bfhi(d));
                if ((q4 & 3) == 0) { d0[q4 >> 2].x = lo; d1[q4 >> 2].x = hi; } else if ((q4 & 3) == 1) { d0[q4 >> 2].y = lo; d1[q4 >> 2].y = hi; }
                else if ((q4 & 3) == 2) { d0[q4 >> 2].z = lo; d1[q4 >> 2].z = hi; } else { d0[q4 >> 2].w = lo; d1[q4 >> 2].w = hi; }
            }
            *(GAS v4u*)(op + hf * 32) = d0[0]; *(GAS v4u*)(op + hf * 32 + 16) = d0[1];
            *(GAS v4u*)(op + SEQ + hf * 32) = d1[0]; *(GAS v4u*)(op + SEQ + hf * 32 + 16) = d1[1];
        }
    }
    }
    GRID_BAR();
#endif
    STAMP(5);
#if (PHM >> 5) & 1
    {
        kptr_t kp = karg(); unsigned char* ws = KWS();
        const unsigned char* Q8 = ws + WS_Q8; const unsigned char* K8 = ws + WS_K8; const unsigned char* Vt8 = ws + WS_VT8; unsigned char* BOUT = ws + WS_BOUT;
        for (int i = 0;; ++i) {
            int pair, qb;
            if (G == 256) { pair = i * 8 + (bx & 7); qb = bx >> 3; if (pair >= 48) break; }
            else { const int L = i * G + bx; if (L >= 48 * 32) break; pair = L >> 5; qb = L & 31; }
            const int sq = pair >> 4, h = pair & 15; const size_t tok0 = (size_t)sq * SEQ + (size_t)qb * 256;
            att::attn_unit(Q8 + tok0 * 3072 + h * 192, K8 + (size_t)pair * SEQ * 192, Vt8 + (size_t)pair * 128 * SEQ, BOUT + tok0 * 2048 + h * 128, lds + RING_OFF);
        }
    }
    GRID_BAR();
#endif
    STAMP(6);
#if (PHM >> 6) & 1
    {
        kptr_t kp = karg(); unsigned char* ws = KWS();
        bf16* PAp = (bf16*)(ws + WS_A); bf16* BOUT = (bf16*)(ws + WS_BOUT); bf16* Wp = (bf16*)(ws + WS_WP); bf16* Bbm = (bf16*)(ws + WS_BBM);
        bf16* Tb = (bf16*)(ws + WS_F); bf16* Mb = (bf16*)(ws + WS_F); bf16* ZG = (bf16*)(ws + WS_ZG);
    {
        pg8::Gemm g{PAp, Wp, M, 4096, 2048}; pg8::StaticOrder S; S.init(M, 4096, G, bx);
        pg8::EpiGateA E{Tb, ZG};
        pg8::gemm_phase<pg8::EpiGateA, pg8::StaticOrder, true, true>(lds + RING_OFF, g, S, E);
    }
    {
        pg8::Gemm g{BOUT, Bbm, M, 4096, 1024}; pg8::StaticOrder S; S.init(M, 4096, G, bx);
        pg8::EpiGateB8 E{Tb, Mb, ZG, 1.0f / 1024.0f};
        pg8::gemm_phase<pg8::EpiGateB8, pg8::StaticOrder, true, true, true>(lds + RING_OFF, g, S, E);
    }
    }
    GRID_BAR();
#endif
    STAMP(7);
#if (PHM >> 7) & 1
    {
        kptr_t kp = karg(); unsigned char* ws = KWS(); const float* x_prompt = KIN(0); const float* x_sample = KIN(1); float* out = KOUT();
        bf16* Mb = (bf16*)(ws + WS_F); bf16* Bo = (bf16*)(ws + WS_BO);
        pg8::Gemm g{Mb, Bo, M, 4096, 4096}; pg8::StaticOrder S; S.init(M, 4096, G, bx);
        pg8::EpiX1 E{x_prompt, x_sample, (bf16*)(ws + WS_H2), (float*)(ws + WS_ROWSS)};
        pg8::gemm_phase<pg8::EpiX1, pg8::StaticOrder, true, true>(lds + RING_OFF, g, S, E);
    }
#endif
    STAMP(8);
#if (PHM >> 8) & 1
    {
        PHASE_IDS();
        kptr_t kp = karg(); unsigned char* ws = KWS(); const float* norm_ffn_gain = KIN(15); const float* w_up = KIN(16); const float* w_down = KIN(19); float* out = KOUT();
        bf16* Bup = (bf16*)(ws + WS_BUP); bf16* Bdown = (bf16*)(ws + WS_BDOWN); bf16* H2 = (bf16*)(ws + WS_H2);
        constexpr int I_UP = 64 * 688, I_DOWN = 0;
        for (int it = gw; it < I_UP + I_DOWN; it += NGW) {
            int r = it;
            if (r < I_UP) { const int n0 = 32 * (r % 688); const int nn = (n0 < DFF) ? n0 : n0 - DFF; const int drow = 256 * (nn >> 7) + (nn & 127) + ((n0 < DFF) ? 0 : 128);
                tr_item(w_up, NUP, Bup, 4096, 64 * (r / 688), n0, drow, scr, lane, norm_ffn_gain); continue; } r -= I_UP;
            tr_item(w_down, 4096, Bdown, DFF, 64 * (r / 128), 32 * (r % 128), 32 * (r % 128), scr, lane);
        }
    }
    GRID_BAR();
#endif
    STAMP(9);
#if (PHM >> 9) & 1
    {
        kptr_t kp = karg(); unsigned char* ws = KWS(); const float* conv_w = KIN(17); const float* conv_b = KIN(18);
        bf16* H2 = (bf16*)(ws + WS_H2); bf16* Bup = (bf16*)(ws + WS_BUP); bf16* ACT = (bf16*)(ws + WS_ACT); bf16* SIDE = (bf16*)(ws + WS_SIDE);
        pg8::Gemm g{H2, Bup, M, NUP, DM}; pg8::DynRoundsOrder S; S.init2(M, NUP, G, bx, (unsigned*)(ws + WS_DYNCTR) + 1024, MISC + 4, 3);
        pg8::EpiConvGlu E{ACT, SIDE, conv_w, conv_b, lds + CONVSCR_OFF, (const float*)(ws + WS_ROWSS)};
        pg8::gemm_phase<pg8::EpiConvGlu, pg8::DynRoundsOrder, true, true>(lds + RING_OFF, g, S, E);
        {
            PHASE_IDS();
            const float* w_down = KIN(19); bf16* Bdown = (bf16*)(ws + WS_BDOWN); unsigned* qctr = (unsigned*)(ws + WS_DYNCTR) + 128;
            for (;;) {
                if (tidp_ == 0) MISC[5] = __hip_atomic_fetch_add(qctr, 1u, __ATOMIC_RELAXED, __HIP_MEMORY_SCOPE_AGENT);
                __syncthreads();
                const unsigned ch = MISC[5];
                __syncthreads();
                if (ch >= 172u * 128u / 16u) break;
#pragma unroll
                for (int j = 0; j < 2; ++j) { const int it = (int)ch * 16 + wavep_ * 2 + j;
                    tr_item(w_down, 4096, Bdown, DFF, 64 * (it / 128), 32 * (it % 128), 32 * (it % 128), scr, lane); }
            }
        }
    }
    GRID_BAR();
    STAMP(10);
    {
        PHASE_IDS();
        kptr_t kp = karg(); unsigned char* ws = KWS(); const float* conv_w = KIN(17); const float* conv_b = KIN(18);
        bf16* ACT = (bf16*)(ws + WS_ACT); const bf16* SIDE = (const bf16*)(ws + WS_SIDE);
        for (int idx = gt; idx < 768 * 1376; idx += NGT) {
            const int rw = idx / 1376, ch = idx % 1376, blk = rw >> 1, last = rw & 1, tile = ch >> 4, j8 = (ch & 15) * 8, c = tile * 128 + j8, col = tile * 256 + j8;
            const bf16* sb = SIDE + (size_t)blk * 4 * NUP + col;
            const v4u zero = {0u, 0u, 0u, 0u};
            v4u gmv, g0v, gpv, vmv, v0v, vpv;
            if (!last) { const bool has = (blk & 127) != 0;
                gmv = has ? *(const GAS v4u*)(sb - NUP) : zero; vmv = has ? *(const GAS v4u*)(sb - NUP + 128) : zero;
                g0v = *(const GAS v4u*)(sb); v0v = *(const GAS v4u*)(sb + 128); gpv = *(const GAS v4u*)(sb + NUP); vpv = *(const GAS v4u*)(sb + NUP + 128); }
            else { const bool has = (blk & 127) != 127;
                gmv = *(const GAS v4u*)(sb + 2 * NUP); vmv = *(const GAS v4u*)(sb + 2 * NUP + 128); g0v = *(const GAS v4u*)(sb + 3 * NUP); v0v = *(const GAS v4u*)(sb + 3 * NUP + 128);
                gpv = has ? *(const GAS v4u*)(sb + 4 * NUP) : zero; vpv = has ? *(const GAS v4u*)(sb + 4 * NUP + 128) : zero; }
            float gm[8], g0[8], gp[8], vm[8], v0[8], vp[8], a[8];
            unpack8(gmv, gm); unpack8(g0v, g0); unpack8(gpv, gp); unpack8(vmv, vm); unpack8(v0v, v0); unpack8(vpv, vp);
#pragma unroll
            for (int j = 0; j < 8; ++j) {
                const float gg = gm[j] * conv_w[c + j] + g0[j] * conv_w[NUP + c + j] + gp[j] * conv_w[2 * NUP + c + j] + conv_b[c + j];
                const float vv = vm[j] * conv_w[DFF + c + j] + v0[j] * conv_w[NUP + DFF + c + j] + vp[j] * conv_w[2 * NUP + DFF + c + j] + conv_b[DFF + c + j];
                a[j] = gg * __builtin_amdgcn_rcpf(1.0f + __expf(-gg)) * vv; }
            *(GAS v4u*)(ACT + ((size_t)blk * 64 + (last ? 63 : 0)) * DFF + c) = pack8(a);
        }
    }
    GRID_BAR();
    STAMP(11);
    {
        kptr_t kp = karg(); unsigned char* ws = KWS(); float* out = KOUT(); bf16* ACT = (bf16*)(ws + WS_ACT); bf16* Bdown = (bf16*)(ws + WS_BDOWN);
        pg8::Gemm g{ACT, Bdown, M, 4096, DFF}; pg8::StaticOrder S; S.init(M, 4096, G, bx);
        pg8::EpiOutX1 E{(const bf16*)(ws + WS_H2), out};
        pg8::gemm_phase<pg8::EpiOutX1, pg8::StaticOrder, true, true>(lds + RING_OFF, g, S, E);
    }
#endif
    STAMP(12);
#if defined(PROBE_A)
#if defined(PROBE_BAR_BX)
    if (bx == (PROBE_BAR_BX) && tid == 0) { unsigned d = MISC[31] * (unsigned)PROBE_MULT;
#else
    if (bx == 0 && tid == 0) { unsigned d = 0u;
#endif
        d += (MISC[16 + PROBE_B] - MISC[16 + PROBE_A]) * (unsigned)PROBE_MULT;
#if defined(PROBE_ATT)
        d += MISC[30] * (unsigned)PROBE_MULT;
#endif
#if defined(PROBE_CLK_A)
        d += (MISC[13] - MISC[12]) >> 4;
#endif
#if defined(PROBE_C)
        d += (MISC[16 + PROBE_D] - MISC[16 + PROBE_C]) * (unsigned)PROBE_MULT;
#endif
        if (d > 2000000u) d = 2000000u;
        const unsigned long long t0 = __builtin_amdgcn_s_memrealtime(); while ((unsigned)(__builtin_amdgcn_s_memrealtime() - t0) < d) __builtin_amdgcn_s_sleep(20); }
#endif
}

extern "C" void kernel_launch(void* const* d_in, const int* in_sizes, int n_in, void* d_out, int out_size, void* d_ws, size_t ws_size, hipStream_t stream) {
    static int grid = 0;
    if (grid == 0) {
        if (n_in != 20 || in_sizes[0] != MP * DM || in_sizes[1] != (M - MP) * DM || out_size != M * DM || ws_size < WS_NEED) {
            fprintf(stderr, "kernel_launch: shape mismatch (n_in %d, in0 %d, in1 %d, out %d, ws %zu, need %zu); nothing launched\n", n_in, n_in > 0 ? in_sizes[0] : -1, n_in > 1 ? in_sizes[1] : -1, out_size, ws_size, (size_t)WS_NEED); grid = -1; return; }
        int dev = 0, cus = 0, per_cu = 0;
        if (hipGetDevice(&dev) != hipSuccess || hipDeviceGetAttribute(&cus, hipDeviceAttributeMultiprocessorCount, dev) != hipSuccess) { fprintf(stderr, "kernel_launch: device query failed\n"); grid = -1; return; }
        if (hipFuncSetAttribute((const void*)fwd_kernel, hipFuncAttributeMaxDynamicSharedMemorySize, LDS_BYTES) != hipSuccess) { fprintf(stderr, "kernel_launch: hipFuncSetAttribute failed\n"); grid = -1; return; }
        if (hipOccupancyMaxActiveBlocksPerMultiprocessor(&per_cu, (const void*)fwd_kernel, NWAVES * 64, LDS_BYTES) != hipSuccess || per_cu < 1)
            fprintf(stderr, "kernel_launch: note: occupancy query reports %d workgroups per CU\n", per_cu);
        (void)hipGetLastError();
        grid = cus;
    }
    if (grid < 0) return;
    if (hipMemsetAsync((char*)d_ws + WS_CTL, 0, CTL_ZERO_BYTES, stream) != hipSuccess) { fprintf(stderr, "kernel_launch: memset failed\n"); return; }
    Args a{};
    for (int i = 0; i < 20; ++i) a.in[i] = (const float*)d_in[i];
    a.out = (float*)d_out; a.ws = (unsigned char*)d_ws;
    hipLaunchKernelGGL(fwd_kernel, dim3(grid), dim3(NWAVES * 64), LDS_BYTES, stream, a);
    const hipError_t le = hipPeekAtLastError();
    if (le != hipSuccess) fprintf(stderr, "kernel_launch: launch failed: %s\n", hipGetErrorName(le));
}
```

```cpp
#include <hip/hip_runtime.h>
#include <cstdio>
#include <cstdint>
namespace pg8 {
#define PG8_LAS __attribute__((address_space(3)))
typedef unsigned short bf16_t;
typedef short bf16x8 __attribute__((ext_vector_type(8)));
typedef float f32x4 __attribute__((ext_vector_type(4)));
typedef unsigned u32x4 __attribute__((ext_vector_type(4)));
constexpr int BM = 256, BK = 64, HALF = 128, HTB = HALF * BK * 2  , STAGE_BYTES = 8 * HTB, NXCD = 8, WGM = 8;

__host__ __device__ __forceinline__ int lds_byte(int r, int c) { const int st = (r >> 4) * 2 + (c >> 5), rr = r & 15, cc = c & 31, ob = rr * 64 + cc * 2; return st * 1024 + (ob ^ (((ob >> 9) & 1) << 5)); }
__host__ __device__ __forceinline__ void stage_rc(int b, int& R, int& C) { const int st = b / 1024, sb = b % 1024, swz = sb ^ (((sb >> 9) & 1) << 5); R = (st >> 1) * 16 + swz / 64; C = (st & 1) * 32 + (swz % 64) / 2; }
__host__ __device__ __forceinline__ int perm32(int rho) { const int n = rho >> 4, i = rho & 15; return 8 * (i >> 2) + 4 * n + (i & 3); }

struct Unit { int pm, pn; };
struct Gemm { const bf16_t* A; const bf16_t* Bt; int M, N, K; int lda; };

struct StaticOrder {
    int nM, nN, nwg, G, c;
    __host__ __device__ void init(int M, int N, int G_, int c_) { nM = M / BM; nN = N / BM; nwg = nM * nN; G = G_; c = c_; }
    __host__ __device__ bool next(int i, Unit& u) const {
        const long L = (long)i * G + c; if (L >= nwg) return false;
        int wgid = (int)L; { const int q = nwg / NXCD, r = nwg % NXCD, xcd = wgid % NXCD, off = wgid / NXCD; wgid = (xcd < r ? xcd * (q + 1) : r * (q + 1) + (xcd - r) * q) + off; }
        const int nig = WGM * nN, gid = wgid / nig, fm = gid * WGM, gsz = (nM - fm) < WGM ? (nM - fm) : WGM;
        u.pm = fm + ((wgid % nig) % gsz); u.pn = (wgid % nig) / gsz; return true;
    }
    __device__ __forceinline__ void a_ready(const Unit&) const {}
    __device__ __forceinline__ void done(const Unit&) const {}
};
__device__ __forceinline__ unsigned cvt_pk_bf16(float lo, float hi) { unsigned r; asm volatile("v_cvt_pk_bf16_f32 %0, %1, %2" : "=v"(r) : "v"(lo), "v"(hi)); return r; }
typedef float f32x2 __attribute__((ext_vector_type(2)));

struct DynTailOrder : StaticOrder {
    unsigned* ctr; volatile PG8_LAS unsigned* slot; int nfull, rem;
    __device__ void init2(int M, int N, int G_, int c_, unsigned* ctr_, volatile PG8_LAS unsigned* slot_) { init(M, N, G_, c_); ctr = ctr_; slot = slot_; nfull = nwg / G_; rem = nwg % G_; }
    __device__ __forceinline__ bool next(int i, Unit& u) const {
        if (i < nfull) return StaticOrder::next(i, u);
        if (i > nfull || rem == 0) return false;
        if (threadIdx.x < 64) {
            unsigned t = 0u; if (threadIdx.x == 0) t = __hip_atomic_fetch_add(ctr, 1u, __ATOMIC_RELAXED, __HIP_MEMORY_SCOPE_AGENT);
            asm volatile("s_waitcnt vmcnt(0)" ::: "memory");
            if (threadIdx.x == 0) *slot = t;
            asm volatile("s_waitcnt lgkmcnt(0)" ::: "memory");
        }
        asm volatile("" ::: "memory"); __builtin_amdgcn_s_barrier(); asm volatile("" ::: "memory");
        const unsigned t = *slot;
        if (t >= (unsigned)rem) return false;
        StaticOrder tmp = *this; tmp.c = (int)t; return tmp.StaticOrder::next(nfull, u);
    }
};
struct DynRoundsOrder : StaticOrder {
    unsigned* ctr; volatile PG8_LAS unsigned* slot; int nstat;
    __device__ void init2(int M, int N, int G_, int c_, unsigned* ctr_, volatile PG8_LAS unsigned* slot_, int R) { init(M, N, G_, c_); ctr = ctr_; slot = slot_; nstat = nwg / G_ - R; if (nstat < 0) nstat = 0; }
    __device__ __forceinline__ bool next(int i, Unit& u) const {
        if (i < nstat) return StaticOrder::next(i, u);
        const int q = nwg / NXCD, base = nstat * (G / NXCD);
        if (threadIdx.x < 64) {
            unsigned code = 0xffffffffu;
            if (threadIdx.x == 0) {
                const int x0 = c % NXCD;
                for (int k = 0; k < NXCD; ++k) { const int x = (x0 + k) % NXCD;
                    const unsigned t = __hip_atomic_fetch_add(ctr + 64 * x, 1u, __ATOMIC_RELAXED, __HIP_MEMORY_SCOPE_AGENT);
                    const int off = base + (int)t; if (off < q) { code = (unsigned)(x * q + off); break; } }
            }
            asm volatile("s_waitcnt vmcnt(0)" ::: "memory");
            if (threadIdx.x == 0) *slot = code;
            asm volatile("s_waitcnt lgkmcnt(0)" ::: "memory");
        }
        asm volatile("" ::: "memory"); __builtin_amdgcn_s_barrier(); asm volatile("" ::: "memory");
        const unsigned code = *slot;
        if (code == 0xffffffffu) return false;
        const int wgid = (int)code;
        const int nig = WGM * nN, gid = wgid / nig, fm = gid * WGM, gsz = (nM - fm) < WGM ? (nM - fm) : WGM;
        u.pm = fm + ((wgid % nig) % gsz); u.pn = (wgid % nig) / gsz; return true;
    }
};
struct PoolOrder {
    int G, c;
    __device__ __forceinline__ bool next(int i, Unit& u) const {
        const int L = i * G + c; if (L >= 768) return false;
        const int g = L / 192, r = L % 192; u.pm = g * 96 + (r >> 1); u.pn = g * 2 + (r & 1); return true;
    }
    __device__ __forceinline__ void a_ready(const Unit&) const {}
    __device__ __forceinline__ void done(const Unit&) const {}
};
typedef unsigned u32x2 __attribute__((ext_vector_type(2)));
__device__ __forceinline__ void st8(bf16_t* p, const f32x4 v0, const f32x4 v1) {
    u32x4 w; w.x = cvt_pk_bf16(v0[0], v0[1]); w.y = cvt_pk_bf16(v0[2], v0[3]); w.z = cvt_pk_bf16(v1[0], v1[1]); w.w = cvt_pk_bf16(v1[2], v1[3]);
    *(u32x4*)p = w;
}
__device__ __forceinline__ void ld8(const bf16_t* p, f32x4& v0, f32x4& v1) {
    const u32x4 w = *(const u32x4*)p;
    v0[0] = __uint_as_float(w.x << 16); v0[1] = __uint_as_float(w.x & 0xffff0000u); v0[2] = __uint_as_float(w.y << 16); v0[3] = __uint_as_float(w.y & 0xffff0000u);
    v1[0] = __uint_as_float(w.z << 16); v1[1] = __uint_as_float(w.z & 0xffff0000u); v1[2] = __uint_as_float(w.w << 16); v1[3] = __uint_as_float(w.w & 0xffff0000u);
}
__device__ __forceinline__ float sigmoidf_(float x) { return __builtin_amdgcn_rcpf(1.0f + __expf(-x)); }
__device__ __forceinline__ f32x4 sig4(const f32x4 x) { f32x4 r; r[0] = sigmoidf_(x[0]); r[1] = sigmoidf_(x[1]); r[2] = sigmoidf_(x[2]); r[3] = sigmoidf_(x[3]); return r; }

struct EpiBf {
    static constexpr bool PERM = true, AFTER_DRAIN = false;
    bf16_t* O; int ldc;
    __device__ __forceinline__ void operator()(const f32x4 (&acc)[2][2][4][2], const Unit& u, int wr, int wc, int fr_in, int fq_in) const {
        int fr = fr_in, fq = fq_in; asm volatile("" : "+v"(fr), "+v"(fq));
        const int row0 = u.pm * BM + wr * 64 + fr, col0 = u.pn * BM + wc * 32 + 8 * fq;
#pragma unroll
        for (int ai = 0; ai < 2; ++ai)
#pragma unroll
            for (int m = 0; m < 4; ++m) { bf16_t* rowp = O + (size_t)(row0 + ai * HALF + m * 16) * ldc + col0;
#pragma unroll
                for (int bj = 0; bj < 2; ++bj) st8(rowp + bj * HALF, acc[ai][bj][m][0], acc[ai][bj][m][1]); }
    }
};
struct EpiKV {
    static constexpr bool PERM = true, AFTER_DRAIN = false;
    bf16_t *KN, *VH;
    __device__ __forceinline__ void operator()(const f32x4 (&acc)[2][2][4][2], const Unit& u, int wr, int wc, int fr_in, int fq_in) const {
        int fr = fr_in, fq = fq_in; asm volatile("" : "+v"(fr), "+v"(fq));
        const int rl0 = wr * 64 + fr, c0 = wc * 32 + 8 * fq, sq = u.pm >> 5, t0 = (u.pm & 31) * BM;
        bf16_t* kn = KN + (size_t)u.pm * BM * 2048 + u.pn * 128 + c0;
        bf16_t* vh = VH + ((size_t)(sq * 16 + u.pn) * 8192 + t0) * 128 + c0;
#pragma unroll
        for (int ai = 0; ai < 2; ++ai)
#pragma unroll
            for (int m = 0; m < 4; ++m) { const int rl = rl0 + ai * HALF + m * 16;
                st8(kn + (size_t)rl * 2048, acc[ai][0][m][0], acc[ai][0][m][1]);
                st8(vh + (size_t)rl * 128, acc[ai][1][m][0], acc[ai][1][m][1]); }
    }
};
struct EpiKV8 {
    static constexpr bool PERM = true, AFTER_DRAIN = false;
    bf16_t *KN, *VH; float cs; const float* rowkv;
    __device__ __forceinline__ void operator()(const f32x4 (&acc)[2][2][4][2], const Unit& u, int wr, int wc, int fr_in, int fq_in) const {
        int fr = fr_in, fq = fq_in; asm volatile("" : "+v"(fr), "+v"(fq));
        const int rl0 = wr * 64 + fr, c0 = wc * 32 + 8 * fq, sq = u.pm >> 5, t0 = (u.pm & 31) * BM;
        bf16_t* kn = KN + (size_t)u.pm * BM * 2048 + u.pn * 128 + c0;
        bf16_t* vh = VH + ((size_t)(sq * 16 + u.pn) * 8192 + t0) * 128 + c0;
#pragma unroll
        for (int ai = 0; ai < 2; ++ai)
#pragma unroll
            for (int m = 0; m < 4; ++m) { const int rl = rl0 + ai * HALF + m * 16; const float rs = cs / sqrtf(rowkv[u.pm * BM + rl] * (1.f / 512.f) + 1e-6f);
                st8(kn + (size_t)rl * 2048, acc[ai][0][m][0] * rs, acc[ai][0][m][1] * rs);
                st8(vh + (size_t)rl * 128, acc[ai][1][m][0] * rs, acc[ai][1][m][1] * rs); }
    }
};
__device__ __forceinline__ float qsum16(float v) { auto r = __builtin_amdgcn_permlane16_swap(__float_as_uint(v), __float_as_uint(v), false, false); return __uint_as_float(r[0]) + __uint_as_float(r[1]); }
__device__ __forceinline__ float qsum32(float v) { auto r = __builtin_amdgcn_permlane32_swap(__float_as_uint(v), __float_as_uint(v), false, false); return __uint_as_float(r[0]) + __uint_as_float(r[1]); }
struct EpiZa {
    static constexpr bool PERM = true, AFTER_DRAIN = false;
    bf16_t *ZA, *ZG;
    __device__ __forceinline__ void operator()(const f32x4 (&acc)[2][2][4][2], const Unit& u, int wr, int wc, int fr_in, int fq_in) const {
        int fr = fr_in, fq = fq_in; asm volatile("" : "+v"(fr), "+v"(fq));
        bf16_t* base; int ldc, colt;
        if (u.pn < 8) { base = ZA; ldc = 2048; colt = u.pn * 256; } else { base = ZG; ldc = 8192; colt = (u.pn - 8) * 256; }
        const int row0 = u.pm * BM + wr * 64 + fr, col0 = colt + wc * 32 + 8 * fq;
#pragma unroll
        for (int ai = 0; ai < 2; ++ai)
#pragma unroll
            for (int m = 0; m < 4; ++m) { bf16_t* rowp = base + (size_t)(row0 + ai * HALF + m * 16) * ldc + col0;
#pragma unroll
                for (int bj = 0; bj < 2; ++bj) st8(rowp + bj * HALF, acc[ai][bj][m][0], acc[ai][bj][m][1]); }
    }
};
struct EpiZb {
    static constexpr bool PERM = true, AFTER_DRAIN = false;
    unsigned char* CQ8; unsigned char* CKV8; float* rowkv; bf16_t *ZG, *ZK; float cs;
    __device__ __forceinline__ static void st8f8(unsigned char* p, const f32x4 v0, const f32x4 v1) {
        int a = __builtin_amdgcn_cvt_pk_fp8_f32(v0[0], v0[1], 0, false); a = __builtin_amdgcn_cvt_pk_fp8_f32(v0[2], v0[3], a, true);
        int b = __builtin_amdgcn_cvt_pk_fp8_f32(v1[0], v1[1], 0, false); b = __builtin_amdgcn_cvt_pk_fp8_f32(v1[2], v1[3], b, true);
        u32x2 w; w.x = (unsigned)a; w.y = (unsigned)b; *(u32x2*)p = w; }
    __device__ __forceinline__ void operator()(const f32x4 (&acc)[2][2][4][2], const Unit& u, int wr, int wc, int fr_in, int fq_in) const {
        if (u.pn < 6) {
            int fr = fr_in, fq = fq_in; asm volatile("" : "+v"(fr), "+v"(fq));
            const bool isq = u.pn < 4; const int ldc = isq ? 1024 : 512;
            unsigned char* p0 = (isq ? CQ8 : CKV8) + (size_t)(u.pm * BM + wr * 64 + fr) * ldc + (isq ? u.pn : u.pn - 4) * 256 + wc * 32 + 8 * fq;
#pragma unroll
            for (int ai = 0; ai < 2; ++ai)
#pragma unroll
                for (int m = 0; m < 4; ++m) {
#pragma unroll
                    for (int bj = 0; bj < 2; ++bj) st8f8(p0 + (size_t)(ai * HALF + m * 16) * ldc + bj * HALF, acc[ai][bj][m][0] * cs, acc[ai][bj][m][1] * cs);
                    asm volatile("" ::: "memory"); }
            if (!isq) {
                int frr = fr_in, fqq = fq_in; asm volatile("" : "+v"(frr), "+v"(fqq));
                float* rk = rowkv + u.pm * BM + wr * 64 + frr;
#pragma unroll
                for (int ai = 0; ai < 2; ++ai)
#pragma unroll
                    for (int m = 0; m < 4; ++m) { float ss = 0.f;
#pragma unroll
                        for (int bj = 0; bj < 2; ++bj) { const f32x4 v0 = acc[ai][bj][m][0], v1 = acc[ai][bj][m][1];
                            ss += (v0[0] * v0[0] + v0[1] * v0[1]) + (v0[2] * v0[2] + v0[3] * v0[3]) + (v1[0] * v1[0] + v1[1] * v1[1]) + (v1[2] * v1[2] + v1[3] * v1[3]); }
                        ss = qsum32(qsum16(ss)) * (cs * cs);
                        if (fqq == 0) __hip_atomic_fetch_add(rk + ai * HALF + m * 16, ss, __ATOMIC_RELAXED, __HIP_MEMORY_SCOPE_AGENT);
                        __builtin_amdgcn_sched_barrier(0); }
            }
        } else {
            int fr = fr_in, fq = fq_in; asm volatile("" : "+v"(fr), "+v"(fq));
            bf16_t* base; int ldc, colt;
            if (u.pn < 22) { base = ZG; ldc = 8192; colt = 4096 + (u.pn - 6) * 256; } else if (u.pn == 22) { base = ZK; ldc = 256; colt = 0; }
            else { base = ZG; ldc = 8192; colt = (u.pn - 23) * 256; }
            bf16_t* p0 = base + (size_t)(u.pm * BM + wr * 64 + fr) * ldc + colt + wc * 32 + 8 * fq;
#pragma unroll
            for (int ai = 0; ai < 2; ++ai)
#pragma unroll
                for (int m = 0; m < 4; ++m) {
#pragma unroll
                    for (int bj = 0; bj < 2; ++bj) st8(p0 + (size_t)(ai * HALF + m * 16) * ldc + bj * HALF, acc[ai][bj][m][0] * cs, acc[ai][bj][m][1] * cs);
                    asm volatile("" ::: "memory"); }
        }
    }
};

struct EpiZ {
    static constexpr bool PERM = true, AFTER_DRAIN = false;
    bf16_t *ZA, *ZG, *ZK;
    __device__ __forceinline__ void operator()(const f32x4 (&acc)[2][2][4][2], const Unit& u, int wr, int wc, int fr_in, int fq_in) const {
        int fr = fr_in, fq = fq_in; asm volatile("" : "+v"(fr), "+v"(fq));
        bf16_t* base; int ldc, colt;
        if (u.pn < 14) { base = ZA; ldc = 3584; colt = u.pn * 256; } else if (u.pn < 46) { base = ZG; ldc = 8192; colt = (u.pn - 14) * 256; } else { base = ZK; ldc = 256; colt = 0; }
        const int row0 = u.pm * BM + wr * 64 + fr, col0 = colt + wc * 32 + 8 * fq;
#pragma unroll
        for (int ai = 0; ai < 2; ++ai)
#pragma unroll
            for (int m = 0; m < 4; ++m) { bf16_t* rowp = base + (size_t)(row0 + ai * HALF + m * 16) * ldc + col0;
#pragma unroll
                for (int bj = 0; bj < 2; ++bj) st8(rowp + bj * HALF, acc[ai][bj][m][0], acc[ai][bj][m][1]); }
    }
};
struct EpiPool {
    static constexpr bool PERM = true, AFTER_DRAIN = false;
    bf16_t* O; const float* scale;
    __device__ __forceinline__ void operator()(const f32x4 (&acc)[2][2][4][2], const Unit& u, int wr, int wc, int fr_in, int fq_in) const {
        int fr = fr_in, fq = fq_in; asm volatile("" : "+v"(fr), "+v"(fq));
        const int g = u.pm / 96, row0 = (u.pm % 96) * BM + wr * 64 + fr, col0 = g * 512 + (u.pn & 1) * 256 + wc * 32 + 8 * fq;
        f32x4 sv[2][2];
#pragma unroll
        for (int bj = 0; bj < 2; ++bj)
#pragma unroll
            for (int n = 0; n < 2; ++n) sv[bj][n] = *(const f32x4*)(scale + col0 + bj * HALF + 4 * n);
#pragma unroll
        for (int ai = 0; ai < 2; ++ai)
#pragma unroll
            for (int m = 0; m < 4; ++m) { bf16_t* rowp = O + (size_t)(row0 + ai * HALF + m * 16) * 2048 + col0;
#pragma unroll
                for (int bj = 0; bj < 2; ++bj) st8(rowp + bj * HALF, acc[ai][bj][m][0] * sv[bj][0], acc[ai][bj][m][1] * sv[bj][1]); }
    }
};
struct EpiGateA {
    static constexpr bool PERM = true, AFTER_DRAIN = false;
    bf16_t* T; const bf16_t* ZG;
    __device__ __forceinline__ void operator()(const f32x4 (&acc)[2][2][4][2], const Unit& u, int wr, int wc, int fr_in, int fq_in) const {
        int fr = fr_in, fq = fq_in; asm volatile("" : "+v"(fr), "+v"(fq));
        const int row0 = u.pm * BM + wr * 64 + fr, col0 = u.pn * BM + wc * 32 + 8 * fq;
#pragma unroll
        for (int ai = 0; ai < 2; ++ai)
#pragma unroll
            for (int m = 0; m < 4; ++m) { const size_t r = (size_t)(row0 + ai * HALF + m * 16);
#pragma unroll
                for (int bj = 0; bj < 2; ++bj) { f32x4 g0, g1; ld8(ZG + r * 8192 + col0 + bj * HALF, g0, g1);
                    st8(T + r * 4096 + col0 + bj * HALF, acc[ai][bj][m][0] * sig4(g0), acc[ai][bj][m][1] * sig4(g1)); } }
    }
};
struct EpiGateB {
    static constexpr bool PERM = true, AFTER_DRAIN = false;
    const bf16_t* T; bf16_t* Mo; const bf16_t* ZG;
    __device__ __forceinline__ void operator()(const f32x4 (&acc)[2][2][4][2], const Unit& u, int wr, int wc, int fr_in, int fq_in) const {
        int fr = fr_in, fq = fq_in; asm volatile("" : "+v"(fr), "+v"(fq));
        const int row0 = u.pm * BM + wr * 64 + fr, col0 = u.pn * BM + wc * 32 + 8 * fq;
#pragma unroll
        for (int ai = 0; ai < 2; ++ai)
#pragma unroll
            for (int m = 0; m < 4; ++m) { const size_t r = (size_t)(row0 + ai * HALF + m * 16);
#pragma unroll
                for (int bj = 0; bj < 2; ++bj) { f32x4 g0, g1, t0, t1; ld8(ZG + r * 8192 + 4096 + col0 + bj * HALF, g0, g1); ld8(T + r * 4096 + col0 + bj * HALF, t0, t1);
                    st8(Mo + r * 4096 + col0 + bj * HALF, t0 + acc[ai][bj][m][0] * sig4(g0), t1 + acc[ai][bj][m][1] * sig4(g1)); } }
    }
};
struct EpiGateB8 {
    static constexpr bool PERM = true, AFTER_DRAIN = false;
    const bf16_t* T; bf16_t* Mo; const bf16_t* ZG; float cs;
    __device__ __forceinline__ void operator()(const f32x4 (&acc)[2][2][4][2], const Unit& u, int wr, int wc, int fr_in, int fq_in) const {
        int fr = fr_in, fq = fq_in; asm volatile("" : "+v"(fr), "+v"(fq));
        const int row0 = u.pm * BM + wr * 64 + fr, col0 = u.pn * BM + wc * 32 + 8 * fq;
#pragma unroll
        for (int ai = 0; ai < 2; ++ai)
#pragma unroll
            for (int m = 0; m < 4; ++m) { const size_t r = (size_t)(row0 + ai * HALF + m * 16);
#pragma unroll
                for (int bj = 0; bj < 2; ++bj) { f32x4 g0, g1, t0, t1; ld8(ZG + r * 8192 + 4096 + col0 + bj * HALF, g0, g1); ld8(T + r * 4096 + col0 + bj * HALF, t0, t1);
                    st8(Mo + r * 4096 + col0 + bj * HALF, t0 + acc[ai][bj][m][0] * (sig4(g0) * cs), t1 + acc[ai][bj][m][1] * (sig4(g1) * cs)); } }
    }
};
struct EpiX1 {
    static constexpr bool PERM = true, AFTER_DRAIN = false;
    const float *xp, *xs; bf16_t* X1; float* rowss;
    __device__ __forceinline__ void operator()(const f32x4 (&acc)[2][2][4][2], const Unit& u, int wr, int wc, int fr_in, int fq_in) const {
        int fr = fr_in, fq = fq_in; asm volatile("" : "+v"(fr), "+v"(fq));
        const float* xb = (u.pm < 64) ? xp + (size_t)u.pm * BM * 4096 : xs + (size_t)(u.pm - 64) * BM * 4096;
        const int rl0 = wr * 64 + fr, col0 = u.pn * BM + wc * 32 + 8 * fq;
        float ssr[2][4];
#pragma unroll
        for (int ai = 0; ai < 2; ++ai)
#pragma unroll
            for (int m = 0; m < 4; ++m) { const int rl = rl0 + ai * HALF + m * 16; const size_t off = (size_t)rl * 4096 + col0; float ss = 0.f;
#pragma unroll
                for (int bj = 0; bj < 2; ++bj) { const f32x4 v0 = *(const f32x4*)(xb + off + bj * HALF) + acc[ai][bj][m][0], v1 = *(const f32x4*)(xb + off + bj * HALF + 4) + acc[ai][bj][m][1];
                    ss += (v0[0] * v0[0] + v0[1] * v0[1]) + (v0[2] * v0[2] + v0[3] * v0[3]) + (v1[0] * v1[0] + v1[1] * v1[1]) + (v1[2] * v1[2] + v1[3] * v1[3]);
                    st8(X1 + (size_t)u.pm * BM * 4096 + off + bj * HALF, v0, v1); }
                ssr[ai][m] = ss;
                asm volatile("" ::: "memory"); }
#pragma unroll
        for (int ai = 0; ai < 2; ++ai)
#pragma unroll
            for (int m = 0; m < 4; ++m) { const float ss = qsum32(qsum16(ssr[ai][m]));
                if (fq == 0) __hip_atomic_fetch_add(rowss + u.pm * BM + rl0 + ai * HALF + m * 16, ss, __ATOMIC_RELAXED, __HIP_MEMORY_SCOPE_AGENT); }
    }
};
struct EpiOutX1 {
    static constexpr bool PERM = false, AFTER_DRAIN = false;
    const bf16_t* X1; float* out;
    __device__ __forceinline__ void operator()(const f32x4 (&acc)[2][2][4][2], const Unit& u, int wr, int wc, int fr_in, int fq_in) const {
        int fr = fr_in, fq = fq_in; asm volatile("" : "+v"(fr), "+v"(fq));
        const bf16_t* xb = X1 + (size_t)u.pm * BM * 4096; float* ob = out + (size_t)u.pm * BM * 4096;
        const int rl0 = wr * 64 + fr, col0 = u.pn * BM + wc * 32 + 4 * fq;
#pragma unroll
        for (int ai = 0; ai < 2; ++ai)
#pragma unroll
            for (int m = 0; m < 4; ++m) { const size_t off = (size_t)(rl0 + ai * HALF + m * 16) * 4096 + col0;
#pragma unroll
                for (int bj = 0; bj < 2; ++bj)
#pragma unroll
                    for (int n = 0; n < 2; ++n) { const u32x2 w = *(const u32x2*)(xb + off + bj * HALF + n * 16);
                        const f32x4 xv = {__uint_as_float(w.x << 16), __uint_as_float(w.x & 0xffff0000u), __uint_as_float(w.y << 16), __uint_as_float(w.y & 0xffff0000u)};
                        *(f32x4*)(ob + off + bj * HALF + n * 16) = xv + acc[ai][bj][m][n]; }
                asm volatile("" ::: "memory"); }
    }
};
struct EpiResX {
    static constexpr bool PERM = false, AFTER_DRAIN = false;
    const float *xp, *xs; float* out;
    __device__ __forceinline__ void operator()(const f32x4 (&acc)[2][2][4][2], const Unit& u, int wr, int wc, int fr_in, int fq_in) const {
        int fr = fr_in, fq = fq_in; asm volatile("" : "+v"(fr), "+v"(fq));
        const float* xb = (u.pm < 64) ? xp + (size_t)u.pm * BM * 4096 : xs + (size_t)(u.pm - 64) * BM * 4096;
        float* ob = out + (size_t)u.pm * BM * 4096;
        const int rl0 = wr * 64 + fr, col0 = u.pn * BM + wc * 32 + 4 * fq;
#pragma unroll
        for (int ai = 0; ai < 2; ++ai)
#pragma unroll
            for (int m = 0; m < 4; ++m) { const size_t off = (size_t)(rl0 + ai * HALF + m * 16) * 4096 + col0;
#pragma unroll
                for (int bj = 0; bj < 2; ++bj)
#pragma unroll
                    for (int n = 0; n < 2; ++n) { const f32x4 xv = *(const f32x4*)(xb + off + bj * HALF + n * 16); *(f32x4*)(ob + off + bj * HALF + n * 16) = xv + acc[ai][bj][m][n]; }
                asm volatile("" ::: "memory"); }
    }
};
struct EpiResOut {
    static constexpr bool PERM = false, AFTER_DRAIN = false;
    float* out;
    __device__ __forceinline__ void operator()(const f32x4 (&acc)[2][2][4][2], const Unit& u, int wr, int wc, int fr_in, int fq_in) const {
        int fr = fr_in, fq = fq_in; asm volatile("" : "+v"(fr), "+v"(fq));
        float* ob = out + (size_t)u.pm * BM * 4096;
        const int rl0 = wr * 64 + fr, col0 = u.pn * BM + wc * 32 + 4 * fq;
#pragma unroll
        for (int ai = 0; ai < 2; ++ai)
#pragma unroll
            for (int m = 0; m < 4; ++m) { const size_t off = (size_t)(rl0 + ai * HALF + m * 16) * 4096 + col0;
#pragma unroll
                for (int bj = 0; bj < 2; ++bj)
#pragma unroll
                    for (int n = 0; n < 2; ++n) { const f32x4 xv = *(const f32x4*)(ob + off + bj * HALF + n * 16); *(f32x4*)(ob + off + bj * HALF + n * 16) = xv + acc[ai][bj][m][n]; }
                asm volatile("" ::: "memory"); }
    }
};

__device__ __forceinline__ float silu_(float x) { return x * __builtin_amdgcn_rcpf(1.0f + __builtin_amdgcn_exp2f(-1.4426950408889634f * x)); }
constexpr int CONV_SLICE_BYTES = 66 * 32;
__device__ __forceinline__ void st4(bf16_t* p, const f32x4 v) { u32x2 w; w.x = cvt_pk_bf16(v[0], v[1]); w.y = cvt_pk_bf16(v[2], v[3]); *(u32x2*)p = w; }
struct EpiConvGlu {
    static constexpr bool PERM = false, AFTER_DRAIN = false;
    bf16_t* ACT; bf16_t* SIDE; const float* cw; const float* cb; PG8_LAS unsigned char* scr; const float* rowss;
    __device__ __forceinline__ void conv4(const f32x4 (&a)[4][2], int n, const float* wp, const float* bp, PG8_LAS unsigned char* sl, f32x4 (&out)[4]) const {
        const f32x4 w0 = *(const f32x4*)(wp), w1 = *(const f32x4*)(wp + 22016), w2 = *(const f32x4*)(wp + 2 * 22016), bb = *(const f32x4*)(bp);
#pragma unroll
        for (int m = 0; m < 4; ++m) { u32x2 w; w.x = cvt_pk_bf16(a[m][n][0], a[m][n][1]); w.y = cvt_pk_bf16(a[m][n][2], a[m][n][3]); *(PG8_LAS u32x2*)(sl + m * 512) = w; }
        asm volatile("s_waitcnt lgkmcnt(0)" ::: "memory");
        u32x2 pv[4], nx[4];
#pragma unroll
        for (int m = 0; m < 4; ++m) { pv[m] = *(const PG8_LAS u32x2*)(sl + m * 512 - 32); nx[m] = *(const PG8_LAS u32x2*)(sl + m * 512 + 32); }
        asm volatile("s_waitcnt lgkmcnt(0)" ::: "memory");
#pragma unroll
        for (int m = 0; m < 4; ++m) {
            const float p[4] = {__uint_as_float(pv[m].x << 16), __uint_as_float(pv[m].x & 0xffff0000u), __uint_as_float(pv[m].y << 16), __uint_as_float(pv[m].y & 0xffff0000u)};
            const float q[4] = {__uint_as_float(nx[m].x << 16), __uint_as_float(nx[m].x & 0xffff0000u), __uint_as_float(nx[m].y << 16), __uint_as_float(nx[m].y & 0xffff0000u)};
#pragma unroll
            for (int i = 0; i < 4; ++i) out[m][i] = fmaf(w0[i], p[i], fmaf(w1[i], a[m][n][i], fmaf(w2[i], q[i], bb[i])));
        }
    }
    __device__ __forceinline__ void operator()(f32x4 (&acc)[2][2][4][2], const Unit& u, int wr, int wc, int fr_in, int fq_in) const {
        int fr = fr_in, fq = fq_in; asm volatile("" : "+v"(fr), "+v"(fq));
#pragma unroll
        for (int ai = 0; ai < 2; ++ai)
#pragma unroll
            for (int m = 0; m < 4; ++m) { const float rs = 1.0f / sqrtf(rowss[u.pm * BM + ai * HALF + wr * 64 + m * 16 + fr] * (1.f / 4096.f) + 1e-6f);
#pragma unroll
                for (int bj = 0; bj < 2; ++bj)
#pragma unroll
                    for (int n = 0; n < 2; ++n) acc[ai][bj][m][n] *= rs; }
        const int chan0 = u.pn * 128 + wc * 32 + 4 * fq;
        const bool e0 = (fr == 0), e15 = (fr == 15);
        PG8_LAS unsigned char* sl = scr + (wr * 4 + wc) * CONV_SLICE_BYTES + (1 + fr) * 32 + fq * 8;
#pragma unroll
        for (int ai = 0; ai < 2; ++ai) {
            const int blk = u.pm * 4 + ai * 2 + wr;
#pragma unroll
            for (int bj = 0; bj < 2; ++bj)
#pragma unroll
                for (int n = 0; n < 2; ++n) { const int col = u.pn * 256 + bj * 128 + wc * 32 + 16 * n + 4 * fq;
                    if (fr < 2) st4(SIDE + ((size_t)blk * 4 + fr) * 22016 + col, acc[ai][bj][0][n]);
                    if (fr >= 14) st4(SIDE + ((size_t)blk * 4 + (fr - 12)) * 22016 + col, acc[ai][bj][3][n]); }
#pragma unroll
            for (int n = 0; n < 2; ++n) {
                f32x4 cg[4], cv[4];
                asm volatile("" ::: "memory");
                conv4(acc[ai][0], n, cw + chan0 + 16 * n, cb + chan0 + 16 * n, sl, cg);
                conv4(acc[ai][1], n, cw + 11008 + chan0 + 16 * n, cb + 11008 + chan0 + 16 * n, sl, cv);
#pragma unroll
                for (int m = 0; m < 4; ++m) {
                    f32x4 r;
#pragma unroll
                    for (int i = 0; i < 4; ++i) r[i] = silu_(cg[m][i]) * cv[m][i];
                    const bool skip = (m == 0 && e0) || (m == 3 && e15);
                    if (!skip) st4(ACT + (size_t)(u.pm * BM + ai * HALF + wr * 64 + m * 16 + fr) * 11008 + chan0 + 16 * n, r);
                }
            }
        }
    }
};
typedef int pg8_v8i __attribute__((ext_vector_type(8)));
typedef int pg8_v4i __attribute__((ext_vector_type(4)));
__device__ __forceinline__ f32x4 pg8_mfma128(const bf16x8 a0, const bf16x8 a1, const bf16x8 b0, const bf16x8 b1, const f32x4 c, int sc) {
    const pg8_v4i x0 = __builtin_bit_cast(pg8_v4i, a0), x1 = __builtin_bit_cast(pg8_v4i, a1), y0 = __builtin_bit_cast(pg8_v4i, b0), y1 = __builtin_bit_cast(pg8_v4i, b1);
    const pg8_v8i a = {x0.x, x0.y, x0.z, x0.w, x1.x, x1.y, x1.z, x1.w}, b = {y0.x, y0.y, y0.z, y0.w, y1.x, y1.y, y1.z, y1.w};
    f32x4 d = c;
    asm volatile("v_mfma_scale_f32_16x16x128_f8f6f4 %0, %1, %2, %0, %3, %3 op_sel_hi:[0,0,0]" : "+v"(d) : "v"(a), "v"(b), "v"(sc));
    return d;
}
template <class Epi, class Sched, bool ALIGN_EPI = false, bool SP2 = false, bool FP8 = false>
__device__ __forceinline__ void gemm_phase(PG8_LAS unsigned char* lds, const Gemm g, const Sched& S, const Epi& E) {
    int tid_l = threadIdx.x; asm volatile("" : "+v"(tid_l));
    const int tid = tid_l, wid = __builtin_amdgcn_readfirstlane(tid >> 6), lane = tid & 63, wr = wid >> 2, wc = wid & 3, fr = lane & 15, fq = lane >> 4;
    const int K = g.K, nt = K / BK;
    const int LDA = g.lda ? g.lda : K;
    int f8sc = 0x7f7f7f7f; if constexpr (FP8) asm volatile("" : "+v"(f8sc)); (void)f8sc;
    unsigned voffA[2], voffB[2];
#pragma unroll
    for (int i = 0; i < 2; ++i) { int R, C; stage_rc(tid * 16 + i * 8192, R, C); const int Rb = Epi::PERM ? ((R & ~31) + perm32(R & 31)) : R;
        voffA[i] = (unsigned)(R * LDA + C) * 2u; voffB[i] = (unsigned)(Rb * K + C) * 2u; }
    const size_t kstep = (size_t)(BK * 2);
    const size_t hstepA = (size_t)HALF * LDA * 2, tstepA = 2 * hstepA;
    const size_t hstep = (size_t)HALF * K * 2;
    const size_t tstep = 2 * hstep;
    const unsigned ldsw = (unsigned)wid * 1024u;
    const int aoff = lds_byte(wr * 64 + fr, fq * 8), boff = lds_byte(wc * 32 + fr, fq * 8);
#define PG8_SA(b, h) (((b) * 2 + (h)) * HTB)
#define PG8_SB(b, h) ((4 + (b) * 2 + (h)) * HTB)
#define PG8_STAGE(bufoff, gbase, voff) do { _Pragma("unroll") for (int _i = 0; _i < 2; ++_i) \
        __builtin_amdgcn_global_load_lds((const unsigned*)((const char*)(gbase) + (voff)[_i]), (PG8_LAS unsigned*)(lds + (bufoff) + ldsw + _i * 8192), 16, 0, 0); } while (0)
#define PG8_LDA(dst, b, h) do { _Pragma("unroll") for (int m = 0; m < 4; ++m) _Pragma("unroll") for (int k = 0; k < 2; ++k) dst[m][k] = *(const PG8_LAS bf16x8*)(lds + PG8_SA(b, h) + aoff + m * 2048 + k * 1024); } while (0)
#define PG8_LDB(dst, b, h) do { _Pragma("unroll") for (int n = 0; n < 2; ++n) _Pragma("unroll") for (int k = 0; k < 2; ++k) dst[n][k] = *(const PG8_LAS bf16x8*)(lds + PG8_SB(b, h) + boff + n * 2048 + k * 1024); } while (0)
#define PG8_MMA(ai, bj, At, Bt) do { __builtin_amdgcn_s_setprio(1); \
        if constexpr (FP8) { _Pragma("unroll") for (int m = 0; m < 4; ++m) _Pragma("unroll") for (int n = 0; n < 2; ++n) \
            acc[ai][bj][m][n] = pg8_mfma128(Bt[n][0], Bt[n][1], At[m][0], At[m][1], acc[ai][bj][m][n], f8sc); } \
        else { _Pragma("unroll") for (int m = 0; m < 4; ++m) _Pragma("unroll") for (int n = 0; n < 2; ++n) _Pragma("unroll") for (int k = 0; k < 2; ++k) \
            acc[ai][bj][m][n] = __builtin_amdgcn_mfma_f32_16x16x32_bf16(Bt[n][k], At[m][k], acc[ai][bj][m][n], 0, 0, 0); } \
        __builtin_amdgcn_s_setprio(0); } while (0)
#define PG8_WAIT_V(n) asm volatile("s_waitcnt vmcnt(" #n ")" ::: "memory")
#define PG8_WAIT_L(n) asm volatile("s_waitcnt lgkmcnt(" #n ")" ::: "memory")
#define PG8_BAR __builtin_amdgcn_s_barrier()
#define PG8_SCHED __builtin_amdgcn_sched_barrier(0)
    Unit cur, nxt; int ui = 0;
    if (!S.next(0, cur)) return;
    f32x4 acc[2][2][4][2];
#pragma unroll
    for (int a = 0; a < 2; ++a)
#pragma unroll
        for (int b = 0; b < 2; ++b)
#pragma unroll
            for (int m = 0; m < 4; ++m)
#pragma unroll
                for (int n = 0; n < 2; ++n) acc[a][b][m][n] = (f32x4){0.f, 0.f, 0.f, 0.f};
    bf16x8 At[4][2], B0[2][2], B1[2][2];
    const char* cA = (const char*)g.A + (size_t)cur.pm * tstepA; const char* cB = (const char*)g.Bt + (size_t)cur.pn * tstep;
    S.a_ready(cur);
    if constexpr (SP2) {
        PG8_STAGE(PG8_SB(0, 0), cB, voffB); PG8_STAGE(PG8_SB(0, 1), cB + hstep, voffB); PG8_STAGE(PG8_SA(0, 0), cA, voffA); PG8_STAGE(PG8_SA(0, 1), cA + hstepA, voffA);
        if (wr == 1) PG8_BAR;
        PG8_WAIT_V(2); PG8_BAR;
        PG8_STAGE(PG8_SB(1, 0), cB + kstep, voffB); PG8_STAGE(PG8_SA(1, 0), cA + kstep, voffA); PG8_STAGE(PG8_SB(1, 1), cB + hstep + kstep, voffB);
        PG8_WAIT_V(6); PG8_BAR;
    } else {
        PG8_STAGE(PG8_SB(0, 0), cB, voffB); PG8_STAGE(PG8_SA(0, 0), cA, voffA); PG8_STAGE(PG8_SB(0, 1), cB + hstep, voffB); PG8_STAGE(PG8_SA(0, 1), cA + hstepA, voffA);
        if (wr == 1) PG8_BAR;
        PG8_WAIT_V(4); PG8_BAR;
        PG8_STAGE(PG8_SB(1, 0), cB + kstep, voffB); PG8_STAGE(PG8_SA(1, 0), cA + kstep, voffA); PG8_STAGE(PG8_SB(1, 1), cB + hstep + kstep, voffB);
        PG8_WAIT_V(6); PG8_BAR;
    }
    for (;;) {
        const bool has_next = S.next(ui + 1, nxt);
        const char* nA = has_next ? (const char*)g.A + (size_t)nxt.pm * tstepA : cA; const char* nB = has_next ? (const char*)g.Bt + (size_t)nxt.pn * tstep : cB;
        for (int t = 0; t < nt; t += 2) {
            const bool last = (t == nt - 2);
            const char* a1 = cA + (size_t)(t + 1) * kstep;
            const char* a2 = last ? nA : cA + (size_t)(t + 2) * kstep; const char* b2 = last ? nB : cB + (size_t)(t + 2) * kstep;
            const char* a3 = a2 + kstep; const char* b3 = b2 + kstep;
            if (last && has_next) S.a_ready(nxt);
            if constexpr (SP2) {
            PG8_LDB(B0, 0, 0); PG8_LDB(B1, 0, 1); PG8_SCHED; PG8_LDA(At, 0, 0); PG8_STAGE(PG8_SA(1, 1), a1 + hstepA, voffA);
            PG8_WAIT_V(8); PG8_WAIT_L(0); PG8_BAR; PG8_MMA(0, 0, At, B0); PG8_MMA(0, 1, At, B1); PG8_BAR; PG8_SCHED;
            PG8_LDA(At, 0, 1); PG8_STAGE(PG8_SB(0, 0), b2, voffB); PG8_STAGE(PG8_SB(0, 1), b2 + hstep, voffB); PG8_STAGE(PG8_SA(0, 0), a2, voffA);
            PG8_WAIT_V(8); PG8_WAIT_L(0); PG8_BAR; PG8_MMA(1, 0, At, B0); PG8_MMA(1, 1, At, B1); PG8_BAR; PG8_SCHED;
            PG8_LDB(B0, 1, 0); PG8_LDB(B1, 1, 1); PG8_SCHED; PG8_LDA(At, 1, 0); PG8_STAGE(PG8_SA(0, 1), a2 + hstepA, voffA);
            PG8_WAIT_V(8); PG8_WAIT_L(0); PG8_BAR; PG8_MMA(0, 0, At, B0); PG8_MMA(0, 1, At, B1); PG8_BAR; PG8_SCHED;
            PG8_LDA(At, 1, 1); PG8_STAGE(PG8_SB(1, 0), b3, voffB); PG8_STAGE(PG8_SB(1, 1), b3 + hstep, voffB); PG8_STAGE(PG8_SA(1, 0), a3, voffA);
            PG8_WAIT_V(8); PG8_WAIT_L(0); PG8_BAR; PG8_MMA(1, 0, At, B0); PG8_MMA(1, 1, At, B1); PG8_BAR; PG8_SCHED;
            } else {
            PG8_LDB(B0, 0, 0); PG8_SCHED; PG8_LDA(At, 0, 0); PG8_STAGE(PG8_SA(1, 1), a1 + hstepA, voffA);
            PG8_WAIT_L(8); PG8_BAR; PG8_WAIT_L(0); PG8_MMA(0, 0, At, B0); PG8_BAR; PG8_SCHED;
            PG8_LDB(B1, 0, 1); PG8_STAGE(PG8_SB(0, 0), b2, voffB);
            PG8_BAR; PG8_WAIT_L(0); PG8_MMA(0, 1, At, B1); PG8_BAR;
            PG8_LDA(At, 0, 1); PG8_STAGE(PG8_SA(0, 0), a2, voffA);
            PG8_BAR; PG8_WAIT_L(0); PG8_MMA(1, 0, At, B0); PG8_BAR; PG8_SCHED;
            PG8_STAGE(PG8_SB(0, 1), b2 + hstep, voffB);
            PG8_WAIT_V(6); PG8_BAR; PG8_MMA(1, 1, At, B1); PG8_BAR;
            PG8_LDB(B0, 1, 0); PG8_SCHED; PG8_LDA(At, 1, 0); PG8_STAGE(PG8_SA(0, 1), a2 + hstepA, voffA);
            PG8_WAIT_L(8); PG8_BAR; PG8_WAIT_L(0); PG8_MMA(0, 0, At, B0); PG8_BAR; PG8_SCHED;
            PG8_LDB(B1, 1, 1); PG8_STAGE(PG8_SB(1, 0), b3, voffB);
            PG8_BAR; PG8_WAIT_L(0); PG8_MMA(0, 1, At, B1); PG8_BAR;
            PG8_LDA(At, 1, 1); PG8_STAGE(PG8_SA(1, 0), a3, voffA);
            PG8_BAR; PG8_WAIT_L(0); PG8_MMA(1, 0, At, B0); PG8_BAR; PG8_SCHED;
            PG8_STAGE(PG8_SB(1, 1), b3 + hstep, voffB);
            PG8_WAIT_V(6); PG8_BAR; PG8_MMA(1, 1, At, B1); PG8_BAR;
            }
        }
        if constexpr (ALIGN_EPI) { if (wr == 0) PG8_BAR; }
        if constexpr (FP8) asm volatile("s_nop 7\n\ts_nop 7" ::: "memory");
        if constexpr (!Epi::AFTER_DRAIN) { E(acc, cur, wr, wc, fr, fq); S.done(cur); }
        if (!has_next) break;
#pragma unroll
        for (int a = 0; a < 2; ++a)
#pragma unroll
            for (int b = 0; b < 2; ++b)
#pragma unroll
                for (int m = 0; m < 4; ++m)
#pragma unroll
                    for (int n = 0; n < 2; ++n) acc[a][b][m][n] = (f32x4){0.f, 0.f, 0.f, 0.f};
        cur = nxt; cA = nA; cB = nB; ++ui;
        if constexpr (ALIGN_EPI) { if (wr == 1) PG8_BAR; }
    }
    PG8_WAIT_V(0);
    if constexpr (!ALIGN_EPI) { if (wr == 0) PG8_BAR; }
    PG8_BAR;
    if constexpr (Epi::AFTER_DRAIN) { E.fused(acc, cur, wr, wc, fr, fq, lds, wid, lane); S.done(cur); }
#undef PG8_SA
#undef PG8_SB
#undef PG8_STAGE
#undef PG8_LDA
#undef PG8_LDB
#undef PG8_MMA
#undef PG8_WAIT_V
#undef PG8_WAIT_L
#undef PG8_BAR
#undef PG8_SCHED
}
}

namespace att {
#define ATT_LAS __attribute__((address_space(3)))
typedef unsigned short bf16_t;
typedef unsigned u32x4 __attribute__((ext_vector_type(4)));
typedef unsigned u32x2 __attribute__((ext_vector_type(2)));
constexpr int K_SLOT = 64 * 192, V_SLOT = 128 * 64;
constexpr int NKS = 3, NVS = 4;
constexpr int OFF_K = 0, OFF_V = NKS * K_SLOT, OFF_SCR = OFF_V + NVS * V_SLOT, ATT_LDS_BYTES = OFF_SCR + 8 * 64 * 4;
constexpr float BND = 360.f, SH0 = 4.0f, SHS = 6.0f;
constexpr int LDQ = 3072, LDK = 192, LDVT = 8192, LDO = 2048, SEQ = 8192;
constexpr float OSCALE = 32.f;
#define ATT_SBAR() __builtin_amdgcn_sched_barrier(0)
typedef float f32x4a __attribute__((ext_vector_type(4)));
__device__ __forceinline__ unsigned cvtpk(float lo, float hi) { unsigned r; asm volatile("v_cvt_pk_bf16_f32 %0, %1, %2" : "=v"(r) : "v"(lo), "v"(hi)); return r; }
__device__ __forceinline__ unsigned pk4f8(float a, float b, float c, float d) { int w = __builtin_amdgcn_cvt_pk_fp8_f32(a, b, 0, false); w = __builtin_amdgcn_cvt_pk_fp8_f32(c, d, w, true); return (unsigned)w; }
__device__ __forceinline__ f32x4a mfma8(unsigned a0, unsigned a1, unsigned b0, unsigned b1, f32x4a c) {
  return __builtin_amdgcn_mfma_f32_16x16x32_fp8_fp8(__builtin_bit_cast(long, (u32x2){a0, a1}), __builtin_bit_cast(long, (u32x2){b0, b1}), c, 0, 0, 0); }
__device__ __forceinline__ float max3f(float a, float b, float c) { float r; asm("v_max3_f32 %0, %1, %2, %3" : "=v"(r) : "v"(a), "v"(b), "v"(c)); return r; }
__device__ __forceinline__ float max2f(float a, float b) { float r; asm("v_max_f32_e32 %0, %1, %2" : "=v"(r) : "v"(a), "v"(b)); return r; }
__device__ __forceinline__ float xmax16(float v) { auto r = __builtin_amdgcn_permlane16_swap(__float_as_uint(v), __float_as_uint(v), false, false); return max2f(__uint_as_float(r[0]), __uint_as_float(r[1])); }
__device__ __forceinline__ float xmax32(float v) { auto r = __builtin_amdgcn_permlane32_swap(__float_as_uint(v), __float_as_uint(v), false, false); return max2f(__uint_as_float(r[0]), __uint_as_float(r[1])); }
__device__ __forceinline__ float xsum16(float v) { auto r = __builtin_amdgcn_permlane16_swap(__float_as_uint(v), __float_as_uint(v), false, false); return __uint_as_float(r[0]) + __uint_as_float(r[1]); }
__device__ __forceinline__ float xsum32(float v) { auto r = __builtin_amdgcn_permlane32_swap(__float_as_uint(v), __float_as_uint(v), false, false); return __uint_as_float(r[0]) + __uint_as_float(r[1]); }
__device__ __forceinline__ void glds16(const void* gsrc, unsigned lds_dst) { unsigned keep;
  asm volatile("s_mov_b32 %0, m0\n\ts_mov_b32 m0, %2\n\ts_nop 0\n\tglobal_load_lds_dwordx4 %1, off\n\ts_mov_b32 m0, %0" : "=&s"(keep) : "v"(gsrc), "s"(lds_dst) : "memory"); }
#define ATT_WAIT_BAR(N) asm volatile("s_waitcnt vmcnt(" #N ") lgkmcnt(0)\n\ts_barrier" ::: "memory")

__device__ __forceinline__ void attn_unit(const unsigned char* __restrict__ Qb, const unsigned char* __restrict__ Kh, const unsigned char* __restrict__ Vth, unsigned char* __restrict__ Ob, ATT_LAS unsigned char* lds) {
  int tid_l = threadIdx.x; asm volatile("" : "+v"(tid_l));
  const int tid = tid_l, wid = __builtin_amdgcn_readfirstlane(tid >> 6), lane = tid & 63, n16 = lane & 15, g = lane >> 4;
  ATT_LAS float* scr = (ATT_LAS float*)(lds + OFF_SCR) + wid * 64; ATT_LAS float* li_l = scr; ATT_LAS float* al_l = scr + 32;
  const unsigned ldsb = (unsigned)(uintptr_t)lds;
  float l_reg[2] = {0.f, 0.f}; f32x4a negm[2] = {(f32x4a){0.f, 0.f, 0.f, 0.f}, (f32x4a){0.f, 0.f, 0.f, 0.f}};
  f32x4a o[2][8];
#pragma unroll
  for (int qt = 0; qt < 2; ++qt)
#pragma unroll
    for (int c = 0; c < 8; ++c) o[qt][c] = (f32x4a){0.f, 0.f, 0.f, 0.f};
  u32x4 qr[2][3];
#pragma unroll
  for (int qt = 0; qt < 2; ++qt) { const unsigned char* Qw = Qb + (size_t)(wid * 32 + 16 * qt + n16) * LDQ + 16 * g;
#pragma unroll
    for (int sp = 0; sp < 3; ++sp) qr[qt][sp] = *(const u32x4*)(Qw + 64 * sp); }
  const int kb = 1024 * (n16 >> 2) + 64 * (n16 & 3) + 16 * (g ^ (n16 >> 2));
  const int vb = 64 * n16 + 16 * (g ^ (n16 >> 2));
  int kgo[2], vgo;
#pragma unroll
  for (int i = 0; i < 2; ++i) { const int p = wid + 8 * i, sp = p >> 2, r = 16 * (p & 3) + (lane >> 2), c = (lane & 3) ^ (p & 3); kgo[i] = r * LDK + 64 * sp + 16 * c; }
  { const int r = 16 * wid + (lane >> 2), c = (lane & 3) ^ ((lane >> 4) & 3); vgo = r * LDVT + 16 * c; }
#define ATT_ISSUE_K(kt, slot, two) do { const unsigned char* kp_ = Kh + (size_t)(kt) * (64 * LDK); const unsigned d_ = ldsb + OFF_K + (unsigned)(slot) * K_SLOT + (unsigned)wid * 1024u; \
    glds16(kp_ + kgo[0], d_); if (two) glds16(kp_ + kgo[1], d_ + 8192u); } while (0)
#define ATT_ISSUE_V(vt, slot) do { const unsigned char* vp_ = Vth + (size_t)(vt) * 64; const unsigned d_ = ldsb + OFF_V + (unsigned)(slot) * V_SLOT + (unsigned)wid * 1024u; \
    glds16(vp_ + vgo, d_); } while (0)
#define ATT_TOP_A(s, ks2) do { if ((s) < NT - 1) ATT_WAIT_BAR(3); else ATT_WAIT_BAR(0); \
    if ((s) + 2 < NT) { ATT_ISSUE_K((s) + 2, ks2, true); ATT_ISSUE_V((s) + 2, ((s) + 2) & 3); } } while (0)
#define ATT_TOP_B(s, ks2) do { if ((s) < NT - 1) ATT_WAIT_BAR(2); else ATT_WAIT_BAR(0); \
    if ((s) + 2 < NT) { ATT_ISSUE_K((s) + 2, ks2, false); ATT_ISSUE_V((s) + 2, ((s) + 2) & 3); } } while (0)
#define ATT_KLD(kslot, sp, kt) (*(const ATT_LAS u32x4*)((kslot) + kb + 4096 * (sp) + 512 * ((kt) >> 1) + 256 * ((kt) & 1)))
#define ATT_QKT(kslot_) do { const ATT_LAS unsigned char* ksl_ = (kslot_); u32x4 kf[2][4]; \
    _Pragma("unroll") for (int kt = 0; kt < 4; ++kt) { S[kt][0] = negm[0]; S[kt][1] = negm[1]; kf[0][kt] = ATT_KLD(ksl_, 0, kt); } \
    ATT_SBAR(); \
    _Pragma("unroll") for (int sp = 0; sp < 3; ++sp) { \
      if (sp + 1 < 3) { _Pragma("unroll") for (int kt = 0; kt < 4; ++kt) kf[(sp + 1) & 1][kt] = ATT_KLD(ksl_, sp + 1, kt); } \
      ATT_SBAR(); \
      _Pragma("unroll") for (int kt = 0; kt < 4; ++kt) { \
        S[kt][0] = mfma8(kf[sp & 1][kt].x, kf[sp & 1][kt].y, qr[0][sp].x, qr[0][sp].y, S[kt][0]); \
        S[kt][1] = mfma8(kf[sp & 1][kt].x, kf[sp & 1][kt].y, qr[1][sp].x, qr[1][sp].y, S[kt][1]); } \
      _Pragma("unroll") for (int kt = 0; kt < 4; ++kt) { \
        S[kt][0] = mfma8(kf[sp & 1][kt].z, kf[sp & 1][kt].w, qr[0][sp].z, qr[0][sp].w, S[kt][0]); \
        S[kt][1] = mfma8(kf[sp & 1][kt].z, kf[sp & 1][kt].w, qr[1][sp].z, qr[1][sp].w, S[kt][1]); } \
      ATT_SBAR(); } } while (0)
#define ATT_VLD(vslot_, c) (*(const ATT_LAS u32x4*)((vslot_) + vb + 1024 * (c)))
#define ATT_SOFTMAX_PV(vslot_, first_) do { const ATT_LAS unsigned char* vsl_ = (vslot_); float al_[2] = {1.f, 1.f}; u32x2 pa[2][2]; float ps_[2]; \
    u32x4 vf[8];     \
    _Pragma("unroll") for (int c = 0; c < 8; ++c) vf[c] = ATT_VLD(vsl_, c); \
    ATT_SBAR(); \
    _Pragma("unroll") for (int qt = 0; qt < 2; ++qt) { float ps = 0.f; \
      _Pragma("unroll") for (int kt = 0; kt < 4; ++kt) _Pragma("unroll") for (int i = 0; i < 4; ++i) { const float e = __builtin_amdgcn_exp2f(S[kt][qt][i]); S[kt][qt][i] = e; ps += e; } \
      ps_[qt] = xsum32(xsum16(ps)); } \
      \
    const bool keepw_ = !(first_) && __all(ps_[0] <= BND && ps_[1] <= BND); \
    if (!keepw_) {     \
      _Pragma("unroll") for (int qt = 0; qt < 2; ++qt) { float pm = max3f(S[0][qt][0], S[0][qt][1], S[0][qt][2]); pm = max3f(pm, S[0][qt][3], S[1][qt][0]); \
        pm = max3f(pm, S[1][qt][1], S[1][qt][2]); pm = max3f(pm, S[1][qt][3], S[2][qt][0]); pm = max3f(pm, S[2][qt][1], S[2][qt][2]); pm = max3f(pm, S[2][qt][3], S[3][qt][0]); \
        pm = max3f(pm, S[3][qt][1], S[3][qt][2]); pm = max2f(pm, S[3][qt][3]); pm = xmax32(xmax16(pm)); \
        float d = max2f(__builtin_amdgcn_logf(pm) - SH0, __builtin_amdgcn_logf(ps_[qt]) - SHS); if (!(first_)) d = max2f(d, 0.f); \
        al_[qt] = __builtin_amdgcn_exp2f(-d); negm[qt] -= d; ps_[qt] *= al_[qt]; \
        _Pragma("unroll") for (int kt = 0; kt < 4; ++kt) S[kt][qt] *= al_[qt]; } \
      if (g == 0) { al_l[n16] = al_[0]; al_l[16 + n16] = al_[1]; } asm volatile("s_waitcnt lgkmcnt(0)" ::: "memory"); \
      _Pragma("unroll") for (int qt = 0; qt < 2; ++qt) { const f32x4a av = *(const ATT_LAS f32x4a*)(al_l + 16 * qt + 4 * g); \
        _Pragma("unroll") for (int c = 0; c < 8; ++c) o[qt][c] *= av; } } \
    _Pragma("unroll") for (int qt = 0; qt < 2; ++qt) { l_reg[qt] = l_reg[qt] * al_[qt] + ps_[qt]; \
      _Pragma("unroll") for (int t = 0; t < 2; ++t) { pa[qt][t].x = pk4f8(S[2 * t][qt][0], S[2 * t][qt][1], S[2 * t][qt][2], S[2 * t][qt][3]); \
        pa[qt][t].y = pk4f8(S[2 * t + 1][qt][0], S[2 * t + 1][qt][1], S[2 * t + 1][qt][2], S[2 * t + 1][qt][3]); } } \
    ATT_SBAR(); \
    _Pragma("unroll") for (int gq = 0; gq < 2; ++gq) { \
      _Pragma("unroll") for (int c = 0; c < 4; ++c) { \
        o[0][4 * gq + c] = mfma8(pa[0][0].x, pa[0][0].y, vf[4 * gq + c].x, vf[4 * gq + c].y, o[0][4 * gq + c]); \
        o[1][4 * gq + c] = mfma8(pa[1][0].x, pa[1][0].y, vf[4 * gq + c].x, vf[4 * gq + c].y, o[1][4 * gq + c]); } \
      _Pragma("unroll") for (int c = 0; c < 4; ++c) { \
        o[0][4 * gq + c] = mfma8(pa[0][1].x, pa[0][1].y, vf[4 * gq + c].z, vf[4 * gq + c].w, o[0][4 * gq + c]); \
        o[1][4 * gq + c] = mfma8(pa[1][1].x, pa[1][1].y, vf[4 * gq + c].z, vf[4 * gq + c].w, o[1][4 * gq + c]); } } \
    ATT_SBAR(); } while (0)
  constexpr int NT = SEQ / 64;
  f32x4a S[4][2];
  if (wid < 4) { ATT_ISSUE_K(0, 0, true); ATT_ISSUE_V(0, 0); ATT_ISSUE_K(1, 1, true); ATT_ISSUE_V(1, 1); }
  else { ATT_ISSUE_K(0, 0, false); ATT_ISSUE_V(0, 0); ATT_ISSUE_K(1, 1, false); ATT_ISSUE_V(1, 1); }
  asm volatile("" : "+v"(qr[0][0]), "+v"(qr[0][1]), "+v"(qr[0][2]), "+v"(qr[1][0]), "+v"(qr[1][1]), "+v"(qr[1][2]));
  if (wid < 4) {
    int ks = 0;
    for (int s = 0; s < NT; ++s) {
      const int ks2 = ks == 0 ? 2 : ks - 1;
      ATT_TOP_A(s, ks2);
      ATT_QKT(lds + OFF_K + ks * K_SLOT);
      ATT_SOFTMAX_PV(lds + OFF_V + (s & 3) * V_SLOT, s == 0);
      ks = ks == 2 ? 0 : ks + 1;
    }
    ATT_WAIT_BAR(0);
  } else {
    __builtin_amdgcn_s_setprio(1);
    ATT_TOP_B(0, 2);
    ATT_QKT(lds + OFF_K);
    int ks = 1;
    for (int s = 1; s < NT; ++s) {
      const int ks2 = ks == 0 ? 2 : ks - 1;
      ATT_TOP_B(s, ks2);
      ATT_SOFTMAX_PV(lds + OFF_V + ((s - 1) & 3) * V_SLOT, s == 1);
      ATT_QKT(lds + OFF_K + ks * K_SLOT);
      ks = ks == 2 ? 0 : ks + 1;
    }
    ATT_WAIT_BAR(0);
    ATT_SOFTMAX_PV(lds + OFF_V + ((NT - 1) & 3) * V_SLOT, false);
    __builtin_amdgcn_s_setprio(0);
  }
  if (g == 0) { li_l[n16] = l_reg[0]; li_l[16 + n16] = l_reg[1]; }
  asm volatile("s_waitcnt lgkmcnt(0)" ::: "memory");
#pragma unroll
  for (int qt = 0; qt < 2; ++qt) { const f32x4a lv = *(const ATT_LAS f32x4a*)(li_l + 16 * qt + 4 * g);
    unsigned char* Ow = Ob + (size_t)(wid * 32 + 16 * qt + 4 * g) * LDO + n16;
#pragma unroll
    for (int i = 0; i < 4; ++i) { const float rl = __builtin_amdgcn_rcpf(lv[i]) * OSCALE;
#pragma unroll
      for (int c = 0; c < 8; ++c) { const float v = o[qt][c][i] * rl; Ow[(size_t)i * LDO + 16 * c] = (unsigned char)(__builtin_amdgcn_cvt_pk_fp8_f32(v, v, 0, false) & 0xff); } } }
  ATT_WAIT_BAR(0);
#undef ATT_ISSUE_K
#undef ATT_ISSUE_V
#undef ATT_TOP_A
#undef ATT_TOP_B
#undef ATT_KLD
#undef ATT_QKT
#undef ATT_VLD
#undef ATT_SOFTMAX_PV
}
}

constexpr int NWAVES = 8;
constexpr int M = 24576, DM = 4096, SEQ = 8192, NSEQ = 3, MP = 16384;
constexpr int DFF = 11008, NUP = 22016, NIN = 12032;
constexpr float RMS_EPS = 1e-6f;
constexpr size_t MiB = 1u << 20;
constexpr size_t WS_CTL = 0, CTL_ZERO_BYTES = 1 * MiB;
constexpr size_t WS_DYNCTR = 64 * 1024;
constexpr size_t WS_ROWSS = 128 * 1024;
constexpr size_t WS_ROPE = 1 * MiB;
constexpr size_t WS_BPOOL = 4 * MiB, WS_BUQ = 6 * MiB, WS_BUKV = 12 * MiB, WS_BBP = 16 * MiB, WS_BBM = 32 * MiB, WS_BO = 1316 * MiB, WS_BIN = 80 * MiB;
constexpr size_t WS_BINB = 128 * MiB, WS_H8 = 932 * MiB;
constexpr size_t WS_CKV8 = 64 * MiB, WS_CQ8 = 512 * MiB, WS_ZAP = 1220 * MiB, WS_ROWKV = 256 * 1024;
constexpr size_t WS_WP = 48 * MiB;
constexpr size_t WS_Q8 = 80 * MiB, WS_K8 = 932 * MiB, WS_VT8 = 308 * MiB;
constexpr size_t WS_A = 176 * MiB;
constexpr size_t WS_B = 368 * MiB;
constexpr size_t WS_ZK = 536 * MiB;
constexpr size_t WS_ZG = 548 * MiB;
constexpr size_t WS_AO = 932 * MiB;
constexpr size_t WS_F = 1028 * MiB;
constexpr size_t WS_BOUT = 1220 * MiB;
constexpr size_t WS_END1 = 1316 * MiB;
constexpr size_t WS_BUP = 4 * MiB, WS_BDOWN = 176 * MiB, WS_H2 = 262 * MiB, WS_ACT = 454 * MiB, WS_SIDE = 970 * MiB, WS_END2 = 1036 * MiB;
constexpr size_t WS_NEED = 1348 * MiB;
constexpr int CW_TMO = 0, CW_CODE = 1, CW_BAR = 4096;
constexpr int RING_OFF = 0, RING_BYTES = 131072;
constexpr int CONVSCR_OFF = RING_BYTES;
constexpr int LDSCTL_OFF = CONVSCR_OFF + 16896, MISC_OFF = LDSCTL_OFF;
constexpr int LDS_BYTES = LDSCTL_OFF + 512;

#define GAS __attribute__((address_space(1)))
#define LAS __attribute__((address_space(3)))
typedef unsigned short bf16;
typedef unsigned v4u __attribute__((ext_vector_type(4)));
typedef unsigned v2u __attribute__((ext_vector_type(2)));
typedef float f32x4 __attribute__((ext_vector_type(4)));
typedef GAS unsigned gu32;
#define RLX_AGENT __ATOMIC_RELAXED, __HIP_MEMORY_SCOPE_AGENT
#define LDS_WAIT() asm volatile("s_waitcnt lgkmcnt(0)" ::: "memory")
#define VM_WAIT() asm volatile("s_waitcnt vmcnt(0)" ::: "memory")
__device__ __forceinline__ unsigned f2bf(float f) { unsigned u = __builtin_bit_cast(unsigned, f); return (u + 0x7fffu + ((u >> 16) & 1u)) >> 16; }
__device__ __forceinline__ unsigned pk2(float lo, float hi) { return f2bf(lo) | (f2bf(hi) << 16); }
__device__ __forceinline__ float bflo(unsigned w) { return __uint_as_float(w << 16); }
__device__ __forceinline__ float bfhi(unsigned w) { return __uint_as_float(w & 0xffff0000u); }
__device__ __forceinline__ void unpack8(const v4u w, float (&v)[8]) { v[0] = bflo(w.x); v[1] = bfhi(w.x); v[2] = bflo(w.y); v[3] = bfhi(w.y); v[4] = bflo(w.z); v[5] = bfhi(w.z); v[6] = bflo(w.w); v[7] = bfhi(w.w); }
__device__ __forceinline__ v4u pack8(const float (&v)[8]) { v4u w; w.x = pk2(v[0], v[1]); w.y = pk2(v[2], v[3]); w.z = pk2(v[4], v[5]); w.w = pk2(v[6], v[7]); return w; }
#define XB_TMO      128
#define XB_XCNT(j)  (256  + 64 * (j))
#define XB_XSUB(j)  (1280 + 64 * (j))
#define XB_XGEN(j)  (2304 + 64 * (j))
#define XB_TOP      3328
#define XB_TOPGEN   3392
#define XCD_BAR_WORDS 3456
#define XB_SPIN_CAP (1u << 18)

__device__ __forceinline__ unsigned xb_ld(unsigned* p)              { return __hip_atomic_load(p, __ATOMIC_RELAXED, __HIP_MEMORY_SCOPE_AGENT); }
__device__ __forceinline__ unsigned xb_add(unsigned* p, unsigned v) { return __hip_atomic_fetch_add(p, v, __ATOMIC_RELAXED, __HIP_MEMORY_SCOPE_AGENT); }
__device__ __forceinline__ unsigned xb_xcc_id() { return (unsigned)__builtin_amdgcn_s_getreg((3 << 11) | 20) & 0xFu; }
#define XB_SPIN(cond, bar) do { unsigned _sp = 0; while (cond) { __builtin_amdgcn_s_sleep(1); \
    if ((++_sp & 255u) == 0u) { if (xb_ld(&(bar)[XB_TMO])) break; if (_sp > XB_SPIN_CAP) { atomicAdd(&(bar)[XB_TMO], 1u); break; } } } } while (0)

struct XcdBarrier {
    unsigned* bar; unsigned x;
    volatile LAS unsigned* st;
};

__device__ __forceinline__ XcdBarrier xcd_barrier_post(unsigned* bar, volatile LAS unsigned* st) {
    XcdBarrier b; b.bar = bar; b.x = xb_xcc_id(); b.st = st;
    if (threadIdx.x == 0) (void)xb_add(&bar[XB_XCNT(b.x)], 1u);
    return b;
}
__device__ __forceinline__ void xcd_barrier_complete(unsigned* bar, unsigned x, unsigned& nloc, unsigned& nx) {
    const unsigned G = gridDim.x * gridDim.y * gridDim.z;
    unsigned sum, cnt, mine, sp = 0u;
    for (;;) {
        sum = 0u; cnt = 0u; mine = 0u;
#pragma unroll
        for (unsigned j = 0; j < 16; ++j) { const unsigned c = xb_ld(&bar[XB_XCNT(j)]); sum += c; cnt += (c > 0u) ? 1u : 0u; mine = (j == x) ? c : mine; }
        if (sum == G) break;
        __builtin_amdgcn_s_sleep(1);
        if ((++sp & 255u) == 0u) { if (xb_ld(&bar[XB_TMO])) break; if (sp > XB_SPIN_CAP) { atomicAdd(&bar[XB_TMO], 1u); break; } }
    }
    nloc = mine > 0u ? mine : 1u; nx = cnt > 0u ? cnt : 1u;
}

__device__ __forceinline__ void xcd_barrier(const XcdBarrier& b) {
    asm volatile("s_waitcnt vmcnt(0)" ::: "memory");
    __syncthreads();
    if (threadIdx.x == 0) {
        unsigned* bar = b.bar;
        __builtin_amdgcn_s_waitcnt(0);
        unsigned nloc = b.st[0], nx = b.st[1];
        if (nloc == 0u) { xcd_barrier_complete(bar, b.x, nloc, nx); b.st[0] = nloc; b.st[1] = nx; }
        const unsigned old = xb_add(&bar[XB_XSUB(b.x)], 1u);
        const unsigned gen = old / nloc;
        if (old + 1u == (gen + 1u) * nloc) {
            __builtin_amdgcn_fence(__ATOMIC_RELEASE, "agent");
            asm volatile("s_waitcnt vmcnt(0)" ::: "memory");
            const unsigned og = xb_add(&bar[XB_TOP], 1u);
            const unsigned tg = og / nx;
            if (og + 1u == (tg + 1u) * nx) xb_add(&bar[XB_TOPGEN], 1u);
            else XB_SPIN(xb_ld(&bar[XB_TOPGEN]) == tg, bar);
            __builtin_amdgcn_fence(__ATOMIC_ACQUIRE, "agent");
            xb_add(&bar[XB_XGEN(b.x)], 1u);
            asm volatile("s_waitcnt vmcnt(0)" ::: "memory");
        } else {
            XB_SPIN(xb_ld(&bar[XB_XGEN(b.x)]) == gen, bar);
            __builtin_amdgcn_fence(__ATOMIC_ACQUIRE, "agent");
            asm volatile("s_waitcnt vmcnt(0)" ::: "memory");
        }
    }
    __syncthreads();
}

__device__ __forceinline__ float wave_sum(float v) {
#pragma unroll
    for (int o = 1; o < 64; o <<= 1) v += __shfl_xor(v, o);
    return v;
}
__device__ __forceinline__ void tr_item(const float* W, int N, bf16* WT, int ldt, int k0, int n0, int drow0, LAS float* scr, int lane, const float* kscale = nullptr) {
#pragma unroll 8
    for (int i = 0; i < 32; ++i) { const int kk = 2 * i + (lane >> 5); scr[kk * 33 + (lane & 31)] = W[(size_t)(k0 + kk) * N + n0 + (lane & 31)]; }
    LDS_WAIT(); asm volatile("" ::: "memory");
    const int c = lane & 7;
    f32x4 g0 = {1.f, 1.f, 1.f, 1.f}, g1 = g0;
    if (kscale) { g0 = *(const GAS f32x4*)(kscale + k0 + 8 * c); g1 = *(const GAS f32x4*)(kscale + k0 + 8 * c + 4); }
#pragma unroll
    for (int j = 0; j < 4; ++j) { const int n = (lane >> 3) + 8 * j; const LAS float* s = scr + (8 * c) * 33 + n;
        v4u o; o.x = pk2(s[0 * 33] * g0.x, s[1 * 33] * g0.y); o.y = pk2(s[2 * 33] * g0.z, s[3 * 33] * g0.w); o.z = pk2(s[4 * 33] * g1.x, s[5 * 33] * g1.y); o.w = pk2(s[6 * 33] * g1.z, s[7 * 33] * g1.w);
        *(GAS v4u*)(WT + (size_t)(drow0 + n) * ldt + k0 + 8 * c) = o; }
    LDS_WAIT(); asm volatile("" ::: "memory");
}
__device__ __forceinline__ void tr_item8(const float* W, int N, unsigned char* WT8, int ldt, int k0, int n0, int drow0, LAS float* scr, int lane, float sc, const float* kscale = nullptr) {
#pragma unroll 8
    for (int i = 0; i < 32; ++i) { const int kk = 2 * i + (lane >> 5); scr[kk * 33 + (lane & 31)] = W[(size_t)(k0 + kk) * N + n0 + (lane & 31)]; }
    LDS_WAIT(); asm volatile("" ::: "memory");
    const int c = lane & 7;
    f32x4 g0 = {sc, sc, sc, sc}, g1 = g0;
    if (kscale) { g0 = *(const GAS f32x4*)(kscale + k0 + 8 * c) * sc; g1 = *(const GAS f32x4*)(kscale + k0 + 8 * c + 4) * sc; }
#pragma unroll
    for (int j = 0; j < 4; ++j) { const int n = (lane >> 3) + 8 * j; const LAS float* s = scr + (8 * c) * 33 + n;
        int a = __builtin_amdgcn_cvt_pk_fp8_f32(s[0 * 33] * g0.x, s[1 * 33] * g0.y, 0, false); a = __builtin_amdgcn_cvt_pk_fp8_f32(s[2 * 33] * g0.z, s[3 * 33] * g0.w, a, true);
        int b = __builtin_amdgcn_cvt_pk_fp8_f32(s[4 * 33] * g1.x, s[5 * 33] * g1.y, 0, false); b = __builtin_amdgcn_cvt_pk_fp8_f32(s[6 * 33] * g1.z, s[7 * 33] * g1.w, b, true);
        v2u o; o.x = (unsigned)a; o.y = (unsigned)b;
        *(GAS v2u*)(WT8 + (size_t)(drow0 + n) * ldt + k0 + 8 * c) = o; }
    LDS_WAIT(); asm volatile("" ::: "memory");
}
__device__ __forceinline__ void rms_row_4096(const float* xrow, const float* gain, bf16* orow, unsigned char* orow8, int lane) {
    const GAS f32x4* xr = (const GAS f32x4*)xrow + lane; const GAS f32x4* gr = (const GAS f32x4*)gain + lane;
    f32x4 v[16]; float s = 0.f;
#pragma unroll
    for (int j = 0; j < 16; ++j) { v[j] = xr[64 * j]; s += (v[j].x * v[j].x + v[j].y * v[j].y) + (v[j].z * v[j].z + v[j].w * v[j].w); }
    const float r = 1.0f / sqrtf(wave_sum(s) * (1.f / 4096.f) + RMS_EPS);
    GAS v2u* o8 = (GAS v2u*)orow + lane;
    GAS unsigned* o4 = (GAS unsigned*)orow8 + lane;
#pragma unroll
    for (int j = 0; j < 16; ++j) { const f32x4 g = gr[64 * j]; const float a = v[j].x * r * g.x, b = v[j].y * r * g.y, c = v[j].z * r * g.z, d = v[j].w * r * g.w;
        v2u w; w.x = pk2(a, b); w.y = pk2(c, d); o8[64 * j] = w;
        int q = __builtin_amdgcn_cvt_pk_fp8_f32(a, b, 0, false); q = __builtin_amdgcn_cvt_pk_fp8_f32(c, d, q, true); o4[64 * j] = (unsigned)q; }
}
__device__ __forceinline__ void sincos_d(double a, double& s, double& c) {
    const double TWO_PI = 6.283185307179586476925286766559;
    const double n = __builtin_rint(a / TWO_PI); const double x = a - n * TWO_PI;
    const double x2 = x * x; double ts = 1.0, tc = 1.0; double ss = 1.0, cs = 1.0;
#pragma unroll
    for (int k = 1; k <= 14; ++k) { tc *= -x2 / (double)((2 * k - 1) * (2 * k)); cs += tc; ts *= -x2 / (double)((2 * k) * (2 * k + 1)); ss += ts; }
    s = x * ss; c = cs;
}

__device__ __forceinline__ v2u pack8_f8(const float (&v)[8], float sc) {
    int a = __builtin_amdgcn_cvt_pk_fp8_f32(v[0] * sc, v[1] * sc, 0, false); a = __builtin_amdgcn_cvt_pk_fp8_f32(v[2] * sc, v[3] * sc, a, true);
    int b = __builtin_amdgcn_cvt_pk_fp8_f32(v[4] * sc, v[5] * sc, 0, false); b = __builtin_amdgcn_cvt_pk_fp8_f32(v[6] * sc, v[7] * sc, b, true);
    v2u w; w.x = (unsigned)a; w.y = (unsigned)b; return w;
}
__device__ __forceinline__ unsigned pk4_f8(float a, float b, float c, float d) { int w = __builtin_amdgcn_cvt_pk_fp8_f32(a, b, 0, false); w = __builtin_amdgcn_cvt_pk_fp8_f32(c, d, w, true); return (unsigned)w; }

#ifndef PHM
#define PHM 0x3ff
#endif
typedef const __attribute__((address_space(4))) unsigned char* kptr_t;
__device__ __forceinline__ kptr_t karg() { kptr_t p = (kptr_t)__builtin_amdgcn_kernarg_segment_ptr(); asm volatile("" : "+s"(p)); return p; }
#define KIN(i) (*(const float* const __attribute__((address_space(4)))*)(kp + 8 * (i)))
#define KOUT() (*(float* const __attribute__((address_space(4)))*)(kp + 8 * 20))
#define KWS() (*(unsigned char* const __attribute__((address_space(4)))*)(kp + 8 * 21))
struct Args { const float* in[20]; float* out; unsigned char* ws; };
__global__ void __launch_bounds__(NWAVES * 64, 2) fwd_kernel(Args args) {
    extern __shared__ __attribute__((aligned(16))) unsigned char lds_raw[];
    LAS unsigned char* lds = (LAS unsigned char*)lds_raw;
    volatile LAS unsigned* MISC = (volatile LAS unsigned*)(lds + MISC_OFF);
    const int tid = threadIdx.x;
    const int G = gridDim.x, bx = blockIdx.x;
    const int vcu = (G % 8 == 0) ? (bx % 8) * (G / 8) + bx / 8 : bx;
    gu32* ctl = (gu32*)(args.ws + WS_CTL);
    for (int u = tid; u < (LDS_BYTES - LDSCTL_OFF) / 4; u += NWAVES * 64) ((LAS unsigned*)(lds + LDSCTL_OFF))[u] = 0u;
    __syncthreads();
    XcdBarrier bar = xcd_barrier_post((unsigned*)(ctl + CW_BAR), MISC + 8);
#if defined(PROBE_BAR_BX)
#define GRID_BAR() do { const unsigned long long tb0_ = __builtin_amdgcn_s_memrealtime(); xcd_barrier(bar); if ((int)blockIdx.x == (PROBE_BAR_BX) && threadIdx.x == 0) MISC[31] = MISC[31] + (unsigned)(__builtin_amdgcn_s_memrealtime() - tb0_); } while (0)
#else
#define GRID_BAR() xcd_barrier(bar)
#endif
#if defined(PROBE_A)
#if defined(PROBE_CLK_A)
#define STAMP(k) do { if (bx == 0 && tid == 0) { MISC[16 + (k)] = (unsigned)__builtin_amdgcn_s_memrealtime(); if ((k) == PROBE_CLK_A) MISC[12] = (unsigned)__builtin_amdgcn_s_memtime(); if ((k) == PROBE_CLK_B) MISC[13] = (unsigned)__builtin_amdgcn_s_memtime(); } } while (0)
#else
#define STAMP(k) do { if (bx == 0 && tid == 0) MISC[16 + (k)] = (unsigned)__builtin_amdgcn_s_memrealtime(); } while (0)
#endif
#else
#define STAMP(k) do { } while (0)
#endif
    STAMP(0);
    const int NGW = G * NWAVES, NGT = G * NWAVES * 64;
#define PHASE_IDS() int tidp_ = threadIdx.x; asm volatile("" : "+v"(tidp_)); const int lane = tidp_ & 63, wavep_ = __builtin_amdgcn_readfirstlane(tidp_ >> 6); \
    const int gw = vcu * NWAVES + wavep_, gt = vcu * (NWAVES * 64) + tidp_; LAS float* scr = (LAS float*)(lds + RING_OFF + wavep_ * 16384); (void)gw; (void)gt; (void)scr; (void)lane

#if (PHM >> 0) & 1
    {
        PHASE_IDS();
        kptr_t kp = karg(); unsigned char* ws = KWS();
        const float* x_prompt = KIN(0); const float* x_sample = KIN(1); const float* norm_mix_gain = KIN(2); const float* w_in = KIN(3); const float* pool_w = KIN(4);
        const float* w_uq = KIN(7); const float* w_ukv = KIN(9); const float* w_bp = KIN(12); const float* w_bm = KIN(13); const float* w_o = KIN(14);
        float* ropec = (float*)(ws + WS_ROPE); float* ropes = ropec + SEQ * 32;
        bf16* Bpool = (bf16*)(ws + WS_BPOOL); bf16* Buq = (bf16*)(ws + WS_BUQ); bf16* Bukv = (bf16*)(ws + WS_BUKV); bf16* Bbp = (bf16*)(ws + WS_BBP);
        bf16* Bbm = (bf16*)(ws + WS_BBM); bf16* Bo = (bf16*)(ws + WS_BO); bf16* Bin = (bf16*)(ws + WS_BIN); unsigned char* BinB = ws + WS_BINB; bf16* Hb = (bf16*)(ws + WS_A); unsigned char* H8 = ws + WS_H8;
        constexpr int I_POOL = 0, I_UQ = 1536, I_UKV = 1024, I_BP = 4096, I_BM = 4096, I_O = 8192, I_IN = 23680;
        constexpr int NITEMS = I_POOL + I_UQ + I_UKV + I_BP + I_BM + I_O + I_IN;
        for (int it = gw; it < NITEMS; it += NGW) {
            int r = it;
            if (r < I_POOL) { const int g = r >> 7, q = r & 127; tr_item(pool_w + (size_t)g * 512 * 512, 512, Bpool, 512, 64 * (q >> 4), 32 * (q & 15), g * 512 + 32 * (q & 15), scr, lane); continue; } r -= I_POOL;
            if (r < I_UQ) { tr_item8(w_uq, 3072, (unsigned char*)Buq, 1024, 64 * (r / 96), 32 * (r % 96), 32 * (r % 96), scr, lane, 32.f, KIN(6)); continue; } r -= I_UQ;
            if (r < I_UKV) { tr_item8(w_ukv, 4096, (unsigned char*)Bukv, 512, 64 * (r / 128), 32 * (r % 128), 32 * (r % 128), scr, lane, 16.f, KIN(8)); continue; } r -= I_UKV;
            if (r < I_BP) { tr_item(w_bp, 4096, Bbp, 2048, 64 * (r / 128), 32 * (r % 128), 32 * (r % 128), scr, lane); continue; } r -= I_BP;
            if (r < I_BM) { tr_item8(w_bm, 4096, (unsigned char*)Bbm, 2048, 64 * (r / 128), 32 * (r % 128), 32 * (r % 128), scr, lane, 32.f); continue; } r -= I_BM;
            if (r < I_O) { tr_item(w_o, 4096, Bo, 4096, 64 * (r / 128), 32 * (r % 128), 32 * (r % 128), scr, lane); continue; } r -= I_O;
            { const int n0 = 32 * (r % 370), k0 = 64 * (r / 370);
              if (n0 < 2048) tr_item(w_in, 11840, Bin, 4096, k0, n0, n0, scr, lane);
              else { const int drow = (n0 < 3072) ? n0 - 2048 : (n0 < 3584) ? 1024 + (n0 - 3072) : (n0 < 3648) ? 5632 + (n0 - 3584) : (n0 < 7744) ? 5888 + (n0 - 3648) : 1536 + (n0 - 7744);
                     tr_item8(w_in, 11840, BinB, 4096, k0, n0, drow, scr, lane, 64.f); } }
        }
        { const float* pool_scale = KIN(5);
          for (int i = gt; i < 4 * 512 * 512 / 8; i += NGT) { const int e = i * 8, g = e >> 18, d = e & 511;
            const GAS f32x4* wp = (const GAS f32x4*)(pool_w + e); const GAS f32x4* sp = (const GAS f32x4*)(pool_scale + g * 512 + d);
            const f32x4 w0 = wp[0], w1 = wp[1], s0 = sp[0], s1 = sp[1];
            float o[8] = {w0.x * s0.x, w0.y * s0.y, w0.z * s0.z, w0.w * s0.w, w1.x * s1.x, w1.y * s1.y, w1.z * s1.z, w1.w * s1.w};
            *(GAS v4u*)(Bpool + e) = pack8(o); } }
        { GAS v4u* z = (GAS v4u*)(BinB + (size_t)5696 * 4096); const v4u zero = {0u, 0u, 0u, 0u};
          for (int i = gt; i < 192 * 4096 / 16; i += NGT) z[i] = zero; }
        for (int i = gt; i < SEQ * 32; i += NGT) { const int t = i >> 5, f = i & 31;
            const float inv = 1.0f / (float)exp2(13.287712379549449 * ((double)(2 * f) / 64.0));
            const float ang = (float)t * inv; double s, c; sincos_d((double)ang, s, c); ropec[i] = (float)c; ropes[i] = (float)s; }
        for (int m = gw; m < M; m += NGW) { const float* xr = (m < MP) ? x_prompt + (size_t)m * DM : x_sample + (size_t)(m - MP) * DM; rms_row_4096(xr, norm_mix_gain, Hb + (size_t)m * DM, H8 + (size_t)m * DM, lane); }
    }
    GRID_BAR();
#endif
    STAMP(1);
#if (PHM >> 1) & 1
    {
        kptr_t kp = karg(); unsigned char* ws = KWS();
        bf16* Hb = (bf16*)(ws + WS_A); bf16* Bin = (bf16*)(ws + WS_BIN); bf16* ZA = (bf16*)(ws + WS_ZAP); bf16* ZK = (bf16*)(ws + WS_ZK); bf16* ZG = (bf16*)(ws + WS_ZG);
        {
            pg8::Gemm g{Hb, Bin, M, 2048, DM}; pg8::StaticOrder S; S.init(M, 2048, G, bx);
            pg8::EpiZa E{ZA, ZG};
            pg8::gemm_phase<pg8::EpiZa, pg8::StaticOrder, true, true>(lds + RING_OFF, g, S, E);
        }
        {
            pg8::Gemm g{(const bf16*)(ws + WS_H8), (const bf16*)(ws + WS_BINB), M, 9984, DM / 2}; pg8::DynTailOrder S; S.init2(M, 9984, G, bx, (unsigned*)(ws + WS_DYNCTR), MISC + 4);
            pg8::EpiZb E{ws + WS_CQ8, ws + WS_CKV8, (float*)(ws + WS_ROWKV), ZG, ZK, 1.0f / 64.0f};
            pg8::gemm_phase<pg8::EpiZb, pg8::DynTailOrder, true, true, true>(lds + RING_OFF, g, S, E);
        }
    }
    GRID_BAR();
#endif
    STAMP(2);
#if (PHM >> 2) & 1
#endif
    STAMP(3);
#if (PHM >> 3) & 1
    {
        kptr_t kp = karg(); unsigned char* ws = KWS();
        bf16* CQN = (bf16*)(ws + WS_CQ8); bf16* CKVN = (bf16*)(ws + WS_CKV8);
        bf16* Bpool = (bf16*)(ws + WS_BPOOL); bf16* Buq = (bf16*)(ws + WS_BUQ); bf16* Bukv = (bf16*)(ws + WS_BUKV);
        bf16* Qb = (bf16*)(ws + WS_B); bf16* KN = (bf16*)(ws + WS_F); bf16* VH = (bf16*)(ws + WS_F + 96 * MiB);
    for (int gi = 0; gi < 4; ++gi) {
        pg8::Gemm g{(const bf16*)(ws + WS_BBP) + gi * 512, Bpool + (size_t)gi * 512 * 512, 4096, 512, 512, 2048}; pg8::StaticOrder S; S.init(4096, 512, G, (bx + 2 * G - 128 - 32 * gi) % G);
        pg8::EpiBf E{(bf16*)(ws + WS_WP) + gi * 512, 2048};
        pg8::gemm_phase<pg8::EpiBf, pg8::StaticOrder, true, true>(lds + RING_OFF, g, S, E);
    }
    {
        pg8::Gemm g{CQN, Buq, M, 3072, 512}; pg8::StaticOrder S; S.init(M, 3072, G, bx);
        pg8::EpiBf E{Qb, 3072};
        pg8::gemm_phase<pg8::EpiBf, pg8::StaticOrder, true, true, true>(lds + RING_OFF, g, S, E);
    }
    {
        pg8::Gemm g{CKVN, Bukv, M, 4096, 256}; pg8::StaticOrder S; S.init(M, 4096, G, bx);
        pg8::EpiKV8 E{KN, VH, 1.0f / 16.0f, (const float*)(ws + WS_ROWKV)};
        pg8::gemm_phase<pg8::EpiKV8, pg8::StaticOrder, true, true, true>(lds + RING_OFF, g, S, E);
    }
    }
    GRID_BAR();
#endif
    STAMP(4);
#if (PHM >> 4) & 1
    {
        PHASE_IDS();
        kptr_t kp = karg(); unsigned char* ws = KWS(); const float* q_gain = KIN(10); const float* k_gain = KIN(11);
        const float* ropec = (const float*)(ws + WS_ROPE); const float* ropes = ropec + SEQ * 32;
        bf16* Qb = (bf16*)(ws + WS_B); bf16* KN = (bf16*)(ws + WS_F); bf16* ZK = (bf16*)(ws + WS_ZK); const bf16* VH = (const bf16*)(ws + WS_F + 96 * MiB);
        unsigned char* Q8 = ws + WS_Q8; unsigned char* K8 = ws + WS_K8; unsigned char* Vt8 = ws + WS_VT8;
    { const bf16* ZAp = (const bf16*)(ws + WS_ZAP); bf16* PAp = (bf16*)(ws + WS_A);
    for (int task = gw; task < 4 * (M / 64); task += NGW) {
        const int g = task & 3, m0 = (task >> 2) * 64, t0 = m0 % SEQ, half = 1 << g;
        const bf16* zc = ZAp + (size_t)m0 * 2048 + g * 512 + lane * 8;
        bf16* pc = PAp + (size_t)m0 * 2048 + g * 512 + lane * 8;
        float sum[8] = {0.f, 0.f, 0.f, 0.f, 0.f, 0.f, 0.f, 0.f};
        for (int d = -half; d < half; ++d) { const int tt = t0 + d;
            if (tt >= 0 && tt < SEQ) { float v[8]; unpack8(*(const GAS v4u*)(zc + (ptrdiff_t)d * 2048), v);
#pragma unroll
                for (int j = 0; j < 8; ++j) sum[j] += v[j]; } }
#pragma unroll 4
        for (int i = 0; i < 64; ++i) {
            const int t = t0 + i, lo = (t - half < 0) ? 0 : t - half, hi = (t + half > SEQ) ? SEQ : t + half;
            const bool has_lead = (t + half < SEQ), has_trail = (t - half >= 0);
            const int il = has_lead ? i + half : i, it = has_trail ? i - half : i;
            const v4u ws_ = *(const GAS v4u*)(zc + (ptrdiff_t)i * 2048), wl = *(const GAS v4u*)(zc + (ptrdiff_t)il * 2048), wt = *(const GAS v4u*)(zc + (ptrdiff_t)it * 2048);
            float self[8], lead[8], trail[8], o[8]; unpack8(ws_, self); unpack8(wl, lead); unpack8(wt, trail);
            const float rc = 1.0f / (float)(hi - lo);
#pragma unroll
            for (int j = 0; j < 8; ++j) { o[j] = sum[j] * rc - self[j]; sum[j] += (has_lead ? lead[j] : 0.f) - (has_trail ? trail[j] : 0.f); }
            *(GAS v4u*)(pc + (size_t)i * 2048) = pack8(o);
        }
    }
    }
    for (int m = gw; m < M; m += NGW) {
        const int t = m % SEQ, h = lane >> 2, s4 = lane & 3;
        float cs[8], sn[8];
        { const GAS f32x4* cp = (const GAS f32x4*)(ropec + t * 32 + 8 * s4); const GAS f32x4* sp = (const GAS f32x4*)(ropes + t * 32 + 8 * s4);
          const f32x4 c0 = cp[0], c1 = cp[1], s0 = sp[0], s1 = sp[1];
#pragma unroll
          for (int j = 0; j < 4; ++j) { cs[j] = c0[j]; cs[4 + j] = c1[j]; sn[j] = s0[j]; sn[4 + j] = s1[j]; } }
#pragma unroll
        for (int which = 0; which < 2; ++which) {
            float v[6][8];
            const float* gain = which ? k_gain : q_gain;
            if (which == 0) { const bf16* qp = Qb + (size_t)m * 3072 + h * 192;
#pragma unroll
                for (int c = 0; c < 4; ++c) unpack8(*(const GAS v4u*)(qp + 32 * s4 + 8 * c), v[c]);
                unpack8(*(const GAS v4u*)(qp + 128 + 8 * s4), v[4]); unpack8(*(const GAS v4u*)(qp + 160 + 8 * s4), v[5]); }
            else { const bf16* kp = KN + (size_t)m * 2048 + h * 128; const bf16* rp = ZK + (size_t)m * 256;
#pragma unroll
                for (int c = 0; c < 4; ++c) unpack8(*(const GAS v4u*)(kp + 32 * s4 + 8 * c), v[c]);
                unpack8(*(const GAS v4u*)(rp + 8 * s4), v[4]); unpack8(*(const GAS v4u*)(rp + 32 + 8 * s4), v[5]); }
            float ss = 0.f;
#pragma unroll
            for (int c = 0; c < 6; ++c)
#pragma unroll
                for (int j = 0; j < 8; ++j) ss += v[c][j] * v[c][j];
            ss += __shfl_xor(ss, 1); ss += __shfl_xor(ss, 2);
            const float r = 1.0f / sqrtf(ss * (1.f / 192.f) + RMS_EPS);
#pragma unroll
            for (int c = 0; c < 6; ++c) { const int d = (c < 4) ? 32 * s4 + 8 * c : (c == 4 ? 128 + 8 * s4 : 160 + 8 * s4);
                const GAS f32x4* gp = (const GAS f32x4*)(gain + d); const f32x4 g0 = gp[0], g1 = gp[1];
#pragma unroll
                for (int j = 0; j < 4; ++j) { v[c][j] *= r * g0[j]; v[c][4 + j] *= r * g1[j]; } }
#pragma unroll
            for (int j = 0; j < 8; ++j) { const float x1 = v[4][j], x2 = v[5][j]; v[4][j] = x1 * cs[j] - x2 * sn[j]; v[5][j] = x2 * cs[j] + x1 * sn[j]; }
            const float sc = (which == 0) ? 4.0f * 0.10411755178336285f : 0.25f;
            unsigned char* op = (which == 0) ? Q8 + (size_t)m * 3072 + h * 192 : K8 + ((size_t)((m / SEQ) * 16 + h) * SEQ + t) * 192;
#pragma unroll
            for (int c = 0; c < 4; ++c) *(GAS v2u*)(op + 32 * s4 + 8 * c) = pack8_f8(v[c], sc);
            *(GAS v2u*)(op + 128 + 8 * s4) = pack8_f8(v[4], sc); *(GAS v2u*)(op + 160 + 8 * s4) = pack8_f8(v[5], sc);
        }
    }
    for (int task = gw; task < 48 * 128; task += NGW) {
        const int pair = task >> 7, kb = task & 127;
        const bf16* vp = VH + ((size_t)pair * SEQ + (size_t)kb * 64) * 128 + 2 * lane;
        unsigned char* op = Vt8 + ((size_t)pair * 128 + 2 * lane) * SEQ + kb * 64;
#pragma unroll
        for (int hf = 0; hf < 2; ++hf) {
            unsigned w[32];
#pragma unroll
            for (int i = 0; i < 32; ++i) w[i] = *(const GAS unsigned*)(vp + (size_t)(hf * 32 + i) * 128);
            v4u d0[2], d1[2];
#pragma unroll
            for (int q4 = 0; q4 < 8; ++q4) {
                const unsigned a = w[4 * q4], b = w[4 * q4 + 1], c = w[4 * q4 + 2], d = w[4 * q4 + 3];
                const unsigned lo = pk4_f8(bflo(a), bflo(b), bflo(c), bflo(d)), hi = pk4_f8(bfhi(a), bfhi(b), bfhi(c), bfhi(d));
                if ((q4 & 3) == 0) { d0[q4 >> 2].x = lo; d1[q4 >> 2].x = hi; } else if ((q4 & 3) == 1) { d0[q4 >> 2].y = lo; d1[q4 >> 2].y = hi; }
                else if ((q4 & 3) == 2) { d0[q4 >> 2].z = lo; d1[q4 >> 2].z = hi; } else { d0[q4 >> 2].w = lo; d1[q4 >> 2].w = hi; }
            }
            *(GAS v4u*)(op + hf * 32) = d0[0]; *(GAS v4u*)(op + hf * 32 + 16) = d0[1];
            *(GAS v4u*)(op + SEQ + hf * 32) = d1[0]; *(GAS v4u*)(op + SEQ + hf * 32 + 16) = d1[1];
        }
    }
    }
    GRID_BAR();
#endif
    STAMP(5);
#if (PHM >> 5) & 1
    {
        kptr_t kp = karg(); unsigned char* ws = KWS();
        const unsigned char* Q8 = ws + WS_Q8; const unsigned char* K8 = ws + WS_K8; const unsigned char* Vt8 = ws + WS_VT8; unsigned char* BOUT = ws + WS_BOUT;
        for (int i = 0;; ++i) {
            int pair, qb;
            if (G == 256) { pair = i * 8 + (bx & 7); qb = bx >> 3; if (pair >= 48) break; }
            else { const int L = i * G + bx; if (L >= 48 * 32) break; pair = L >> 5; qb = L & 31; }
            const int sq = pair >> 4, h = pair & 15; const size_t tok0 = (size_t)sq * SEQ + (size_t)qb * 256;
            att::attn_unit(Q8 + tok0 * 3072 + h * 192, K8 + (size_t)pair * SEQ * 192, Vt8 + (size_t)pair * 128 * SEQ, BOUT + tok0 * 2048 + h * 128, lds + RING_OFF);
        }
    }
    GRID_BAR();
#endif
    STAMP(6);
#if (PHM >> 6) & 1
    {
        kptr_t kp = karg(); unsigned char* ws = KWS();
        bf16* PAp = (bf16*)(ws + WS_A); bf16* BOUT = (bf16*)(ws + WS_BOUT); bf16* Wp = (bf16*)(ws + WS_WP); bf16* Bbm = (bf16*)(ws + WS_BBM);
        bf16* Tb = (bf16*)(ws + WS_F); bf16* Mb = (bf16*)(ws + WS_F); bf16* ZG = (bf16*)(ws + WS_ZG);
    {
        pg8::Gemm g{PAp, Wp, M, 4096, 2048}; pg8::StaticOrder S; S.init(M, 4096, G, bx);
        pg8::EpiGateA E{Tb, ZG};
        pg8::gemm_phase<pg8::EpiGateA, pg8::StaticOrder, true, true>(lds + RING_OFF, g, S, E);
    }
    {
        pg8::Gemm g{BOUT, Bbm, M, 4096, 1024}; pg8::StaticOrder S; S.init(M, 4096, G, bx);
        pg8::EpiGateB8 E{Tb, Mb, ZG, 1.0f / 1024.0f};
        pg8::gemm_phase<pg8::EpiGateB8, pg8::StaticOrder, true, true, true>(lds + RING_OFF, g, S, E);
    }
    }
    GRID_BAR();
#endif
    STAMP(7);
#if (PHM >> 7) & 1
    {
        kptr_t kp = karg(); unsigned char* ws = KWS(); const float* x_prompt = KIN(0); const float* x_sample = KIN(1); float* out = KOUT();
        bf16* Mb = (bf16*)(ws + WS_F); bf16* Bo = (bf16*)(ws + WS_BO);
        pg8::Gemm g{Mb, Bo, M, 4096, 4096}; pg8::StaticOrder S; S.init(M, 4096, G, bx);
        pg8::EpiX1 E{x_prompt, x_sample, (bf16*)(ws + WS_H2), (float*)(ws + WS_ROWSS)};
        pg8::gemm_phase<pg8::EpiX1, pg8::StaticOrder, true, true>(lds + RING_OFF, g, S, E);
    }
#endif
    STAMP(8);
#if (PHM >> 8) & 1
    {
        PHASE_IDS();
        kptr_t kp = karg(); unsigned char* ws = KWS(); const float* norm_ffn_gain = KIN(15); const float* w_up = KIN(16); const float* w_down = KIN(19); float* out = KOUT();
        bf16* Bup = (bf16*)(ws + WS_BUP); bf16* Bdown = (bf16*)(ws + WS_BDOWN); bf16* H2 = (bf16*)(ws + WS_H2);
        constexpr int I_UP = 64 * 688, I_DOWN = 0;
        for (int it = gw; it < I_UP + I_DOWN; it += NGW) {
            int r = it;
            if (r < I_UP) { const int n0 = 32 * (r % 688); const int nn = (n0 < DFF) ? n0 : n0 - DFF; const int drow = 256 * (nn >> 7) + (nn & 127) + ((n0 < DFF) ? 0 : 128);
                tr_item(w_up, NUP, Bup, 4096, 64 * (r / 688), n0, drow, scr, lane, norm_ffn_gain); continue; } r -= I_UP;
            tr_item(w_down, 4096, Bdown, DFF, 64 * (r / 128), 32 * (r % 128), 32 * (r % 128), scr, lane);
        }
    }
    GRID_BAR();
#endif
    STAMP(9);
#if (PHM >> 9) & 1
    {
        kptr_t kp = karg(); unsigned char* ws = KWS(); const float* conv_w = KIN(17); const float* conv_b = KIN(18);
        bf16* H2 = (bf16*)(ws + WS_H2); bf16* Bup = (bf16*)(ws + WS_BUP); bf16* ACT = (bf16*)(ws + WS_ACT); bf16* SIDE = (bf16*)(ws + WS_SIDE);
        pg8::Gemm g{H2, Bup, M, NUP, DM}; pg8::DynRoundsOrder S; S.init2(M, NUP, G, bx, (unsigned*)(ws + WS_DYNCTR) + 1024, MISC + 4, 3);
        pg8::EpiConvGlu E{ACT, SIDE, conv_w, conv_b, lds + CONVSCR_OFF, (const float*)(ws + WS_ROWSS)};
        pg8::gemm_phase<pg8::EpiConvGlu, pg8::DynRoundsOrder, true, true>(lds + RING_OFF, g, S, E);
        {
            PHASE_IDS();
            const float* w_down = KIN(19); bf16* Bdown = (bf16*)(ws + WS_BDOWN); unsigned* qctr = (unsigned*)(ws + WS_DYNCTR) + 128;
            for (;;) {
                if (tidp_ == 0) MISC[5] = __hip_atomic_fetch_add(qctr, 1u, __ATOMIC_RELAXED, __HIP_MEMORY_SCOPE_AGENT);
                __syncthreads();
                const unsigned ch = MISC[5];
                __syncthreads();
                if (ch >= 172u * 128u / 16u) break;
#pragma unroll
                for (int j = 0; j < 2; ++j) { const int it = (int)ch * 16 + wavep_ * 2 + j;
                    tr_item(w_down, 4096, Bdown, DFF, 64 * (it / 128), 32 * (it % 128), 32 * (it % 128), scr, lane); }
            }
        }
    }
    GRID_BAR();
    STAMP(10);
    {
        PHASE_IDS();
        kptr_t kp = karg(); unsigned char* ws = KWS(); const float* conv_w = KIN(17); const float* conv_b = KIN(18);
        bf16* ACT = (bf16*)(ws + WS_ACT); const bf16* SIDE = (const bf16*)(ws + WS_SIDE);
        for (int idx = gt; idx < 768 * 1376; idx += NGT) {
            const int rw = idx / 1376, ch = idx % 1376, blk = rw >> 1, last = rw & 1, tile = ch >> 4, j8 = (ch & 15) * 8, c = tile * 128 + j8, col = tile * 256 + j8;
            const bf16* sb = SIDE + (size_t)blk * 4 * NUP + col;
            const v4u zero = {0u, 0u, 0u, 0u};
            v4u gmv, g0v, gpv, vmv, v0v, vpv;
            if (!last) { const bool has = (blk & 127) != 0;
                gmv = has ? *(const GAS v4u*)(sb - NUP) : zero; vmv = has ? *(const GAS v4u*)(sb - NUP + 128) : zero;
                g0v = *(const GAS v4u*)(sb); v0v = *(const GAS v4u*)(sb + 128); gpv = *(const GAS v4u*)(sb + NUP); vpv = *(const GAS v4u*)(sb + NUP + 128); }
            else { const bool has = (blk & 127) != 127;
                gmv = *(const GAS v4u*)(sb + 2 * NUP); vmv = *(const GAS v4u*)(sb + 2 * NUP + 128); g0v = *(const GAS v4u*)(sb + 3 * NUP); v0v = *(const GAS v4u*)(sb + 3 * NUP + 128);
                gpv = has ? *(const GAS v4u*)(sb + 4 * NUP) : zero; vpv = has ? *(const GAS v4u*)(sb + 4 * NUP + 128) : zero; }
            float gm[8], g0[8], gp[8], vm[8], v0[8], vp[8], a[8];
            unpack8(gmv, gm); unpack8(g0v, g0); unpack8(gpv, gp); unpack8(vmv, vm); unpack8(v0v, v0); unpack8(vpv, vp);
#pragma unroll
            for (int j = 0; j < 8; ++j) {
                const float gg = gm[j] * conv_w[c + j] + g0[j] * conv_w[NUP + c + j] + gp[j] * conv_w[2 * NUP + c + j] + conv_b[c + j];
                const float vv = vm[j] * conv_w[DFF + c + j] + v0[j] * conv_w[NUP + DFF + c + j] + vp[j] * conv_w[2 * NUP + DFF + c + j] + conv_b[DFF + c + j];
                a[j] = gg * __builtin_amdgcn_rcpf(1.0f + __expf(-gg)) * vv; }
            *(GAS v4u*)(ACT + ((size_t)blk * 64 + (last ? 63 : 0)) * DFF + c) = pack8(a);
        }
    }
    GRID_BAR();
    STAMP(11);
    {
        kptr_t kp = karg(); unsigned char* ws = KWS(); float* out = KOUT(); bf16* ACT = (bf16*)(ws + WS_ACT); bf16* Bdown = (bf16*)(ws + WS_BDOWN);
        pg8::Gemm g{ACT, Bdown, M, 4096, DFF}; pg8::StaticOrder S; S.init(M, 4096, G, bx);
        pg8::EpiOutX1 E{(const bf16*)(ws + WS_H2), out};
        pg8::gemm_phase<pg8::EpiOutX1, pg8::StaticOrder, true, true>(lds + RING_OFF, g, S, E);
    }
#endif
    STAMP(12);
#if defined(PROBE_A)
#if defined(PROBE_BAR_BX)
    if (bx == (PROBE_BAR_BX) && tid == 0) { unsigned d = MISC[31] * (unsigned)PROBE_MULT;
#else
    if (bx == 0 && tid == 0) { unsigned d = 0u;
#endif
        d += (MISC[16 + PROBE_B] - MISC[16 + PROBE_A]) * (unsigned)PROBE_MULT;
#if defined(PROBE_ATT)
        d += MISC[30] * (unsigned)PROBE_MULT;
#endif
#if defined(PROBE_CLK_A)
        d += (MISC[13] - MISC[12]) >> 4;
#endif
#if defined(PROBE_C)
        d += (MISC[16 + PROBE_D] - MISC[16 + PROBE_C]) * (unsigned)PROBE_MULT;
#endif
        if (d > 2000000u) d = 2000000u;
        const unsigned long long t0 = __builtin_amdgcn_s_memrealtime(); while ((unsigned)(__builtin_amdgcn_s_memrealtime() - t0) < d) __builtin_amdgcn_s_sleep(20); }
#endif
}

extern "C" void kernel_launch(void* const* d_in, const int* in_sizes, int n_in, void* d_out, int out_size, void* d_ws, size_t ws_size, hipStream_t stream) {
    static int grid = 0;
    if (grid == 0) {
        if (n_in != 20 || in_sizes[0] != MP * DM || in_sizes[1] != (M - MP) * DM || out_size != M * DM || ws_size < WS_NEED) {
            fprintf(stderr, "kernel_launch: shape mismatch (n_in %d, in0 %d, in1 %d, out %d, ws %zu, need %zu); nothing launched\n", n_in, n_in > 0 ? in_sizes[0] : -1, n_in > 1 ? in_sizes[1] : -1, out_size, ws_size, (size_t)WS_NEED); grid = -1; return; }
        int dev = 0, cus = 0, per_cu = 0;
        if (hipGetDevice(&dev) != hipSuccess || hipDeviceGetAttribute(&cus, hipDeviceAttributeMultiprocessorCount, dev) != hipSuccess) { fprintf(stderr, "kernel_launch: device query failed\n"); grid = -1; return; }
        if (hipFuncSetAttribute((const void*)fwd_kernel, hipFuncAttributeMaxDynamicSharedMemorySize, LDS_BYTES) != hipSuccess) { fprintf(stderr, "kernel_launch: hipFuncSetAttribute failed\n"); grid = -1; return; }
        if (hipOccupancyMaxActiveBlocksPerMultiprocessor(&per_cu, (const void*)fwd_kernel, NWAVES * 64, LDS_BYTES) != hipSuccess || per_cu < 1)
            fprintf(stderr, "kernel_launch: note: occupancy query reports %d workgroups per CU\n", per_cu);
        (void)hipGetLastError();
        grid = cus;
    }
    if (grid < 0) return;
    if (hipMemsetAsync((char*)d_ws + WS_CTL, 0, CTL_ZERO_BYTES, stream) != hipSuccess) { fprintf(stderr, "kernel_launch: memset failed\n"); return; }
    Args a{};
    for (int i = 0; i < 20; ++i) a.in[i] = (const float*)d_in[i];
    a.out = (float*)d_out; a.ws = (unsigned char*)d_ws;
    hipLaunchKernelGGL(fwd_kernel, dim3(grid), dim3(NWAVES * 64), LDS_BYTES, stream, a);
    const hipError_t le = hipPeekAtLastError();
    if (le != hipSuccess) fprintf(stderr, "kernel_launch: launch failed: %s\n", hipGetErrorName(le));
}
```
